# Optimizing an MI355X kernel written in HIP

```python
import math
import jax, jax.numpy as jnp
from jax import lax
import numpy as np


D_MODEL = 1024
BATCH = 8
SEQ = 4096
DEPTH = 4

CHUNK = 64
A_HEADS = 4
A_HEAD_DIM = 64
A_WIDTH = A_HEADS * A_HEAD_DIM
SGU_BLOCK = 128
B_WIDTH = 256
CONV_WIDTH = 31
C_HEADS = 8
C_HEAD_DIM = 64
C_WIDTH = C_HEADS * C_HEAD_DIM
DECAY_LORA = 64
ICLR_LORA = 64
MIX_WIDTH = A_WIDTH + B_WIDTH + C_WIDTH
PLE_DIM = 256
C_SHIFT_COLS = 3 * C_WIDTH + DECAY_LORA + ICLR_LORA
IN_COLS = 3 * A_WIDTH + 3 * B_WIDTH + C_SHIFT_COLS + C_WIDTH
RMS_EPS = 1e-6
LN_EPS = 1e-5
GN_EPS = 64e-5
DECAY_SCALE = math.exp(-0.5)

kernel_name = "hybrid_sgu_conformer_rwkv7_stream"


def rms_norm(x, g):
    xf = x.astype(jnp.float32)
    y = xf * lax.rsqrt(jnp.mean(xf * xf, axis=-1, keepdims=True) + RMS_EPS)
    return (y * g.astype(jnp.float32)).astype(x.dtype)


def layer_norm(x, g, b):
    xf = x.astype(jnp.float32)
    mu = jnp.mean(xf, axis=-1, keepdims=True)
    var = jnp.mean(jnp.square(xf - mu), axis=-1, keepdims=True)
    y = (xf - mu) * lax.rsqrt(var + LN_EPS)
    return (y * g.astype(jnp.float32) + b.astype(jnp.float32)).astype(x.dtype)


def chunk_causal_mask(n):
    ci = jnp.arange(n)[:, None] // CHUNK
    cj = jnp.arange(n)[None, :] // CHUNK
    return cj <= ci


def spatial_gating(u, v, ln_g, ln_b, w_s, b_s):
    bsz, seq, _ = v.shape
    v = layer_norm(v, ln_g, ln_b)
    vb = v.reshape(bsz, seq // SGU_BLOCK, SGU_BLOCK, A_HEADS, A_HEAD_DIM)
    w = jnp.where(chunk_causal_mask(SGU_BLOCK)[None], w_s, jnp.zeros_like(w_s))
    mixed = jnp.einsum('hij,bnjhd->bnihd', w, vb) + b_s.T[None, None, :, :, None]
    return u * mixed.reshape(bsz, seq, A_WIDTH)


def conv_module(val, glu_gate, conv_w, conv_b, ln_g, ln_b, pw_w, pw_b):
    y = val * jax.nn.sigmoid(glu_gate)
    y = lax.conv_general_dilated(
        y, conv_w[:, None, :], window_strides=(1,), padding=[(CONV_WIDTH - 1, 0)],
        dimension_numbers=('NWC', 'WIO', 'NWC'), feature_group_count=B_WIDTH) + conv_b
    y = jax.nn.silu(layer_norm(y, ln_g, ln_b))
    return y @ pw_w + pw_b


def token_shift(z, mu):
    prev = jnp.pad(z, ((0, 0), (1, 0), (0, 0)))[:, :-1]
    return z + mu * (prev - z)


def rwkv7_scan(r, w, k, v, a, b):
    bsz = r.shape[0]

    def step(state, inp):
        r_t, w_t, k_t, v_t, a_t, b_t = inp
        sa = jnp.einsum('bhvk,bhk->bhv', state, a_t)
        state = (state * w_t[:, :, None, :] + sa[..., None] * b_t[:, :, None, :]
                 + v_t[..., None] * k_t[:, :, None, :])
        y_t = jnp.einsum('bhvk,bhk->bhv', state, r_t)
        return state, y_t

    xs = (r.transpose(1, 0, 2, 3), w.transpose(1, 0, 2, 3), k.transpose(1, 0, 2, 3),
          v.transpose(1, 0, 2, 3), a.transpose(1, 0, 2, 3), b.transpose(1, 0, 2, 3))
    init = jnp.zeros((bsz, C_HEADS, C_HEAD_DIM, C_HEAD_DIM), jnp.float32)
    _, ys = lax.scan(step, init, xs)
    return ys.transpose(1, 0, 2, 3)


def rwkv7_mix(z, mu, w0, w_up, a0, a_up, k_k, k_a, r_k, lnx_g, lnx_b):
    bsz, seq, _ = z.shape
    f32 = jnp.float32
    z = token_shift(z, mu)
    r = z[..., :C_WIDTH]
    k = z[..., C_WIDTH:2 * C_WIDTH]
    v = z[..., 2 * C_WIDTH:3 * C_WIDTH]
    wd = z[..., 3 * C_WIDTH:3 * C_WIDTH + DECAY_LORA]
    ad = z[..., 3 * C_WIDTH + DECAY_LORA:]
    log_w = -DECAY_SCALE * jax.nn.sigmoid((w0 + jnp.tanh(wd) @ w_up).astype(f32))
    a = jax.nn.sigmoid((a0 + ad @ a_up).astype(f32))

    def heads(t):
        return t.astype(f32).reshape(bsz, seq, C_HEADS, C_HEAD_DIM)

    def hvec(t):
        return t.astype(f32).reshape(C_HEADS, C_HEAD_DIM)

    r, k, v, w, a = heads(r), heads(k), heads(v), jnp.exp(heads(log_w)), heads(a)
    kk = k * hvec(k_k)
    kk = kk * lax.rsqrt(jnp.maximum(jnp.sum(kk * kk, axis=-1, keepdims=True), 1e-12))
    k = k * (1.0 + (a - 1.0) * hvec(k_a))
    y = rwkv7_scan(r, w, k, v, -kk, kk * a)
    mu_y = jnp.mean(y, axis=-1, keepdims=True)
    var_y = jnp.mean(jnp.square(y - mu_y), axis=-1, keepdims=True)
    y = (y - mu_y) * lax.rsqrt(var_y + GN_EPS) * hvec(lnx_g) + hvec(lnx_b)
    y = y + jnp.sum(r * k * r_k.astype(f32), axis=-1, keepdims=True) * v
    return y.reshape(bsz, seq, C_WIDTH).astype(z.dtype)


def setup_inputs(seed: int = 0) -> dict:
    key = jax.random.key(seed)
    ks = jax.random.split(key, 40)
    f32 = jnp.float32

    def nrm(k, shape, scale):
        return jax.random.normal(k, shape, f32) * scale

    def gain(k, shape):
        return 1.0 + 0.05 * jax.random.normal(k, shape, f32)

    L = DEPTH
    return {
        'x': nrm(ks[0], (BATCH, SEQ, D_MODEL), 1.0),
        'p': nrm(ks[1], (DEPTH, BATCH, SEQ, PLE_DIM), 1.0),
        'pre_norm_g': gain(ks[2], (L, D_MODEL)),
        'w_in': nrm(ks[3], (L, D_MODEL, IN_COLS), D_MODEL ** -0.5),
        'sgu_ln_g': gain(ks[4], (L, A_WIDTH)),
        'sgu_ln_b': nrm(ks[5], (L, A_WIDTH), 0.01),
        'sgu_w': nrm(ks[6], (L, A_HEADS, SGU_BLOCK, SGU_BLOCK), SGU_BLOCK ** -0.5),
        'sgu_b': 1.0 + nrm(ks[7], (L, A_HEADS, SGU_BLOCK), 0.1),
        'conv_w': nrm(ks[8], (L, CONV_WIDTH, B_WIDTH), CONV_WIDTH ** -0.5),
        'conv_b': nrm(ks[9], (L, B_WIDTH), 0.01),
        'conv_ln_g': gain(ks[10], (L, B_WIDTH)),
        'conv_ln_b': nrm(ks[11], (L, B_WIDTH), 0.01),
        'pw_w': nrm(ks[12], (L, B_WIDTH, B_WIDTH), B_WIDTH ** -0.5),
        'pw_b': nrm(ks[13], (L, B_WIDTH), 0.01),
        'shift_mu': jax.random.uniform(ks[14], (L, C_SHIFT_COLS), f32),
        'w0': nrm(ks[15], (L, C_WIDTH), 0.5),
        'w_up': nrm(ks[16], (L, DECAY_LORA, C_WIDTH), 0.5 * DECAY_LORA ** -0.5),
        'a0': nrm(ks[17], (L, C_WIDTH), 0.5),
        'a_up': nrm(ks[18], (L, ICLR_LORA, C_WIDTH), 0.5 * ICLR_LORA ** -0.5),
        'k_k': 0.85 + nrm(ks[19], (L, C_WIDTH), 0.05),
        'k_a': gain(ks[20], (L, C_WIDTH)),
        'r_k': nrm(ks[21], (L, C_HEADS, C_HEAD_DIM), 0.1),
        'lnx_g': gain(ks[22], (L, C_WIDTH)),
        'lnx_b': nrm(ks[23], (L, C_WIDTH), 0.01),
        'w_out': nrm(ks[24], (L, MIX_WIDTH, D_MODEL), MIX_WIDTH ** -0.5),
        'post_norm_g': gain(ks[25], (L, D_MODEL)),
        'ple_w': nrm(ks[26], (L, PLE_DIM, D_MODEL), PLE_DIM ** -0.5),
        'ple_gate_w': nrm(ks[27], (L, D_MODEL, D_MODEL), D_MODEL ** -0.5),
        'ple_gate_b': nrm(ks[28], (L, D_MODEL), 0.01),
    }


def reference(x, p, pre_norm_g, w_in, sgu_ln_g, sgu_ln_b, sgu_w, sgu_b, conv_w, conv_b,
              conv_ln_g, conv_ln_b, pw_w, pw_b, shift_mu, w0, w_up, a0, a_up, k_k, k_a,
              r_k, lnx_g, lnx_b, w_out, post_norm_g, ple_w, ple_gate_w, ple_gate_b):
    oa = 0
    ob = 3 * A_WIDTH
    oc = ob + 3 * B_WIDTH
    og = oc + C_SHIFT_COLS
    for i in range(DEPTH):
        h = rms_norm(x, pre_norm_g[i])
        z = h @ w_in[i]
        u_a = z[..., oa:oa + A_WIDTH]
        v_a = z[..., oa + A_WIDTH:oa + 2 * A_WIDTH]
        g_a = z[..., oa + 2 * A_WIDTH:ob]
        out_a = spatial_gating(u_a, v_a, sgu_ln_g[i], sgu_ln_b[i], sgu_w[i], sgu_b[i]) * jax.nn.silu(g_a)
        val_b = z[..., ob:ob + B_WIDTH]
        glu_b = z[..., ob + B_WIDTH:ob + 2 * B_WIDTH]
        g_b = z[..., ob + 2 * B_WIDTH:oc]
        out_b = conv_module(val_b, glu_b, conv_w[i], conv_b[i], conv_ln_g[i], conv_ln_b[i],
                            pw_w[i], pw_b[i]) * jax.nn.silu(g_b)
        out_c = rwkv7_mix(z[..., oc:og], shift_mu[i], w0[i], w_up[i], a0[i], a_up[i], k_k[i],
                          k_a[i], r_k[i], lnx_g[i], lnx_b[i]) * jax.nn.silu(z[..., og:])
        mix = jnp.concatenate([out_a, out_b, out_c], axis=-1) @ w_out[i]
        x = x + rms_norm(mix, post_norm_g[i])
        gate = jax.nn.sigmoid(x @ ple_gate_w[i] + ple_gate_b[i])
        x = x + (p[i] @ ple_w[i]) * gate
    return x
```

```cpp
#include <hip/hip_runtime.h>
#include <hip/hip_cooperative_groups.h>
#include <cstdio>
namespace cg = cooperative_groups;
namespace pg8 {
#define PG8_LAS __attribute__((address_space(3)))
typedef unsigned short bf16_t;
typedef short bf16x8 __attribute__((ext_vector_type(8)));
typedef float f32x4 __attribute__((ext_vector_type(4)));
typedef unsigned u32x4 __attribute__((ext_vector_type(4)));
constexpr int BM = 256, BK = 64, HALF = 128, HTB = HALF * BK * 2  , STAGE_BYTES = 8 * HTB, NXCD = 8, WGM = 8;

__host__ __device__ __forceinline__ int lds_byte(int r, int c) { const int st = (r >> 4) * 2 + (c >> 5), rr = r & 15, cc = c & 31, ob = rr * 64 + cc * 2; return st * 1024 + (ob ^ (((ob >> 9) & 1) << 5)); }
__host__ __device__ __forceinline__ void stage_rc(int b, int& R, int& C) { const int st = b / 1024, sb = b % 1024, swz = sb ^ (((sb >> 9) & 1) << 5); R = (st >> 1) * 16 + swz / 64; C = (st & 1) * 32 + (swz % 64) / 2; }
__host__ __device__ __forceinline__ int perm32(int rho) { const int n = rho >> 4, i = rho & 15; return 8 * (i >> 2) + 4 * n + (i & 3); }

struct Unit { int pm, pn; };
struct Gemm { const bf16_t* A; const bf16_t* Bt; int M, N, K; };

struct StaticOrder {
    int nM, nN, nwg, G, c;
    __host__ __device__ void init(int M, int N, int G_, int c_) { nM = M / BM; nN = N / BM; nwg = nM * nN; G = G_; c = c_; }
    __host__ __device__ bool next(int i, Unit& u) const {
        const long L = (long)i * G + c; if (L >= nwg) return false;
        int wgid = (int)L; { const int q = nwg / NXCD, r = nwg % NXCD, xcd = wgid % NXCD, off = wgid / NXCD; wgid = (xcd < r ? xcd * (q + 1) : r * (q + 1) + (xcd - r) * q) + off; }
        const int nig = WGM * nN, gid = wgid / nig, fm = gid * WGM, gsz = (nM - fm) < WGM ? (nM - fm) : WGM;
        u.pm = fm + ((wgid % nig) % gsz); u.pn = (wgid % nig) / gsz; return true;
    }
    __device__ __forceinline__ void a_ready(const Unit&) const {}
    __device__ __forceinline__ void done(const Unit&) const {}
};
__device__ __forceinline__ unsigned cvt_pk_bf16(float lo, float hi) { unsigned r; asm volatile("v_cvt_pk_bf16_f32 %0, %1, %2" : "=v"(r) : "v"(lo), "v"(hi)); return r; }
typedef float f32x2 __attribute__((ext_vector_type(2)));
template <class Epi, class Sched, bool STAMP = false>
__device__ __forceinline__ void gemm_phase(PG8_LAS unsigned char* lds, const Gemm g, const Sched& S, const Epi& E, unsigned long long* stamps) {
    int tid_ = threadIdx.x; asm volatile("" : "+v"(tid_));
    const int tid = tid_, wid = __builtin_amdgcn_readfirstlane(tid >> 6), lane = tid & 63, wr = wid >> 2, wc = wid & 3, fr = lane & 15, fq = lane >> 4;
    const int K = g.K, nt = K / BK;
    int ts_lo = 0, ts_hi = 0, nts = 0; const unsigned long long rt_entry = STAMP ? (unsigned long long)wall_clock64() : 0ull;
#define PG8_STAMP() do { if (STAMP && wid == 0 && nts < 64) { const unsigned long long _c = (unsigned long long)clock64(); \
        ts_lo = (lane == nts) ? (int)(unsigned)_c : ts_lo; ts_hi = (lane == nts) ? (int)(unsigned)(_c >> 32) : ts_hi; ++nts; } } while (0)
    PG8_STAMP();
    unsigned voffA[2], voffB[2];
#pragma unroll
    for (int i = 0; i < 2; ++i) { int R, C; stage_rc(tid * 16 + i * 8192, R, C); const int Rb = Epi::PERM ? ((R & ~31) + perm32(R & 31)) : R;
        voffA[i] = (unsigned)(R * K + C) * 2u; voffB[i] = (unsigned)(Rb * K + C) * 2u; }
    const size_t kstep = (size_t)(BK * 2);
    const size_t hstep = (size_t)HALF * K * 2;
    const size_t tstep = 2 * hstep;
    const unsigned ldsw = (unsigned)wid * 1024u;
    const int aoff = lds_byte(wr * 64 + fr, fq * 8), boff = lds_byte(wc * 32 + fr, fq * 8);
#define PG8_SA(b, h) (((b) * 2 + (h)) * HTB)
#define PG8_SB(b, h) ((4 + (b) * 2 + (h)) * HTB)
#define PG8_STAGE(bufoff, gbase, voff) do { _Pragma("unroll") for (int _i = 0; _i < 2; ++_i) \
        __builtin_amdgcn_global_load_lds((const unsigned*)((const char*)(gbase) + (voff)[_i]), (PG8_LAS unsigned*)(lds + (bufoff) + ldsw + _i * 8192), 16, 0, 0); } while (0)
#define PG8_LDA(dst, b, h) do { _Pragma("unroll") for (int m = 0; m < 4; ++m) _Pragma("unroll") for (int k = 0; k < 2; ++k) dst[m][k] = *(const PG8_LAS bf16x8*)(lds + PG8_SA(b, h) + aoff + m * 2048 + k * 1024); } while (0)
#define PG8_LDB(dst, b, h) do { _Pragma("unroll") for (int n = 0; n < 2; ++n) _Pragma("unroll") for (int k = 0; k < 2; ++k) dst[n][k] = *(const PG8_LAS bf16x8*)(lds + PG8_SB(b, h) + boff + n * 2048 + k * 1024); } while (0)
#define PG8_MMA(ai, bj, At, Bt) do { __builtin_amdgcn_s_setprio(1); _Pragma("unroll") for (int m = 0; m < 4; ++m) _Pragma("unroll") for (int n = 0; n < 2; ++n) _Pragma("unroll") for (int k = 0; k < 2; ++k) \
        acc[ai][bj][m][n] = __builtin_amdgcn_mfma_f32_16x16x32_bf16(Bt[n][k], At[m][k], acc[ai][bj][m][n], 0, 0, 0); __builtin_amdgcn_s_setprio(0); } while (0)
#define PG8_WAIT_V(n) asm volatile("s_waitcnt vmcnt(" #n ")" ::: "memory")
#define PG8_WAIT_L(n) asm volatile("s_waitcnt lgkmcnt(" #n ")" ::: "memory")
#define PG8_BAR __builtin_amdgcn_s_barrier()
#define PG8_SCHED __builtin_amdgcn_sched_barrier(0)
    Unit cur, nxt; int ui = 0;
    if (!S.next(0, cur)) return;
    f32x4 acc[2][2][4][2];
#pragma unroll
    for (int a = 0; a < 2; ++a)
#pragma unroll
        for (int b = 0; b < 2; ++b)
#pragma unroll
            for (int m = 0; m < 4; ++m)
#pragma unroll
                for (int n = 0; n < 2; ++n) acc[a][b][m][n] = (f32x4){0.f, 0.f, 0.f, 0.f};
    bf16x8 At[4][2], B0[2][2], B1[2][2];
    const char* cA = (const char*)g.A + (size_t)cur.pm * tstep; const char* cB = (const char*)g.Bt + (size_t)cur.pn * tstep;
    S.a_ready(cur);
    PG8_STAGE(PG8_SB(0, 0), cB, voffB); PG8_STAGE(PG8_SA(0, 0), cA, voffA); PG8_STAGE(PG8_SB(0, 1), cB + hstep, voffB); PG8_STAGE(PG8_SA(0, 1), cA + hstep, voffA);
    if (wr == 1) PG8_BAR;
    PG8_WAIT_V(4); PG8_BAR;
    PG8_STAGE(PG8_SB(1, 0), cB + kstep, voffB); PG8_STAGE(PG8_SA(1, 0), cA + kstep, voffA); PG8_STAGE(PG8_SB(1, 1), cB + hstep + kstep, voffB);
    PG8_WAIT_V(6); PG8_BAR;
    PG8_STAMP();
    for (;;) {
        const bool has_next = S.next(ui + 1, nxt);
        const char* nA = has_next ? (const char*)g.A + (size_t)nxt.pm * tstep : cA; const char* nB = has_next ? (const char*)g.Bt + (size_t)nxt.pn * tstep : cB;
        for (int t = 0; t < nt; t += 2) {
            const bool last = (t == nt - 2);
            const char* a1 = cA + (size_t)(t + 1) * kstep;
            const char* a2 = last ? nA : cA + (size_t)(t + 2) * kstep; const char* b2 = last ? nB : cB + (size_t)(t + 2) * kstep;
            const char* a3 = a2 + kstep; const char* b3 = b2 + kstep;
            if (last && has_next) S.a_ready(nxt);
            PG8_LDB(B0, 0, 0); PG8_SCHED; PG8_LDA(At, 0, 0); PG8_STAGE(PG8_SA(1, 1), a1 + hstep, voffA);
            PG8_WAIT_L(8); PG8_BAR; PG8_WAIT_L(0); PG8_MMA(0, 0, At, B0); PG8_BAR; PG8_SCHED;
            PG8_LDB(B1, 0, 1); PG8_STAGE(PG8_SB(0, 0), b2, voffB);
            PG8_BAR; PG8_WAIT_L(0); PG8_MMA(0, 1, At, B1); PG8_BAR;
            PG8_LDA(At, 0, 1); PG8_STAGE(PG8_SA(0, 0), a2, voffA);
            PG8_BAR; PG8_WAIT_L(0); PG8_MMA(1, 0, At, B0); PG8_BAR; PG8_SCHED;
            PG8_STAGE(PG8_SB(0, 1), b2 + hstep, voffB);
            PG8_WAIT_V(6); PG8_BAR; PG8_MMA(1, 1, At, B1); PG8_BAR;
            PG8_LDB(B0, 1, 0); PG8_SCHED; PG8_LDA(At, 1, 0); PG8_STAGE(PG8_SA(0, 1), a2 + hstep, voffA);
            PG8_WAIT_L(8); PG8_BAR; PG8_WAIT_L(0); PG8_MMA(0, 0, At, B0); PG8_BAR; PG8_SCHED;
            PG8_LDB(B1, 1, 1); PG8_STAGE(PG8_SB(1, 0), b3, voffB);
            PG8_BAR; PG8_WAIT_L(0); PG8_MMA(0, 1, At, B1); PG8_BAR;
            PG8_LDA(At, 1, 1); PG8_STAGE(PG8_SA(1, 0), a3, voffA);
            PG8_BAR; PG8_WAIT_L(0); PG8_MMA(1, 0, At, B0); PG8_BAR; PG8_SCHED;
            PG8_STAGE(PG8_SB(1, 1), b3 + hstep, voffB);
            PG8_WAIT_V(6); PG8_BAR; PG8_MMA(1, 1, At, B1); PG8_BAR;
        }
        PG8_STAMP();
        if constexpr (!Epi::AFTER_DRAIN) { E(acc, cur, wr, wc, fr, fq); S.done(cur); }
        PG8_STAMP();
        if (!has_next) break;
#pragma unroll
        for (int a = 0; a < 2; ++a)
#pragma unroll
            for (int b = 0; b < 2; ++b)
#pragma unroll
                for (int m = 0; m < 4; ++m)
#pragma unroll
                    for (int n = 0; n < 2; ++n) acc[a][b][m][n] = (f32x4){0.f, 0.f, 0.f, 0.f};
        cur = nxt; cA = nA; cB = nB; ++ui;
    }
    PG8_WAIT_V(0);
    if (wr == 0) PG8_BAR;
    PG8_BAR;
    if constexpr (Epi::AFTER_DRAIN) { E.fused(acc, cur, wr, wc, fr, fq, lds, wid, lane); S.done(cur); }
    PG8_STAMP();
    if (STAMP && wid == 0) { stamps[lane] = lane < nts ? (((unsigned long long)(unsigned)ts_hi << 32) | (unsigned)ts_lo) : 0ull;
        if (lane == 62) stamps[62] = rt_entry; if (lane == 63) stamps[63] = (unsigned long long)wall_clock64(); }
#undef PG8_STAMP
#undef PG8_SA
#undef PG8_SB
#undef PG8_STAGE
#undef PG8_LDA
#undef PG8_LDB
#undef PG8_MMA
#undef PG8_WAIT_V
#undef PG8_WAIT_L
#undef PG8_BAR
#undef PG8_SCHED
}
}

using pg8::bf16_t; using pg8::f32x4; using pg8::u32x4; using pg8::Unit;
typedef unsigned u32x2 __attribute__((ext_vector_type(2)));

constexpr int M_ = 32768, D_ = 1024, S_ = 4096, L_ = 4;
constexpr int NZ = 3712, NZP = 3840;
constexpr int ZC_U = 0, ZC_V = 256, ZC_GA = 512, ZC_VAL = 768, ZC_GLU = 1024, ZC_GB = 1280, ZC_R = 1536, ZC_K = 2048, ZC_VV = 2560, ZC_GC = 3072, ZC_WD = 3584, ZC_AD = 3648;
constexpr float RMS_EPS = 1e-6f, LN_EPS = 1e-5f, GN_EPS = 64e-5f, DECAY_SCALE = 0.6065306597126334f;

enum { I_X = 0, I_P, I_PREG, I_WIN, I_SLNG, I_SLNB, I_SGUW, I_SGUB, I_CW, I_CB, I_CLNG, I_CLNB, I_PWW, I_PWB, I_MU, I_W0, I_WUP, I_A0, I_AUP, I_KK, I_KA, I_RK, I_LXG, I_LXB, I_WOUT, I_POSTG, I_PLEW, I_GW, I_GB, N_IN };

constexpr size_t WS_CTL = 0;
constexpr size_t WS_WIN = 65536;
constexpr size_t WS_WOUT = WS_WIN + (size_t)L_ * NZP * 1024 * 2;
constexpr size_t WS_WG = WS_WOUT + (size_t)L_ * 1024 * 1024 * 2;
constexpr size_t WS_WP = WS_WG + (size_t)L_ * 1024 * 1024 * 2;
constexpr size_t WS_SSQ1 = WS_WP + (size_t)L_ * 1024 * 256 * 2;
constexpr size_t WS_SSQ2 = WS_SSQ1 + (size_t)M_ * 16 * 4;
constexpr size_t WS_Z = WS_SSQ2 + (size_t)M_ * 16 * 4;
constexpr size_t WS_RA = WS_Z + (size_t)M_ * NZ * 2;
constexpr size_t WS_RB = WS_RA + (size_t)M_ * 1024 * 2;
constexpr size_t WS_WQ = WS_RB + (size_t)M_ * 1024 * 2;
constexpr size_t WS_AQ = WS_WQ + (size_t)M_ * 512 * 2;
constexpr size_t WS_PB = WS_AQ + (size_t)M_ * 512 * 2;
constexpr size_t WS_END = WS_PB + (size_t)M_ * 256 * 2;
constexpr size_t WS_PP = WS_Z;

struct Args { const float* in[N_IN]; float* out; unsigned char* ws; int ph_lo, ph_hi; };
static_assert(sizeof(Args) == 8 * N_IN + 8 + 8 + 8, "no padding");

__device__ __forceinline__ float bf2f(unsigned h) { return __uint_as_float(h << 16); }
__device__ __forceinline__ unsigned f2bf(float f) { unsigned u = __float_as_uint(f); return (u + 0x7fffu + ((u >> 16) & 1u)) >> 16; }
__device__ __forceinline__ unsigned pk2(float lo, float hi) { return f2bf(lo) | (f2bf(hi) << 16); }
__device__ __forceinline__ float wave_sum(float v) {
#pragma unroll
    for (int o = 1; o < 64; o <<= 1) v += __shfl_xor(v, o);
    return v;
}
__device__ __forceinline__ float sigmoidf_(float x) { return 1.0f / (1.0f + __expf(-x)); }
__device__ __forceinline__ float siluf_(float x) { return x / (1.0f + __expf(-x)); }
__device__ __forceinline__ void unpack8(const u32x4 w, float (&o)[8]) {
    o[0] = bf2f(w.x & 0xffffu); o[1] = __uint_as_float(w.x & 0xffff0000u); o[2] = bf2f(w.y & 0xffffu); o[3] = __uint_as_float(w.y & 0xffff0000u);
    o[4] = bf2f(w.z & 0xffffu); o[5] = __uint_as_float(w.z & 0xffff0000u); o[6] = bf2f(w.w & 0xffffu); o[7] = __uint_as_float(w.w & 0xffff0000u);
}
__device__ __forceinline__ void unpack4(const u32x2 w, float (&o)[4]) {
    o[0] = bf2f(w.x & 0xffffu); o[1] = __uint_as_float(w.x & 0xffff0000u); o[2] = bf2f(w.y & 0xffffu); o[3] = __uint_as_float(w.y & 0xffff0000u);
}

struct EpiZ {
    static constexpr bool PERM = true, AFTER_DRAIN = false;
    bf16_t* Z; const float* ssq;
    __device__ __forceinline__ void operator()(const f32x4 (&acc)[2][2][4][2], const Unit& u, int wr, int wc, int fr, int fq) const {
        const int row0 = u.pm * 256 + wr * 64 + fr, col0 = u.pn * 256 + wc * 32 + 8 * fq;
#pragma unroll
        for (int ai = 0; ai < 2; ++ai)
#pragma unroll
            for (int m = 0; m < 4; ++m) {
                const int row = row0 + ai * 128 + m * 16;
                const f32x4* sp = (const f32x4*)(ssq + (size_t)row * 16);
                const f32x4 s0 = sp[0], s1 = sp[1], s2 = sp[2], s3 = sp[3];
                const float t = ((s0[0] + s0[1]) + (s0[2] + s0[3])) + ((s1[0] + s1[1]) + (s1[2] + s1[3])) + ((s2[0] + s2[1]) + (s2[2] + s2[3])) + ((s3[0] + s3[1]) + (s3[2] + s3[3]));
                const float rstd = rsqrtf(t * (1.0f / 1024.0f) + RMS_EPS);
#pragma unroll
                for (int bj = 0; bj < 2; ++bj) {
                    const int col = col0 + bj * 128;
                    if (col < NZ) {
                        const f32x4 v0 = acc[ai][bj][m][0] * rstd, v1 = acc[ai][bj][m][1] * rstd;
                        u32x4 w; w.x = pg8::cvt_pk_bf16(v0[0], v0[1]); w.y = pg8::cvt_pk_bf16(v0[2], v0[3]); w.z = pg8::cvt_pk_bf16(v1[0], v1[1]); w.w = pg8::cvt_pk_bf16(v1[2], v1[3]);
                        *(u32x4*)(Z + (size_t)row * NZ + col) = w;
                    }
                }
            }
    }
};
struct EpiMix {
    static constexpr bool PERM = true, AFTER_DRAIN = false;
    bf16_t* O; float* ssq;
    __device__ __forceinline__ void operator()(const f32x4 (&acc)[2][2][4][2], const Unit& u, int wr, int wc, int fr, int fq) const {
        const int row0 = u.pm * 256 + wr * 64 + fr, col0 = u.pn * 256 + wc * 32 + 8 * fq;
#pragma unroll
        for (int ai = 0; ai < 2; ++ai)
#pragma unroll
            for (int m = 0; m < 4; ++m) {
                const int row = row0 + ai * 128 + m * 16; float q = 0.f;
#pragma unroll
                for (int bj = 0; bj < 2; ++bj) {
                    const f32x4 v0 = acc[ai][bj][m][0], v1 = acc[ai][bj][m][1];
                    q += (v0[0] * v0[0] + v0[1] * v0[1]) + (v0[2] * v0[2] + v0[3] * v0[3]) + (v1[0] * v1[0] + v1[1] * v1[1]) + (v1[2] * v1[2] + v1[3] * v1[3]);
                    u32x4 w; w.x = pg8::cvt_pk_bf16(v0[0], v0[1]); w.y = pg8::cvt_pk_bf16(v0[2], v0[3]); w.z = pg8::cvt_pk_bf16(v1[0], v1[1]); w.w = pg8::cvt_pk_bf16(v1[2], v1[3]);
                    *(u32x4*)(O + (size_t)row * 1024 + col0 + bj * 128) = w;
                }
                q += __shfl_xor(q, 16); q += __shfl_xor(q, 32);
                if (fq == 0) ssq[(size_t)row * 16 + u.pn * 4 + wc] = q;
            }
    }
};
struct EpiPlain {
    static constexpr bool PERM = true, AFTER_DRAIN = false;
    bf16_t* O;
    __device__ __forceinline__ void operator()(const f32x4 (&acc)[2][2][4][2], const Unit& u, int wr, int wc, int fr, int fq) const {
        const int row0 = u.pm * 256 + wr * 64 + fr, col0 = u.pn * 256 + wc * 32 + 8 * fq;
#pragma unroll
        for (int ai = 0; ai < 2; ++ai)
#pragma unroll
            for (int m = 0; m < 4; ++m) {
                const int row = row0 + ai * 128 + m * 16;
#pragma unroll
                for (int bj = 0; bj < 2; ++bj) {
                    const f32x4 v0 = acc[ai][bj][m][0], v1 = acc[ai][bj][m][1];
                    u32x4 w; w.x = pg8::cvt_pk_bf16(v0[0], v0[1]); w.y = pg8::cvt_pk_bf16(v0[2], v0[3]); w.z = pg8::cvt_pk_bf16(v1[0], v1[1]); w.w = pg8::cvt_pk_bf16(v1[2], v1[3]);
                    *(u32x4*)(O + (size_t)row * 1024 + col0 + bj * 128) = w;
                }
            }
    }
};
struct EpiOut {
    static constexpr bool PERM = true, AFTER_DRAIN = false;
    float* X; const bf16_t* PP; bf16_t* XB; float* ssq; const float* bias;
    __device__ __forceinline__ void operator()(const f32x4 (&acc)[2][2][4][2], const Unit& u, int wr, int wc, int fr, int fq) const {
        const int row0 = u.pm * 256 + wr * 64 + fr, col0 = u.pn * 256 + wc * 32 + 8 * fq;
        f32x4 bv[2][2];
#pragma unroll
        for (int bj = 0; bj < 2; ++bj)
#pragma unroll
            for (int n = 0; n < 2; ++n) bv[bj][n] = *(const f32x4*)(bias + col0 + bj * 128 + 4 * n);
#pragma unroll
        for (int ai = 0; ai < 2; ++ai)
#pragma unroll
            for (int m = 0; m < 4; ++m) {
                const int row = row0 + ai * 128 + m * 16; float q = 0.f;
#pragma unroll
                for (int bj = 0; bj < 2; ++bj) {
                    const size_t off = (size_t)row * 1024 + col0 + bj * 128;
                    const f32x4 g0 = acc[ai][bj][m][0] + bv[bj][0], g1 = acc[ai][bj][m][1] + bv[bj][1];
                    const f32x4 x0 = *(const f32x4*)(X + off), x1 = *(const f32x4*)(X + off + 4);
                    const u32x4 pw = *(const u32x4*)(PP + off); float pp[8]; unpack8(pw, pp);
                    f32x4 o0, o1;
#pragma unroll
                    for (int j = 0; j < 4; ++j) { o0[j] = x0[j] + pp[j] * sigmoidf_(g0[j]); o1[j] = x1[j] + pp[4 + j] * sigmoidf_(g1[j]); }
                    *(f32x4*)(X + off) = o0; *(f32x4*)(X + off + 4) = o1;
                    u32x4 w; w.x = pg8::cvt_pk_bf16(o0[0], o0[1]); w.y = pg8::cvt_pk_bf16(o0[2], o0[3]); w.z = pg8::cvt_pk_bf16(o1[0], o1[1]); w.w = pg8::cvt_pk_bf16(o1[2], o1[3]);
                    *(u32x4*)(XB + off) = w;
                    q += (o0[0] * o0[0] + o0[1] * o0[1]) + (o0[2] * o0[2] + o0[3] * o0[3]) + (o1[0] * o1[0] + o1[1] * o1[1]) + (o1[2] * o1[2] + o1[3] * o1[3]);
                }
                q += __shfl_xor(q, 16); q += __shfl_xor(q, 32);
                if (fq == 0) ssq[(size_t)row * 16 + u.pn * 4 + wc] = q;
            }
    }
};

__device__ __forceinline__ void transpose_item(const float* W, int K, int N, int k0, int nsrc0, bf16_t* WT, int ndst0, const float* g, float* scr, int lane) {
#pragma unroll 8
    for (int i = 0; i < 32; ++i) {
        const int kk = 2 * i + (lane >> 5);
        float v = 0.f;
        if (nsrc0 >= 0) { v = W[(size_t)(k0 + kk) * N + nsrc0 + (lane & 31)]; if (g) v *= g[k0 + kk]; }
        scr[kk * 33 + (lane & 31)] = v;
    }
    __builtin_amdgcn_s_waitcnt(0xC07F); asm volatile("" ::: "memory");
    const int c = lane & 7;
#pragma unroll
    for (int j = 0; j < 4; ++j) {
        const int n = (lane >> 3) + 8 * j; const float* s = scr + (8 * c) * 33 + n;
        u32x4 o; o.x = pk2(s[0 * 33], s[1 * 33]); o.y = pk2(s[2 * 33], s[3 * 33]); o.z = pk2(s[4 * 33], s[5 * 33]); o.w = pk2(s[6 * 33], s[7 * 33]);
        *(u32x4*)(WT + (size_t)(ndst0 + n) * K + k0 + 8 * c) = o;
    }
    __builtin_amdgcn_s_waitcnt(0xC07F); asm volatile("" ::: "memory");
}
__device__ __forceinline__ void phase_prologue(const Args& a, float* ldsf, int wave, int lane) {
    float* scr = ldsf + wave * (64 * 33);
    const int gw = blockIdx.x * 8 + wave, NGW = gridDim.x * 8;
    constexpr int I_IN = 16 * (NZP / 32), I_SQ = 16 * 32, I_PL = 4 * 32, I_LAYER = I_IN + 2 * I_SQ + I_PL;
    for (int it = gw; it < L_ * I_LAYER; it += NGW) {
        const int l = it / I_LAYER; int r = it % I_LAYER;
        if (r < I_IN) {
            const int nblk = NZP / 32, kb = r / nblk, nb = r % nblk, n0 = nb * 32;
            const int src = n0 < 3072 ? n0 : (n0 < 3584 ? n0 + 128 : (n0 < 3712 ? n0 - 512 : -1));
            transpose_item(a.in[I_WIN] + (size_t)l * 1024 * NZ, 1024, NZ, kb * 64, src, (bf16_t*)(a.ws + WS_WIN) + (size_t)l * NZP * 1024, n0, a.in[I_PREG] + l * 1024, scr, lane);
            continue;
        }
        r -= I_IN;
        if (r < I_SQ) { transpose_item(a.in[I_WOUT] + (size_t)l * 1024 * 1024, 1024, 1024, (r / 32) * 64, (r % 32) * 32, (bf16_t*)(a.ws + WS_WOUT) + (size_t)l * 1024 * 1024, (r % 32) * 32, nullptr, scr, lane); continue; }
        r -= I_SQ;
        if (r < I_SQ) { transpose_item(a.in[I_GW] + (size_t)l * 1024 * 1024, 1024, 1024, (r / 32) * 64, (r % 32) * 32, (bf16_t*)(a.ws + WS_WG) + (size_t)l * 1024 * 1024, (r % 32) * 32, nullptr, scr, lane); continue; }
        r -= I_SQ;
        transpose_item(a.in[I_PLEW] + (size_t)l * 256 * 1024, 256, 1024, (r / 32) * 64, (r % 32) * 32, (bf16_t*)(a.ws + WS_WP) + (size_t)l * 1024 * 256, (r % 32) * 32, nullptr, scr, lane);
    }
    const float* x = a.in[I_X]; bf16_t* XB = (bf16_t*)(a.ws + WS_RB); float* ssq = (float*)(a.ws + WS_SSQ1);
    for (int m = gw; m < M_; m += NGW) {
        float q = 0.f;
#pragma unroll
        for (int h = 0; h < 2; ++h) {
            const size_t off = (size_t)m * 1024 + h * 512 + lane * 8;
            const f32x4 x0 = *(const f32x4*)(x + off), x1 = *(const f32x4*)(x + off + 4);
            q += (x0[0] * x0[0] + x0[1] * x0[1]) + (x0[2] * x0[2] + x0[3] * x0[3]) + (x1[0] * x1[0] + x1[1] * x1[1]) + (x1[2] * x1[2] + x1[3] * x1[3]);
            u32x4 w; w.x = pk2(x0[0], x0[1]); w.y = pk2(x0[2], x0[3]); w.z = pk2(x1[0], x1[1]); w.w = pk2(x1[2], x1[3]);
            *(u32x4*)(XB + off) = w;
        }
        q = wave_sum(q);
        if (lane < 16) ssq[(size_t)m * 16 + lane] = lane == 0 ? q : 0.f;
    }
}

__device__ __forceinline__ void sgu_item(const Args& a, int l, int nb, int h, float* ldsf, int tid_in, int wave, int lane_in) {
    int tid = tid_in, lane = lane_in; asm volatile("" : "+v"(tid), "+v"(lane));
    const bf16_t* Z = (const bf16_t*)(a.ws + WS_Z); bf16_t* CAT = (bf16_t*)(a.ws + WS_RA);
    float* mean = ldsf; float* rstd = ldsf + 128; float* vn = ldsf + 256;
    for (int tt = 0; tt < 16; ++tt) {
        const int j = wave * 16 + tt; const size_t tok = (size_t)nb * 128 + j;
        const u32x2 w = *(const u32x2*)(Z + tok * NZ + ZC_V + lane * 4); float v[4]; unpack4(w, v);
        const float mu = wave_sum((v[0] + v[1]) + (v[2] + v[3])) * (1.0f / 256.0f);
        const float d0 = v[0] - mu, d1 = v[1] - mu, d2 = v[2] - mu, d3 = v[3] - mu;
        const float var = wave_sum((d0 * d0 + d1 * d1) + (d2 * d2 + d3 * d3)) * (1.0f / 256.0f);
        if (lane == 0) { mean[j] = mu; rstd[j] = rsqrtf(var + LN_EPS); }
    }
    __syncthreads();
    {
        const int j = tid >> 2, dq = tid & 3; const size_t tok = (size_t)nb * 128 + j;
        const float mu = mean[j], rs = rstd[j];
        const float* g = a.in[I_SLNG] + l * 256 + h * 64 + dq * 16; const float* b = a.in[I_SLNB] + l * 256 + h * 64 + dq * 16;
#pragma unroll
        for (int hh = 0; hh < 2; ++hh) {
            const u32x4 w = *(const u32x4*)(Z + tok * NZ + ZC_V + h * 64 + dq * 16 + hh * 8); float v[8]; unpack8(w, v);
#pragma unroll
            for (int e = 0; e < 8; ++e) vn[j * 64 + dq * 16 + hh * 8 + e] = (v[e] - mu) * rs * g[hh * 8 + e] + b[hh * 8 + e];
        }
    }
    __syncthreads();
    {
        const int i = tid >> 2, dq = tid & 3; const size_t tok = (size_t)nb * 128 + i;
        const float* wrow = a.in[I_SGUW] + (((size_t)l * 4 + h) * 128 + i) * 128;
        float acc[16];
#pragma unroll
        for (int e = 0; e < 16; ++e) acc[e] = 0.f;
        const int jmax = i < 64 ? 64 : 128;
#pragma unroll 1
        for (int j4 = 0; j4 < jmax; j4 += 4) {
            const f32x4 w4 = *(const f32x4*)(wrow + j4);
#pragma unroll
            for (int jj = 0; jj < 4; ++jj) {
                const float w = w4[jj]; const f32x4* vp = (const f32x4*)(vn + (j4 + jj) * 64 + dq * 16);
#pragma unroll
                for (int e4 = 0; e4 < 4; ++e4) { const f32x4 vv = vp[e4]; acc[e4 * 4 + 0] += w * vv[0]; acc[e4 * 4 + 1] += w * vv[1]; acc[e4 * 4 + 2] += w * vv[2]; acc[e4 * 4 + 3] += w * vv[3]; }
            }
        }
        const float bs = a.in[I_SGUB][((size_t)l * 4 + h) * 128 + i];
        const int c = h * 64 + dq * 16;
#pragma unroll
        for (int hh = 0; hh < 2; ++hh) {
            const u32x4 uw = *(const u32x4*)(Z + tok * NZ + ZC_U + c + hh * 8), gw = *(const u32x4*)(Z + tok * NZ + ZC_GA + c + hh * 8);
            float uu[8], gg[8]; unpack8(uw, uu); unpack8(gw, gg); float o[8];
#pragma unroll
            for (int e = 0; e < 8; ++e) o[e] = uu[e] * (acc[hh * 8 + e] + bs) * siluf_(gg[e]);
            u32x4 w; w.x = pk2(o[0], o[1]); w.y = pk2(o[2], o[3]); w.z = pk2(o[4], o[5]); w.w = pk2(o[6], o[7]);
            *(u32x4*)(CAT + tok * 1024 + c + hh * 8) = w;
        }
    }
    __syncthreads();
}

__device__ __forceinline__ void convlora_item(const Args& a, int l, int ti, float* ldsf, int tid_in, int wave, int lane_in) {
    int tid = tid_in, lane = lane_in; asm volatile("" : "+v"(tid), "+v"(lane));
    const bf16_t* Z = (const bf16_t*)(a.ws + WS_Z); bf16_t* CAT = (bf16_t*)(a.ws + WS_RA);
    float* ybuf = ldsf;
    float* cbuf = ldsf + 62 * 256;
    float* tw = cbuf + 32 * 256;
    float* ad = tw + 32 * 64;
    const int t0 = ti * 32, pos0 = t0 & (S_ - 1);
    {
        const int c4 = (tid & 63) * 4, rg = tid >> 6;
        for (int rr = rg; rr < 62; rr += 8) {
            float y[4] = {0.f, 0.f, 0.f, 0.f};
            if (pos0 - 30 + rr >= 0) {
                const size_t tok = (size_t)(t0 - 30 + rr);
                const u32x2 vw = *(const u32x2*)(Z + tok * NZ + ZC_VAL + c4), gw = *(const u32x2*)(Z + tok * NZ + ZC_GLU + c4);
                float v[4], g[4]; unpack4(vw, v); unpack4(gw, g);
#pragma unroll
                for (int e = 0; e < 4; ++e) y[e] = v[e] * sigmoidf_(g[e]);
            }
            *(f32x4*)(ybuf + rr * 256 + c4) = (f32x4){y[0], y[1], y[2], y[3]};
        }
    }
    {
        const float* mu = a.in[I_MU] + (size_t)l * 1664 + 1536;
        for (int e = tid; e < 32 * 128; e += 512) {
            const int t = e >> 7, j = e & 127; const size_t tok = (size_t)(t0 + t);
            const float zc = bf2f(Z[tok * NZ + ZC_WD + j]);
            const float zp = (pos0 + t) > 0 ? bf2f(Z[(tok - 1) * NZ + ZC_WD + j]) : 0.f;
            const float s = zc + mu[j] * (zp - zc);
            if (j < 64) tw[t * 64 + j] = tanhf(s); else ad[t * 64 + (j - 64)] = s;
        }
    }
    __syncthreads();
    {
        const int c = tid & 255, th = tid >> 8;
        float cw[31];
#pragma unroll
        for (int k = 0; k < 31; ++k) cw[k] = a.in[I_CW][((size_t)l * 31 + k) * 256 + c];
        const float cb = a.in[I_CB][l * 256 + c];
#pragma unroll 1
        for (int t = th * 16; t < th * 16 + 16; ++t) {
            float acc = cb;
#pragma unroll
            for (int k = 0; k < 31; ++k) acc += ybuf[(t + k) * 256 + c] * cw[k];
            cbuf[t * 256 + c] = acc;
        }
    }
    __syncthreads();
    for (int tt = 0; tt < 4; ++tt) {
        const int t = wave * 4 + tt;
        f32x4 v = *(const f32x4*)(cbuf + t * 256 + lane * 4);
        const float mu = wave_sum((v[0] + v[1]) + (v[2] + v[3])) * (1.0f / 256.0f);
        v = v - mu;
        const float var = wave_sum((v[0] * v[0] + v[1] * v[1]) + (v[2] * v[2] + v[3] * v[3])) * (1.0f / 256.0f);
        const float rs = rsqrtf(var + LN_EPS);
        const f32x4 g = *(const f32x4*)(a.in[I_CLNG] + l * 256 + lane * 4), b = *(const f32x4*)(a.in[I_CLNB] + l * 256 + lane * 4);
        f32x4 o;
#pragma unroll
        for (int e = 0; e < 4; ++e) o[e] = siluf_(v[e] * rs * g[e] + b[e]);
        *(f32x4*)(cbuf + t * 256 + lane * 4) = o;
    }
    __syncthreads();
    {
        const int c = tid & 255, th = tid >> 8;
        float acc[16]; const float pb = a.in[I_PWB][l * 256 + c];
#pragma unroll
        for (int t = 0; t < 16; ++t) acc[t] = pb;
        const float* pw = a.in[I_PWW] + (size_t)l * 256 * 256 + c;
#pragma unroll 1
        for (int k4 = 0; k4 < 256; k4 += 4) {
            const float w0 = pw[(k4 + 0) * 256], w1 = pw[(k4 + 1) * 256], w2 = pw[(k4 + 2) * 256], w3 = pw[(k4 + 3) * 256];
#pragma unroll
            for (int t = 0; t < 16; ++t) { const f32x4 x = *(const f32x4*)(cbuf + (th * 16 + t) * 256 + k4); acc[t] += (x[0] * w0 + x[1] * w1) + (x[2] * w2 + x[3] * w3); }
        }
#pragma unroll
        for (int t = 0; t < 16; ++t) {
            const size_t tok = (size_t)(t0 + th * 16 + t);
            const float g = bf2f(Z[tok * NZ + ZC_GB + c]);
            CAT[tok * 1024 + 256 + c] = (bf16_t)f2bf(acc[t] * siluf_(g));
        }
    }
    asm volatile("" ::: "memory");
    {
        const int c = tid; unsigned short* Wq = (unsigned short*)(a.ws + WS_WQ); bf16_t* Aq = (bf16_t*)(a.ws + WS_AQ);
        {
            float wr[64];
#pragma unroll
            for (int j = 0; j < 64; ++j) wr[j] = a.in[I_WUP][((size_t)l * 64 + j) * 512 + c];
            const float w0 = a.in[I_W0][l * 512 + c];
#pragma unroll 1
            for (int t = 0; t < 32; ++t) {
                float d = w0;
#pragma unroll
                for (int j4 = 0; j4 < 64; j4 += 4) { const f32x4 x = *(const f32x4*)(tw + t * 64 + j4); d += (x[0] * wr[j4] + x[1] * wr[j4 + 1]) + (x[2] * wr[j4 + 2] + x[3] * wr[j4 + 3]); }
                const float w = __expf(-DECAY_SCALE * sigmoidf_(d));
                float q = rintf((1.0f - w) * 131072.0f); q = fminf(fmaxf(q, 0.f), 65535.f);
                Wq[(size_t)(t0 + t) * 512 + c] = (unsigned short)q;
            }
        }
        asm volatile("" ::: "memory");
        {
            float wr[64];
#pragma unroll
            for (int j = 0; j < 64; ++j) wr[j] = a.in[I_AUP][((size_t)l * 64 + j) * 512 + c];
            const float a0 = a.in[I_A0][l * 512 + c];
#pragma unroll 1
            for (int t = 0; t < 32; ++t) {
                float d = a0;
#pragma unroll
                for (int j4 = 0; j4 < 64; j4 += 4) { const f32x4 x = *(const f32x4*)(ad + t * 64 + j4); d += (x[0] * wr[j4] + x[1] * wr[j4 + 1]) + (x[2] * wr[j4 + 2] + x[3] * wr[j4 + 3]); }
                Aq[(size_t)(t0 + t) * 512 + c] = (bf16_t)f2bf(sigmoidf_(d));
            }
        }
    }
    {
        const float* p = a.in[I_P] + ((size_t)l * M_ + t0) * 256; bf16_t* PB = (bf16_t*)(a.ws + WS_PB) + (size_t)t0 * 256;
        const int e0 = tid * 16;
#pragma unroll
        for (int h = 0; h < 2; ++h) {
            const f32x4 x0 = *(const f32x4*)(p + e0 + h * 8), x1 = *(const f32x4*)(p + e0 + h * 8 + 4);
            u32x4 w; w.x = pk2(x0[0], x0[1]); w.y = pk2(x0[2], x0[3]); w.z = pk2(x1[0], x1[1]); w.w = pk2(x1[2], x1[3]);
            *(u32x4*)(PB + e0 + h * 8) = w;
        }
    }
    __syncthreads();
}

__device__ __forceinline__ void scan_simple(const Args& a, int l, int bh, float* lw, int lane) {
    const bf16_t* Z = (const bf16_t*)(a.ws + WS_Z); bf16_t* CAT = (bf16_t*)(a.ws + WS_RA);
    const unsigned short* Wq = (const unsigned short*)(a.ws + WS_WQ); const bf16_t* Aq = (const bf16_t*)(a.ws + WS_AQ);
    const int b = bh >> 3, h = bh & 7, hc = h * 64 + lane;
    float* LA = lw; float* LB = lw + 64; float* LW = lw + 128; float* LK = lw + 192; float* LR = lw + 256;
    const float mu_r = a.in[I_MU][(size_t)l * 1664 + hc], mu_k = a.in[I_MU][(size_t)l * 1664 + 512 + hc], mu_v = a.in[I_MU][(size_t)l * 1664 + 1024 + hc];
    const float k_k = a.in[I_KK][l * 512 + hc], k_a = a.in[I_KA][l * 512 + hc], r_k = a.in[I_RK][l * 512 + hc];
    const float gng = a.in[I_LXG][l * 512 + hc], gnb = a.in[I_LXB][l * 512 + hc];
    float s[64];
#pragma unroll
    for (int j = 0; j < 64; ++j) s[j] = 0.f;
    float pr = 0.f, pk = 0.f, pv = 0.f;
    size_t tok = (size_t)b * S_;
    unsigned nzr = Z[tok * NZ + ZC_R + hc], nzk = Z[tok * NZ + ZC_K + hc], nzv = Z[tok * NZ + ZC_VV + hc], nzg = Z[tok * NZ + ZC_GC + hc], nqa = Aq[tok * 512 + hc], nqw = Wq[tok * 512 + hc];
#pragma unroll 1
    for (int t = 0; t < S_; ++t, ++tok) {
        const float zr = bf2f(nzr), zk = bf2f(nzk), zv = bf2f(nzv), zg = bf2f(nzg), alpha = bf2f(nqa), w = 1.0f - (float)nqw * (1.0f / 131072.0f);
        if (t + 1 < S_) { const size_t tn = tok + 1; nzr = Z[tn * NZ + ZC_R + hc]; nzk = Z[tn * NZ + ZC_K + hc]; nzv = Z[tn * NZ + ZC_VV + hc]; nzg = Z[tn * NZ + ZC_GC + hc]; nqa = Aq[tn * 512 + hc]; nqw = Wq[tn * 512 + hc]; }
        const float r = zr + mu_r * (pr - zr), k = zk + mu_k * (pk - zk), v = zv + mu_v * (pv - zv);
        pr = zr; pk = zk; pv = zv;
        const float kkr = k * k_k; const float ss = wave_sum(kkr * kkr);
        const float kk = kkr * rsqrtf(fmaxf(ss, 1e-12f));
        const float kp = k * (1.0f + (alpha - 1.0f) * k_a);
        const float bonus = wave_sum(r * kp * r_k);
        LA[lane] = -kk; LB[lane] = kk * alpha; LW[lane] = w; LK[lane] = kp; LR[lane] = r;
        __builtin_amdgcn_s_waitcnt(0xC07F); asm volatile("" ::: "memory");
        float sa = 0.f;
#pragma unroll
        for (int j4 = 0; j4 < 16; ++j4) { const f32x4 x = ((const f32x4*)LA)[j4]; sa += (s[4 * j4] * x[0] + s[4 * j4 + 1] * x[1]) + (s[4 * j4 + 2] * x[2] + s[4 * j4 + 3] * x[3]); if ((j4 & 3) == 3) asm volatile("" ::: "memory"); }
        float y = 0.f;
#pragma unroll
        for (int j4 = 0; j4 < 16; ++j4) {
            const f32x4 xb = ((const f32x4*)LB)[j4], xw = ((const f32x4*)LW)[j4], xk = ((const f32x4*)LK)[j4], xr = ((const f32x4*)LR)[j4];
#pragma unroll
            for (int e = 0; e < 4; ++e) { const float sn = s[4 * j4 + e] * xw[e] + (sa * xb[e] + v * xk[e]); s[4 * j4 + e] = sn; y += sn * xr[e]; }
            asm volatile("" ::: "memory");
        }
        asm volatile("" ::: "memory");
        const float mean = wave_sum(y) * (1.0f / 64.0f); const float d = y - mean;
        const float var = wave_sum(d * d) * (1.0f / 64.0f);
        float o = d * rsqrtf(var + GN_EPS) * gng + gnb + bonus * v;
        o *= siluf_(zg);
        CAT[tok * 1024 + 512 + hc] = (bf16_t)f2bf(o);
    }
}

__device__ __forceinline__ void phase_xnew(const Args& a, int l, int wave, int lane) {
    const int gw = blockIdx.x * 8 + wave, NGW = gridDim.x * 8;
    const float* xin = l == 0 ? a.in[I_X] : a.out; float* xout = a.out;
    const bf16_t* MIX = (const bf16_t*)(a.ws + WS_RB); bf16_t* XNB = (bf16_t*)(a.ws + WS_RA); const float* ssq = (const float*)(a.ws + WS_SSQ2);
    const float* g = a.in[I_POSTG] + l * 1024;
    for (int m = gw; m < M_; m += NGW) {
        const f32x4* sp = (const f32x4*)(ssq + (size_t)m * 16);
        const f32x4 s0 = sp[0], s1 = sp[1], s2 = sp[2], s3 = sp[3];
        const float t = ((s0[0] + s0[1]) + (s0[2] + s0[3])) + ((s1[0] + s1[1]) + (s1[2] + s1[3])) + ((s2[0] + s2[1]) + (s2[2] + s2[3])) + ((s3[0] + s3[1]) + (s3[2] + s3[3]));
        const float rstd = rsqrtf(t * (1.0f / 1024.0f) + RMS_EPS);
#pragma unroll
        for (int h = 0; h < 2; ++h) {
            const int col = h * 512 + lane * 8; const size_t off = (size_t)m * 1024 + col;
            const u32x4 mw = *(const u32x4*)(MIX + off); float mx[8]; unpack8(mw, mx);
            const f32x4 x0 = *(const f32x4*)(xin + off), x1 = *(const f32x4*)(xin + off + 4), g0 = *(const f32x4*)(g + col), g1 = *(const f32x4*)(g + col + 4);
            f32x4 o0, o1;
#pragma unroll
            for (int j = 0; j < 4; ++j) { o0[j] = x0[j] + mx[j] * rstd * g0[j]; o1[j] = x1[j] + mx[4 + j] * rstd * g1[j]; }
            *(f32x4*)(xout + off) = o0; *(f32x4*)(xout + off + 4) = o1;
            u32x4 w; w.x = pk2(o0[0], o0[1]); w.y = pk2(o0[2], o0[3]); w.z = pk2(o1[0], o1[1]); w.w = pk2(o1[2], o1[3]);
            *(u32x4*)(XNB + off) = w;
        }
    }
}

#ifndef MK_ONE_LAUNCH
#define MK_ONE_LAUNCH 0
#endif
constexpr int N_PHASES = 1 + 6 * L_;
template <int KMASK>
__global__ void __launch_bounds__(512, 2) fwd_kernel(Args a) {
    extern __shared__ __attribute__((aligned(16))) unsigned char shm[];
    float* ldsf = (float*)shm;
    const int tid = threadIdx.x, wave = __builtin_amdgcn_readfirstlane(tid >> 6), lane = tid & 63;
#if MK_ONE_LAUNCH
    cg::grid_group grid = cg::this_grid();
#define GRID_BAR() grid.sync()
#else
#define GRID_BAR() do { } while (0)
#endif
    for (int ph = a.ph_lo; ph < a.ph_hi; ++ph) {
        if (ph == 0) { if constexpr ((KMASK >> 6) & 1) phase_prologue(a, ldsf, wave, lane); }
        else {
            const int l = (ph - 1) / 6, sp = (ph - 1) % 6;
            if (sp == 0) {
                if constexpr ((KMASK >> 0) & 1) {
                pg8::Gemm g{(const bf16_t*)(a.ws + WS_RB), (const bf16_t*)(a.ws + WS_WIN) + (size_t)l * NZP * 1024, M_, NZP, 1024};
                pg8::StaticOrder S; S.init(M_, NZP, (int)gridDim.x, (int)blockIdx.x);
                EpiZ E{(bf16_t*)(a.ws + WS_Z), (const float*)(a.ws + WS_SSQ1)};
                pg8::gemm_phase<EpiZ, pg8::StaticOrder, false>((PG8_LAS unsigned char*)shm, g, S, E, nullptr);
                }
            } else if (sp == 1) {
                if constexpr ((KMASK >> 1) & 1) {
                for (int it = blockIdx.x; it < 1024; it += gridDim.x) sgu_item(a, l, it >> 2, it & 3, ldsf, tid, wave, lane);
                for (int it = blockIdx.x; it < 1024; it += gridDim.x) convlora_item(a, l, it, ldsf, tid, wave, lane);
                }
            } else if (sp == 2) {
                if constexpr ((KMASK >> 2) & 1) {
                if (wave == 0) for (int bh = blockIdx.x; bh < 64; bh += gridDim.x) scan_simple(a, l, bh, ldsf, lane);
                }
            } else if (sp == 3) {
                if constexpr ((KMASK >> 3) & 1) {
                {
                    pg8::Gemm g{(const bf16_t*)(a.ws + WS_RA), (const bf16_t*)(a.ws + WS_WOUT) + (size_t)l * 1024 * 1024, M_, 1024, 1024};
                    pg8::StaticOrder S; S.init(M_, 1024, (int)gridDim.x, (int)blockIdx.x);
                    EpiMix E{(bf16_t*)(a.ws + WS_RB), (float*)(a.ws + WS_SSQ2)};
                    pg8::gemm_phase<EpiMix, pg8::StaticOrder, false>((PG8_LAS unsigned char*)shm, g, S, E, nullptr);
                }
                {
                    pg8::Gemm g{(const bf16_t*)(a.ws + WS_PB), (const bf16_t*)(a.ws + WS_WP) + (size_t)l * 1024 * 256, M_, 1024, 256};
                    pg8::StaticOrder S; S.init(M_, 1024, (int)gridDim.x, (int)blockIdx.x);
                    EpiPlain E{(bf16_t*)(a.ws + WS_PP)};
                    pg8::gemm_phase<EpiPlain, pg8::StaticOrder, false>((PG8_LAS unsigned char*)shm, g, S, E, nullptr);
                }
                }
            } else if (sp == 4) {
                if constexpr ((KMASK >> 4) & 1) phase_xnew(a, l, wave, lane);
            } else {
                if constexpr ((KMASK >> 5) & 1) {
                pg8::Gemm g{(const bf16_t*)(a.ws + WS_RA), (const bf16_t*)(a.ws + WS_WG) + (size_t)l * 1024 * 1024, M_, 1024, 1024};
                pg8::StaticOrder S; S.init(M_, 1024, (int)gridDim.x, (int)blockIdx.x);
                EpiOut E{a.out, (const bf16_t*)(a.ws + WS_PP), (bf16_t*)(a.ws + WS_RB), (float*)(a.ws + WS_SSQ1), a.in[I_GB] + l * 1024};
                pg8::gemm_phase<EpiOut, pg8::StaticOrder, false>((PG8_LAS unsigned char*)shm, g, S, E, nullptr);
                }
            }
        }
        if (ph + 1 < a.ph_hi) GRID_BAR();
    }
}

template <int KMASK> static bool prep_kernel(int lds_bytes) {
    return hipFuncSetAttribute((const void*)fwd_kernel<KMASK>, hipFuncAttributeMaxDynamicSharedMemorySize, lds_bytes) == hipSuccess;
}

extern "C" void kernel_launch(void* const* d_in, const int* in_sizes, int n_in, void* d_out, int out_size, void* d_ws, size_t ws_size, hipStream_t stream) {
    static int grid = 0;
    constexpr int LDS_BYTES = pg8::STAGE_BYTES;
    if (grid == 0) {
        if (n_in != N_IN || out_size != M_ * D_ || ws_size < WS_END) { fprintf(stderr, "kernel_launch: unexpected shapes (n_in %d, out %d, ws %zu < %zu)\n", n_in, out_size, ws_size, (size_t)WS_END); grid = -1; return; }
        int dev = 0, cus = 0;
        (void)hipGetDevice(&dev); (void)hipDeviceGetAttribute(&cus, hipDeviceAttributeMultiprocessorCount, dev);
#if MK_ONE_LAUNCH
        bool ok = prep_kernel<127>(LDS_BYTES);
        int per_cu = 0;
        (void)hipOccupancyMaxActiveBlocksPerMultiprocessor(&per_cu, (const void*)fwd_kernel<127>, 512, LDS_BYTES);
        (void)hipGetLastError();
        if (per_cu < 1) { fprintf(stderr, "kernel_launch: occupancy query says %d blocks per CU\n", per_cu); ok = false; }
#else
        bool ok = prep_kernel<1>(LDS_BYTES) && prep_kernel<2>(LDS_BYTES) && prep_kernel<4>(LDS_BYTES) && prep_kernel<8>(LDS_BYTES) && prep_kernel<16>(LDS_BYTES) && prep_kernel<32>(LDS_BYTES) && prep_kernel<64>(LDS_BYTES);
#endif
        if (!ok) { fprintf(stderr, "kernel_launch: kernel set-up failed\n"); grid = -1; return; }
        grid = cus;
    }
    if (grid < 0) return;
    Args a{};
    for (int i = 0; i < N_IN; ++i) a.in[i] = (const float*)d_in[i];
    a.out = (float*)d_out; a.ws = (unsigned char*)d_ws;
#if MK_ONE_LAUNCH
    a.ph_lo = 0; a.ph_hi = N_PHASES;
    void* args[] = {&a};
    hipError_t e = hipLaunchCooperativeKernel((const void*)fwd_kernel<127>, dim3(grid), dim3(512), args, LDS_BYTES, stream);
    if (e != hipSuccess) fprintf(stderr, "cooperative launch failed: %s (grid %d)\n", hipGetErrorString(e), grid);
#else
    for (int ph = 0; ph < N_PHASES; ++ph) {
        a.ph_lo = ph; a.ph_hi = ph + 1;
        const int sp = ph == 0 ? 6 : (ph - 1) % 6;
        switch (sp) {
            case 0: hipLaunchKernelGGL(fwd_kernel<1>, dim3(grid), dim3(512), LDS_BYTES, stream, a); break;
            case 1: hipLaunchKernelGGL(fwd_kernel<2>, dim3(grid), dim3(512), LDS_BYTES, stream, a); break;
            case 2: hipLaunchKernelGGL(fwd_kernel<4>, dim3(grid), dim3(512), LDS_BYTES, stream, a); break;
            case 3: hipLaunchKernelGGL(fwd_kernel<8>, dim3(grid), dim3(512), LDS_BYTES, stream, a); break;
            case 4: hipLaunchKernelGGL(fwd_kernel<16>, dim3(grid), dim3(512), LDS_BYTES, stream, a); break;
            case 5: hipLaunchKernelGGL(fwd_kernel<32>, dim3(grid), dim3(512), LDS_BYTES, stream, a); break;
            default: hipLaunchKernelGGL(fwd_kernel<64>, dim3(grid), dim3(512), LDS_BYTES, stream, a); break;
        }
    }
#endif
}
```

```cpp
#include <hip/hip_runtime.h>
#include <hip/hip_cooperative_groups.h>
#include <cstdio>
namespace cg = cooperative_groups;
namespace pg8 {
#define PG8_LAS __attribute__((address_space(3)))
typedef unsigned short bf16_t;
typedef short bf16x8 __attribute__((ext_vector_type(8)));
typedef float f32x4 __attribute__((ext_vector_type(4)));
typedef unsigned u32x4 __attribute__((ext_vector_type(4)));
constexpr int BM = 256, BK = 64, HALF = 128, HTB = HALF * BK * 2  , STAGE_BYTES = 8 * HTB, NXCD = 8, WGM = 8;

__host__ __device__ __forceinline__ int lds_byte(int r, int c) { const int st = (r >> 4) * 2 + (c >> 5), rr = r & 15, cc = c & 31, ob = rr * 64 + cc * 2; return st * 1024 + (ob ^ (((ob >> 9) & 1) << 5)); }
__host__ __device__ __forceinline__ void stage_rc(int b, int& R, int& C) { const int st = b / 1024, sb = b % 1024, swz = sb ^ (((sb >> 9) & 1) << 5); R = (st >> 1) * 16 + swz / 64; C = (st & 1) * 32 + (swz % 64) / 2; }
__host__ __device__ __forceinline__ int perm32(int rho) { const int n = rho >> 4, i = rho & 15; return 8 * (i >> 2) + 4 * n + (i & 3); }

struct Unit { int pm, pn; };
struct Gemm { const bf16_t* A; const bf16_t* Bt; int M, N, K; };

struct StaticOrder {
    int nM, nN, nwg, G, c;
    __host__ __device__ void init(int M, int N, int G_, int c_) { nM = M / BM; nN = N / BM; nwg = nM * nN; G = G_; c = c_; }
    __host__ __device__ bool next(int i, Unit& u) const {
        const long L = (long)i * G + c; if (L >= nwg) return false;
        int wgid = (int)L; { const int q = nwg / NXCD, r = nwg % NXCD, xcd = wgid % NXCD, off = wgid / NXCD; wgid = (xcd < r ? xcd * (q + 1) : r * (q + 1) + (xcd - r) * q) + off; }
        const int nig = WGM * nN, gid = wgid / nig, fm = gid * WGM, gsz = (nM - fm) < WGM ? (nM - fm) : WGM;
        u.pm = fm + ((wgid % nig) % gsz); u.pn = (wgid % nig) / gsz; return true;
    }
    __device__ __forceinline__ void a_ready(const Unit&) const {}
    __device__ __forceinline__ void done(const Unit&) const {}
};
typedef __bf16 bf16x2_t __attribute__((ext_vector_type(2)));
__device__ __forceinline__ unsigned cvt_pk_bf16(float lo, float hi) { typedef float f32x2_t __attribute__((ext_vector_type(2))); return __builtin_bit_cast(unsigned, __builtin_convertvector((f32x2_t){lo, hi}, bf16x2_t)); }
typedef float f32x2 __attribute__((ext_vector_type(2)));
template <class Epi, class Sched, bool STAMP = false>
__device__ __forceinline__ void gemm_phase(PG8_LAS unsigned char* lds, const Gemm g, const Sched& S, const Epi& E, unsigned long long* stamps) {
    int tid_ = threadIdx.x; asm volatile("" : "+v"(tid_));
    const int tid = tid_, wid = __builtin_amdgcn_readfirstlane(tid >> 6), lane = tid & 63, wr = wid >> 2, wc = wid & 3, fr = lane & 15, fq = lane >> 4;
    const int K = g.K, nt = K / BK;
    int ts_lo = 0, ts_hi = 0, nts = 0; const unsigned long long rt_entry = STAMP ? (unsigned long long)wall_clock64() : 0ull;
#define PG8_STAMP() do { if (STAMP && wid == 0 && nts < 64) { const unsigned long long _c = (unsigned long long)clock64(); \
        ts_lo = (lane == nts) ? (int)(unsigned)_c : ts_lo; ts_hi = (lane == nts) ? (int)(unsigned)(_c >> 32) : ts_hi; ++nts; } } while (0)
    PG8_STAMP();
    unsigned voffA[2], voffB[2];
#pragma unroll
    for (int i = 0; i < 2; ++i) { int R, C; stage_rc(tid * 16 + i * 8192, R, C); const int Rb = Epi::PERM ? ((R & ~31) + perm32(R & 31)) : R;
        voffA[i] = (unsigned)(R * K + C) * 2u; voffB[i] = (unsigned)(Rb * K + C) * 2u; }
    const size_t kstep = (size_t)(BK * 2);
    const size_t hstep = (size_t)HALF * K * 2;
    const size_t tstep = 2 * hstep;
    const unsigned ldsw = (unsigned)wid * 1024u;
    const int aoff = lds_byte(wr * 64 + fr, fq * 8), boff = lds_byte(wc * 32 + fr, fq * 8);
#define PG8_SA(b, h) (((b) * 2 + (h)) * HTB)
#define PG8_SB(b, h) ((4 + (b) * 2 + (h)) * HTB)
#define PG8_STAGE(bufoff, gbase, voff) do { _Pragma("unroll") for (int _i = 0; _i < 2; ++_i) \
        __builtin_amdgcn_global_load_lds((const unsigned*)((const char*)(gbase) + (voff)[_i]), (PG8_LAS unsigned*)(lds + (bufoff) + ldsw + _i * 8192), 16, 0, 0); } while (0)
#define PG8_LDA(dst, b, h) do { _Pragma("unroll") for (int m = 0; m < 4; ++m) _Pragma("unroll") for (int k = 0; k < 2; ++k) dst[m][k] = *(const PG8_LAS bf16x8*)(lds + PG8_SA(b, h) + aoff + m * 2048 + k * 1024); } while (0)
#define PG8_LDB(dst, b, h) do { _Pragma("unroll") for (int n = 0; n < 2; ++n) _Pragma("unroll") for (int k = 0; k < 2; ++k) dst[n][k] = *(const PG8_LAS bf16x8*)(lds + PG8_SB(b, h) + boff + n * 2048 + k * 1024); } while (0)
#define PG8_MMA(ai, bj, At, Bt) do { __builtin_amdgcn_s_setprio(1); _Pragma("unroll") for (int m = 0; m < 4; ++m) _Pragma("unroll") for (int n = 0; n < 2; ++n) _Pragma("unroll") for (int k = 0; k < 2; ++k) \
        acc[ai][bj][m][n] = __builtin_amdgcn_mfma_f32_16x16x32_bf16(Bt[n][k], At[m][k], acc[ai][bj][m][n], 0, 0, 0); __builtin_amdgcn_s_setprio(0); } while (0)
#define PG8_WAIT_V(n) asm volatile("s_waitcnt vmcnt(" #n ")" ::: "memory")
#define PG8_WAIT_L(n) asm volatile("s_waitcnt lgkmcnt(" #n ")" ::: "memory")
#define PG8_BAR __builtin_amdgcn_s_barrier()
#define PG8_SCHED __builtin_amdgcn_sched_barrier(0)
    Unit cur, nxt; int ui = 0;
    if (!S.next(0, cur)) return;
    f32x4 acc[2][2][4][2];
#pragma unroll
    for (int a = 0; a < 2; ++a)
#pragma unroll
        for (int b = 0; b < 2; ++b)
#pragma unroll
            for (int m = 0; m < 4; ++m)
#pragma unroll
                for (int n = 0; n < 2; ++n) acc[a][b][m][n] = (f32x4){0.f, 0.f, 0.f, 0.f};
    bf16x8 At[4][2], B0[2][2], B1[2][2];
    const char* cA = (const char*)g.A + (size_t)cur.pm * tstep; const char* cB = (const char*)g.Bt + (size_t)cur.pn * tstep;
    S.a_ready(cur);
    PG8_STAGE(PG8_SB(0, 0), cB, voffB); PG8_STAGE(PG8_SA(0, 0), cA, voffA); PG8_STAGE(PG8_SB(0, 1), cB + hstep, voffB); PG8_STAGE(PG8_SA(0, 1), cA + hstep, voffA);
    if (wr == 1) PG8_BAR;
    PG8_WAIT_V(4); PG8_BAR;
    PG8_STAGE(PG8_SB(1, 0), cB + kstep, voffB); PG8_STAGE(PG8_SA(1, 0), cA + kstep, voffA); PG8_STAGE(PG8_SB(1, 1), cB + hstep + kstep, voffB);
    PG8_WAIT_V(6); PG8_BAR;
    PG8_STAMP();
    for (;;) {
        const bool has_next = S.next(ui + 1, nxt);
        const char* nA = has_next ? (const char*)g.A + (size_t)nxt.pm * tstep : cA; const char* nB = has_next ? (const char*)g.Bt + (size_t)nxt.pn * tstep : cB;
        for (int t = 0; t < nt; t += 2) {
            const bool last = (t == nt - 2);
            const char* a1 = cA + (size_t)(t + 1) * kstep;
            const char* a2 = last ? nA : cA + (size_t)(t + 2) * kstep; const char* b2 = last ? nB : cB + (size_t)(t + 2) * kstep;
            const char* a3 = a2 + kstep; const char* b3 = b2 + kstep;
            if (last && has_next) S.a_ready(nxt);
            PG8_LDB(B0, 0, 0); PG8_SCHED; PG8_LDA(At, 0, 0); PG8_STAGE(PG8_SA(1, 1), a1 + hstep, voffA);
            PG8_WAIT_L(8); PG8_BAR; PG8_WAIT_L(0); PG8_MMA(0, 0, At, B0); PG8_BAR; PG8_SCHED;
            PG8_LDB(B1, 0, 1); PG8_STAGE(PG8_SB(0, 0), b2, voffB);
            PG8_BAR; PG8_WAIT_L(0); PG8_MMA(0, 1, At, B1); PG8_BAR;
            PG8_LDA(At, 0, 1); PG8_STAGE(PG8_SA(0, 0), a2, voffA);
            PG8_BAR; PG8_WAIT_L(0); PG8_MMA(1, 0, At, B0); PG8_BAR; PG8_SCHED;
            PG8_STAGE(PG8_SB(0, 1), b2 + hstep, voffB);
            PG8_WAIT_V(6); PG8_BAR; PG8_MMA(1, 1, At, B1); PG8_BAR;
            PG8_LDB(B0, 1, 0); PG8_SCHED; PG8_LDA(At, 1, 0); PG8_STAGE(PG8_SA(0, 1), a2 + hstep, voffA);
            PG8_WAIT_L(8); PG8_BAR; PG8_WAIT_L(0); PG8_MMA(0, 0, At, B0); PG8_BAR; PG8_SCHED;
            PG8_LDB(B1, 1, 1); PG8_STAGE(PG8_SB(1, 0), b3, voffB);
            PG8_BAR; PG8_WAIT_L(0); PG8_MMA(0, 1, At, B1); PG8_BAR;
            PG8_LDA(At, 1, 1); PG8_STAGE(PG8_SA(1, 0), a3, voffA);
            PG8_BAR; PG8_WAIT_L(0); PG8_MMA(1, 0, At, B0); PG8_BAR; PG8_SCHED;
            PG8_STAGE(PG8_SB(1, 1), b3 + hstep, voffB);
            PG8_WAIT_V(6); PG8_BAR; PG8_MMA(1, 1, At, B1); PG8_BAR;
        }
        PG8_STAMP();
        if constexpr (!Epi::AFTER_DRAIN) { E(acc, cur, wr, wc, fr, fq); S.done(cur); }
        PG8_STAMP();
        if (!has_next) break;
#pragma unroll
        for (int a = 0; a < 2; ++a)
#pragma unroll
            for (int b = 0; b < 2; ++b)
#pragma unroll
                for (int m = 0; m < 4; ++m)
#pragma unroll
                    for (int n = 0; n < 2; ++n) acc[a][b][m][n] = (f32x4){0.f, 0.f, 0.f, 0.f};
        cur = nxt; cA = nA; cB = nB; ++ui;
    }
    PG8_WAIT_V(0);
    if (wr == 0) PG8_BAR;
    PG8_BAR;
    if constexpr (Epi::AFTER_DRAIN) { E.fused(acc, cur, wr, wc, fr, fq, lds, wid, lane); S.done(cur); }
    PG8_STAMP();
    if (STAMP && wid == 0) { stamps[lane] = lane < nts ? (((unsigned long long)(unsigned)ts_hi << 32) | (unsigned)ts_lo) : 0ull;
        if (lane == 62) stamps[62] = rt_entry; if (lane == 63) stamps[63] = (unsigned long long)wall_clock64(); }
#undef PG8_STAMP
#undef PG8_SA
#undef PG8_SB
#undef PG8_STAGE
#undef PG8_LDA
#undef PG8_LDB
#undef PG8_MMA
#undef PG8_WAIT_V
#undef PG8_WAIT_L
#undef PG8_BAR
#undef PG8_SCHED
}
}

using pg8::bf16_t; using pg8::f32x4; using pg8::u32x4; using pg8::Unit;
typedef unsigned u32x2 __attribute__((ext_vector_type(2)));

constexpr int M_ = 32768, D_ = 1024, S_ = 4096, L_ = 4;
constexpr int NZ = 3712, NZP = 3840;
constexpr int ZC_U = 0, ZC_V = 256, ZC_GA = 512, ZC_VAL = 768, ZC_GLU = 1024, ZC_GB = 1280, ZC_C = 1536  , ZC_WD = 3584, ZC_AD = 3648;
constexpr float RMS_EPS = 1e-6f, LN_EPS = 1e-5f, GN_EPS = 64e-5f, DECAY_SCALE = 0.6065306597126334f;

enum { I_X = 0, I_P, I_PREG, I_WIN, I_SLNG, I_SLNB, I_SGUW, I_SGUB, I_CW, I_CB, I_CLNG, I_CLNB, I_PWW, I_PWB, I_MU, I_W0, I_WUP, I_A0, I_AUP, I_KK, I_KA, I_RK, I_LXG, I_LXB, I_WOUT, I_POSTG, I_PLEW, I_GW, I_GB, N_IN };

constexpr size_t WS_CTL = 0;
constexpr size_t WS_WIN = 65536;
constexpr size_t WS_WOUT = WS_WIN + (size_t)L_ * NZP * 1024 * 2;
constexpr size_t WS_WG = WS_WOUT + (size_t)L_ * 1024 * 1024 * 2;
constexpr size_t WS_WP = WS_WG + (size_t)L_ * 1024 * 1024 * 2;
constexpr size_t WS_SSQ1 = WS_WP + (size_t)L_ * 1024 * 256 * 2;
constexpr size_t WS_SSQ2 = WS_SSQ1 + (size_t)M_ * 16 * 4;
constexpr size_t WS_Z = WS_SSQ2 + (size_t)M_ * 16 * 4;
constexpr size_t WS_RA = WS_Z + (size_t)M_ * NZ * 2;
constexpr size_t WS_RB = WS_RA + (size_t)M_ * 1024 * 2;
constexpr size_t WS_WQ = WS_RB + (size_t)M_ * 1024 * 2;
constexpr size_t WS_AQ = WS_WQ + (size_t)M_ * 512 * 2;
constexpr size_t WS_PB = WS_AQ + (size_t)M_ * 512 * 2;
constexpr size_t WS_BON = WS_PB + (size_t)M_ * 256 * 2;
constexpr size_t WS_SGUW = WS_BON + (size_t)M_ * 8 * 4;
constexpr size_t WS_WPW = WS_SGUW + (size_t)L_ * 4 * 128 * 128 * 2;
constexpr size_t WS_WUP = WS_WPW + (size_t)L_ * 256 * 256 * 2;
constexpr size_t WS_AUP = WS_WUP + (size_t)L_ * 512 * 64 * 2;
constexpr size_t WS_XCH = WS_AUP + (size_t)L_ * 512 * 64 * 2;
constexpr size_t WS_CNT = WS_XCH + (size_t)128 * 256 * 4 * 4;
constexpr size_t WS_END = WS_CNT + (size_t)L_ * 128 * 256;
constexpr size_t WS_PP = WS_Z;

struct Args { const float* in[N_IN]; float* out; unsigned char* ws; int ph_lo, ph_hi; };
static_assert(sizeof(Args) == 8 * N_IN + 8 + 8 + 8, "no padding");

__device__ __forceinline__ float bf2f(unsigned h) { return __uint_as_float(h << 16); }
__device__ __forceinline__ unsigned f2bf(float f) { return pg8::cvt_pk_bf16(f, f) & 0xffffu; }
__device__ __forceinline__ unsigned pk2(float lo, float hi) { return pg8::cvt_pk_bf16(lo, hi); }
__device__ __forceinline__ float wave_sum(float v) {
#pragma unroll
    for (int o = 1; o < 64; o <<= 1) v += __shfl_xor(v, o);
    return v;
}
__device__ __forceinline__ float sigmoidf_(float x) { return __builtin_amdgcn_rcpf(1.0f + __expf(-x)); }
__device__ __forceinline__ float siluf_(float x) { return x * __builtin_amdgcn_rcpf(1.0f + __expf(-x)); }
__device__ __forceinline__ void unpack8(const u32x4 w, float (&o)[8]) {
    o[0] = bf2f(w.x & 0xffffu); o[1] = __uint_as_float(w.x & 0xffff0000u); o[2] = bf2f(w.y & 0xffffu); o[3] = __uint_as_float(w.y & 0xffff0000u);
    o[4] = bf2f(w.z & 0xffffu); o[5] = __uint_as_float(w.z & 0xffff0000u); o[6] = bf2f(w.w & 0xffffu); o[7] = __uint_as_float(w.w & 0xffff0000u);
}
__device__ __forceinline__ void unpack4(const u32x2 w, float (&o)[4]) {
    o[0] = bf2f(w.x & 0xffffu); o[1] = __uint_as_float(w.x & 0xffff0000u); o[2] = bf2f(w.y & 0xffffu); o[3] = __uint_as_float(w.y & 0xffff0000u);
}

struct EpiZ {
    static constexpr bool PERM = true, AFTER_DRAIN = false;
    bf16_t* Z; const float* ssq;
    __device__ __forceinline__ void operator()(const f32x4 (&acc)[2][2][4][2], const Unit& u, int wr, int wc, int fr, int fq) const {
        const int row0 = u.pm * 256 + wr * 64 + fr, col0 = u.pn * 256 + wc * 32 + 8 * fq;
#pragma unroll
        for (int ai = 0; ai < 2; ++ai)
#pragma unroll
            for (int m = 0; m < 4; ++m) {
                const int row = row0 + ai * 128 + m * 16;
                const f32x4* sp = (const f32x4*)(ssq + (size_t)row * 16);
                const f32x4 s0 = sp[0], s1 = sp[1], s2 = sp[2], s3 = sp[3];
                const float t = ((s0[0] + s0[1]) + (s0[2] + s0[3])) + ((s1[0] + s1[1]) + (s1[2] + s1[3])) + ((s2[0] + s2[1]) + (s2[2] + s2[3])) + ((s3[0] + s3[1]) + (s3[2] + s3[3]));
                const float rstd = rsqrtf(t * (1.0f / 1024.0f) + RMS_EPS);
#pragma unroll
                for (int bj = 0; bj < 2; ++bj) {
                    const int col = col0 + bj * 128;
                    if (col < NZ) {
                        const f32x4 v0 = acc[ai][bj][m][0] * rstd, v1 = acc[ai][bj][m][1] * rstd;
                        u32x4 w; w.x = pg8::cvt_pk_bf16(v0[0], v0[1]); w.y = pg8::cvt_pk_bf16(v0[2], v0[3]); w.z = pg8::cvt_pk_bf16(v1[0], v1[1]); w.w = pg8::cvt_pk_bf16(v1[2], v1[3]);
                        *(u32x4*)(Z + (size_t)row * NZ + col) = w;
                    }
                }
            }
    }
};
struct EpiMix {
    static constexpr bool PERM = true, AFTER_DRAIN = false;
    bf16_t* O; float* ssq;
    __device__ __forceinline__ void operator()(const f32x4 (&acc)[2][2][4][2], const Unit& u, int wr, int wc, int fr, int fq) const {
        const int row0 = u.pm * 256 + wr * 64 + fr, col0 = u.pn * 256 + wc * 32 + 8 * fq;
#pragma unroll
        for (int ai = 0; ai < 2; ++ai)
#pragma unroll
            for (int m = 0; m < 4; ++m) {
                const int row = row0 + ai * 128 + m * 16; float q = 0.f;
#pragma unroll
                for (int bj = 0; bj < 2; ++bj) {
                    const f32x4 v0 = acc[ai][bj][m][0], v1 = acc[ai][bj][m][1];
                    q += (v0[0] * v0[0] + v0[1] * v0[1]) + (v0[2] * v0[2] + v0[3] * v0[3]) + (v1[0] * v1[0] + v1[1] * v1[1]) + (v1[2] * v1[2] + v1[3] * v1[3]);
                    u32x4 w; w.x = pg8::cvt_pk_bf16(v0[0], v0[1]); w.y = pg8::cvt_pk_bf16(v0[2], v0[3]); w.z = pg8::cvt_pk_bf16(v1[0], v1[1]); w.w = pg8::cvt_pk_bf16(v1[2], v1[3]);
                    *(u32x4*)(O + (size_t)row * 1024 + col0 + bj * 128) = w;
                }
                q += __shfl_xor(q, 16); q += __shfl_xor(q, 32);
                if (fq == 0) ssq[(size_t)row * 16 + u.pn * 4 + wc] = q;
            }
    }
};
struct EpiPlain {
    static constexpr bool PERM = true, AFTER_DRAIN = false;
    bf16_t* O;
    __device__ __forceinline__ void operator()(const f32x4 (&acc)[2][2][4][2], const Unit& u, int wr, int wc, int fr, int fq) const {
        const int row0 = u.pm * 256 + wr * 64 + fr, col0 = u.pn * 256 + wc * 32 + 8 * fq;
#pragma unroll
        for (int ai = 0; ai < 2; ++ai)
#pragma unroll
            for (int m = 0; m < 4; ++m) {
                const int row = row0 + ai * 128 + m * 16;
#pragma unroll
                for (int bj = 0; bj < 2; ++bj) {
                    const f32x4 v0 = acc[ai][bj][m][0], v1 = acc[ai][bj][m][1];
                    u32x4 w; w.x = pg8::cvt_pk_bf16(v0[0], v0[1]); w.y = pg8::cvt_pk_bf16(v0[2], v0[3]); w.z = pg8::cvt_pk_bf16(v1[0], v1[1]); w.w = pg8::cvt_pk_bf16(v1[2], v1[3]);
                    *(u32x4*)(O + (size_t)row * 1024 + col0 + bj * 128) = w;
                }
            }
    }
};
struct EpiOut {
    static constexpr bool PERM = true, AFTER_DRAIN = false;
    const bf16_t* XN; const bf16_t* PP; bf16_t* XB; float* XF; float* ssq; const float* bias;
    __device__ __forceinline__ void operator()(const f32x4 (&acc)[2][2][4][2], const Unit& u, int wr, int wc, int fr, int fq) const {
        const int row0 = u.pm * 256 + wr * 64 + fr, col0 = u.pn * 256 + wc * 32 + 8 * fq;
        f32x4 bv[2][2];
#pragma unroll
        for (int bj = 0; bj < 2; ++bj)
#pragma unroll
            for (int n = 0; n < 2; ++n) bv[bj][n] = *(const f32x4*)(bias + col0 + bj * 128 + 4 * n);
#pragma unroll
        for (int ai = 0; ai < 2; ++ai)
#pragma unroll
            for (int m = 0; m < 4; ++m) {
                const int row = row0 + ai * 128 + m * 16; float q = 0.f;
#pragma unroll
                for (int bj = 0; bj < 2; ++bj) {
                    const size_t off = (size_t)row * 1024 + col0 + bj * 128;
                    const f32x4 g0 = acc[ai][bj][m][0] + bv[bj][0], g1 = acc[ai][bj][m][1] + bv[bj][1];
                    float xr[8], pp[8]; unpack8(*(const u32x4*)(XN + off), xr); unpack8(*(const u32x4*)(PP + off), pp);
                    f32x4 o0, o1;
#pragma unroll
                    for (int j = 0; j < 4; ++j) { o0[j] = xr[j] + pp[j] * sigmoidf_(g0[j]); o1[j] = xr[4 + j] + pp[4 + j] * sigmoidf_(g1[j]); }
                    if (XF) { *(f32x4*)(XF + off) = o0; *(f32x4*)(XF + off + 4) = o1; }
                    else {
                        u32x4 w; w.x = pg8::cvt_pk_bf16(o0[0], o0[1]); w.y = pg8::cvt_pk_bf16(o0[2], o0[3]); w.z = pg8::cvt_pk_bf16(o1[0], o1[1]); w.w = pg8::cvt_pk_bf16(o1[2], o1[3]);
                        *(u32x4*)(XB + off) = w;
                        q += (o0[0] * o0[0] + o0[1] * o0[1]) + (o0[2] * o0[2] + o0[3] * o0[3]) + (o1[0] * o1[0] + o1[1] * o1[1]) + (o1[2] * o1[2] + o1[3] * o1[3]);
                    }
                }
                if (!XF) { q += __shfl_xor(q, 16); q += __shfl_xor(q, 32); if (fq == 0) ssq[(size_t)row * 16 + u.pn * 4 + wc] = q; }
            }
    }
};


struct EpiXnew {
    static constexpr bool PERM = true, AFTER_DRAIN = true;
    const bf16_t* xin; bf16_t* XNB; const float* g; float* xbuf; unsigned* cnt;
    __device__ __forceinline__ void fused(f32x4 (&acc)[2][2][4][2], const Unit& u, int wr, int wc, int fr, int fq, PG8_LAS unsigned char* lds, int wid, int lane) const {
        PG8_LAS float* P = (PG8_LAS float*)lds;
        PG8_LAS float* Sr = (PG8_LAS float*)(lds + 4096);
#pragma unroll
        for (int ai = 0; ai < 2; ++ai)
#pragma unroll
            for (int m = 0; m < 4; ++m) {
                float q = 0.f;
#pragma unroll
                for (int bj = 0; bj < 2; ++bj)
#pragma unroll
                    for (int n = 0; n < 2; ++n) { const f32x4 v = acc[ai][bj][m][n]; q += (v[0] * v[0] + v[1] * v[1]) + (v[2] * v[2] + v[3] * v[3]); }
                q += __shfl_xor(q, 16); q += __shfl_xor(q, 32);
                if (fq == 0) P[(ai * 128 + wr * 64 + m * 16 + fr) * 4 + wc] = q;
            }
        asm volatile("s_waitcnt lgkmcnt(0)" ::: "memory"); __builtin_amdgcn_s_barrier(); asm volatile("" ::: "memory");
        const int row = wid * 32 + (lane & 31);
        if (lane < 32) {
            const float t = (P[row * 4 + 0] + P[row * 4 + 1]) + (P[row * 4 + 2] + P[row * 4 + 3]);
            __hip_atomic_store(xbuf + ((size_t)(u.pm * 256 + row) * 4 + u.pn), t, __ATOMIC_RELAXED, __HIP_MEMORY_SCOPE_AGENT);
        }
        asm volatile("s_waitcnt vmcnt(0)" ::: "memory");
        if (lane == 0) __hip_atomic_fetch_add(cnt + 64 * u.pm, 1u, __ATOMIC_RELAXED, __HIP_MEMORY_SCOPE_AGENT);
        if (wid == 0) {
            unsigned spins = 0;
            while ((unsigned)__builtin_amdgcn_readfirstlane(__hip_atomic_load(cnt + 64 * u.pm, __ATOMIC_RELAXED, __HIP_MEMORY_SCOPE_AGENT)) < 32u) { __builtin_amdgcn_s_sleep(2); if (++spins > (1u << 22)) break; }
            __builtin_amdgcn_fence(__ATOMIC_ACQUIRE, "agent");
        }
        asm volatile("s_waitcnt vmcnt(0) lgkmcnt(0)" ::: "memory"); __builtin_amdgcn_s_barrier(); asm volatile("" ::: "memory");
        if (lane < 32) {
            const float* slot = xbuf + (size_t)(u.pm * 256 + row) * 4; float t = 0.f;
#pragma unroll
            for (int k = 0; k < 4; ++k) t += __hip_atomic_load(slot + k, __ATOMIC_RELAXED, __HIP_MEMORY_SCOPE_AGENT);
            Sr[row] = rsqrtf(t * (1.0f / 1024.0f) + RMS_EPS);
        }
        asm volatile("s_waitcnt lgkmcnt(0)" ::: "memory"); __builtin_amdgcn_s_barrier(); asm volatile("" ::: "memory");
        float rs[2][4];
#pragma unroll
        for (int ai = 0; ai < 2; ++ai)
#pragma unroll
            for (int m = 0; m < 4; ++m) rs[ai][m] = Sr[ai * 128 + wr * 64 + m * 16 + fr];
        asm volatile("s_waitcnt lgkmcnt(0)" ::: "memory"); __builtin_amdgcn_s_barrier(); asm volatile("" ::: "memory");
        const int col0 = u.pn * 256 + wc * 32 + 8 * fq;
        f32x4 gv[2][2];
#pragma unroll
        for (int bj = 0; bj < 2; ++bj)
#pragma unroll
            for (int n = 0; n < 2; ++n) gv[bj][n] = *(const f32x4*)(g + col0 + bj * 128 + 4 * n);
#pragma unroll
        for (int ai = 0; ai < 2; ++ai)
#pragma unroll
            for (int m = 0; m < 4; ++m) {
                const int r = ai * 128 + wr * 64 + m * 16 + fr; const float rstd = rs[ai][m];
#pragma unroll
                for (int bj = 0; bj < 2; ++bj) {
                    const size_t off = (size_t)(u.pm * 256 + r) * 1024 + col0 + bj * 128;
                    float xr[8]; unpack8(*(const u32x4*)(xin + off), xr);
                    const f32x4 o0 = (f32x4){xr[0], xr[1], xr[2], xr[3]} + acc[ai][bj][m][0] * rstd * gv[bj][0], o1 = (f32x4){xr[4], xr[5], xr[6], xr[7]} + acc[ai][bj][m][1] * rstd * gv[bj][1];
                    u32x4 w; w.x = pg8::cvt_pk_bf16(o0[0], o0[1]); w.y = pg8::cvt_pk_bf16(o0[2], o0[3]); w.z = pg8::cvt_pk_bf16(o1[0], o1[1]); w.w = pg8::cvt_pk_bf16(o1[2], o1[3]);
                    *(u32x4*)(XNB + off) = w;
                }
                asm volatile("" ::: "memory");
            }
    }
};
struct RoundOrder {
    pg8::StaticOrder base; int round;
    __device__ bool next(int i, Unit& u) const { return i == 0 ? base.next(round, u) : false; }
    __device__ __forceinline__ void a_ready(const Unit&) const {}
    __device__ __forceinline__ void done(const Unit&) const {}
};

__device__ __forceinline__ int win_dst_col(int o) {
    if (o < 1536) return o;
    if (o < 3072) return 1536 + 4 * ((o - 1536) & 511) + ((o - 1536) >> 9);
    if (o < 3200) return o + 512;
    return 1536 + 4 * (o - 3200) + 3;
}
template <bool WINMAP = false>
__device__ __forceinline__ void transpose_item(const float* W, int K, int N, int k0, int nsrc0, bf16_t* WT, int ndst0, const float* g, float* scr, int lane) {
    float vv[32];
#pragma unroll
    for (int i = 0; i < 32; ++i) { const int kk = 2 * i + (lane >> 5); vv[i] = 0.f; if (nsrc0 >= 0) vv[i] = W[(size_t)(k0 + kk) * N + nsrc0 + (lane & 31)]; }
#pragma unroll
    for (int i = 0; i < 32; ++i) { const int kk = 2 * i + (lane >> 5); float v = vv[i]; if (g) v *= g[k0 + kk]; scr[kk * 33 + (lane & 31)] = v; }
    __builtin_amdgcn_s_waitcnt(0xC07F); asm volatile("" ::: "memory");
    const int c = lane & 7;
#pragma unroll
    for (int j = 0; j < 4; ++j) {
        const int n = (lane >> 3) + 8 * j; const float* s = scr + (8 * c) * 33 + n;
        u32x4 o; o.x = pk2(s[0 * 33], s[1 * 33]); o.y = pk2(s[2 * 33], s[3 * 33]); o.z = pk2(s[4 * 33], s[5 * 33]); o.w = pk2(s[6 * 33], s[7 * 33]);
        const int row = (WINMAP && nsrc0 >= 0) ? win_dst_col(nsrc0 + n) : ndst0 + n;
        *(u32x4*)(WT + (size_t)row * K + k0 + 8 * c) = o;
    }
    __builtin_amdgcn_s_waitcnt(0xC07F); asm volatile("" ::: "memory");
}
__device__ __forceinline__ void phase_prologue(const Args& a, float* ldsf, int wave, int lane) {
    float* scr = ldsf + wave * (64 * 33);
    const int gw = blockIdx.x * 8 + wave, NGW = gridDim.x * 8;
    constexpr int I_IN = 16 * (NZP / 32), I_SQ = 16 * 32, I_PL = 4 * 32, I_LAYER = I_IN + 2 * I_SQ + I_PL;
    for (int it = gw; it < L_ * I_LAYER; it += NGW) {
        const int l = it / I_LAYER; int r = it % I_LAYER;
        if (r < I_IN) {
            const int kb = r % 16, nb = r / 16, n0 = nb * 32;
            transpose_item<true>(a.in[I_WIN] + (size_t)l * 1024 * NZ, 1024, NZ, kb * 64, n0 < NZ ? n0 : -1, (bf16_t*)(a.ws + WS_WIN) + (size_t)l * NZP * 1024, n0, a.in[I_PREG] + l * 1024, scr, lane);
            continue;
        }
        r -= I_IN;
        if (r < I_SQ) { transpose_item(a.in[I_WOUT] + (size_t)l * 1024 * 1024, 1024, 1024, (r % 16) * 64, (r / 16) * 32, (bf16_t*)(a.ws + WS_WOUT) + (size_t)l * 1024 * 1024, (r / 16) * 32, nullptr, scr, lane); continue; }
        r -= I_SQ;
        if (r < I_SQ) { transpose_item(a.in[I_GW] + (size_t)l * 1024 * 1024, 1024, 1024, (r % 16) * 64, (r / 16) * 32, (bf16_t*)(a.ws + WS_WG) + (size_t)l * 1024 * 1024, (r / 16) * 32, nullptr, scr, lane); continue; }
        r -= I_SQ;
        transpose_item(a.in[I_PLEW] + (size_t)l * 256 * 1024, 256, 1024, (r % 4) * 64, (r / 4) * 32, (bf16_t*)(a.ws + WS_WP) + (size_t)l * 1024 * 256, (r / 4) * 32, nullptr, scr, lane);
    }
    {
        const int lr = lane & 31, lh = lane >> 5;
        for (int it = gw; it < 3 * 512; it += NGW) {
            const int kind = it >> 9, r = it & 511; float v[8]; bf16_t* dst;
            if (kind == 0) {
                const int l = r >> 7, nt = (r >> 4) & 7, ks = r & 15; const float* src = a.in[I_PWW] + (size_t)l * 256 * 256 + (size_t)(16 * ks + 8 * lh) * 256 + nt * 32 + lr;
#pragma unroll
                for (int j = 0; j < 8; ++j) v[j] = src[j * 256];
                dst = (bf16_t*)(a.ws + WS_WPW) + ((((size_t)l * 8 + nt) * 16 + ks) * 64 + lane) * 8;
            } else if (kind == 1) {
                const int mx = r >> 8, l = (r >> 6) & 3, ct = (r >> 2) & 15, ks = r & 3; const float* src = a.in[mx ? I_AUP : I_WUP] + (size_t)l * 64 * 512 + (size_t)(16 * ks + 8 * lh) * 512 + ct * 32 + lr;
#pragma unroll
                for (int j = 0; j < 8; ++j) v[j] = src[j * 512];
                dst = (bf16_t*)(a.ws + (mx ? WS_AUP : WS_WUP)) + ((((size_t)l * 16 + ct) * 4 + ks) * 64 + lane) * 8;
            } else {
                const int l = r >> 7, h = (r >> 5) & 3, itl = (r >> 3) & 3, ks = r & 7; const float* src = a.in[I_SGUW] + (((size_t)l * 4 + h) * 128 + itl * 32 + lr) * 128 + 16 * ks + 8 * lh;
                const f32x4 s0 = *(const f32x4*)(src), s1 = *(const f32x4*)(src + 4);
                v[0] = s0[0]; v[1] = s0[1]; v[2] = s0[2]; v[3] = s0[3]; v[4] = s1[0]; v[5] = s1[1]; v[6] = s1[2]; v[7] = s1[3];
                dst = (bf16_t*)(a.ws + WS_SGUW) + (((((size_t)l * 4 + h) * 4 + itl) * 8 + ks) * 64 + lane) * 8;
            }
            *(u32x4*)dst = (u32x4){pk2(v[0], v[1]), pk2(v[2], v[3]), pk2(v[4], v[5]), pk2(v[6], v[7])};
        }
    }
    const float* x = a.in[I_X]; bf16_t* XB = (bf16_t*)a.out; float* ssq = (float*)(a.ws + WS_SSQ1);
    for (int m0 = gw * 4; m0 < M_; m0 += NGW * 4) {
        f32x4 xv[4][4];
#pragma unroll
        for (int r = 0; r < 4; ++r)
#pragma unroll
            for (int h = 0; h < 2; ++h) { const size_t off = (size_t)(m0 + r) * 1024 + h * 512 + lane * 8; xv[r][2 * h] = *(const f32x4*)(x + off); xv[r][2 * h + 1] = *(const f32x4*)(x + off + 4); }
#pragma unroll
        for (int r = 0; r < 4; ++r) {
            float q = 0.f;
#pragma unroll
            for (int h = 0; h < 2; ++h) {
                const size_t off = (size_t)(m0 + r) * 1024 + h * 512 + lane * 8;
                const f32x4 x0 = xv[r][2 * h], x1 = xv[r][2 * h + 1];
                q += (x0[0] * x0[0] + x0[1] * x0[1]) + (x0[2] * x0[2] + x0[3] * x0[3]) + (x1[0] * x1[0] + x1[1] * x1[1]) + (x1[2] * x1[2] + x1[3] * x1[3]);
                u32x4 w; w.x = pk2(x0[0], x0[1]); w.y = pk2(x0[2], x0[3]); w.z = pk2(x1[0], x1[1]); w.w = pk2(x1[2], x1[3]);
                *(u32x4*)(XB + off) = w;
            }
            q = wave_sum(q);
            if (lane < 16) ssq[(size_t)(m0 + r) * 16 + lane] = lane == 0 ? q : 0.f;
        }
    }
}

template <int CTRL> __device__ __forceinline__ float dpp_f(float x) { return __builtin_bit_cast(float, __builtin_amdgcn_update_dpp(0, __builtin_bit_cast(int, x), CTRL, 0xf, 0xf, true)); }
__device__ __forceinline__ float allreduce16(float x) {
    x += dpp_f<0xB1>(x);
    x += dpp_f<0x4E>(x);
    x += dpp_f<0x141>(x);
    x += dpp_f<0x140>(x);
    return x;
}
__device__ __forceinline__ float wave_sum_d(float v) { v = allreduce16(v); v += __shfl_xor(v, 16); v += __shfl_xor(v, 32); return v; }
typedef float f32x16 __attribute__((ext_vector_type(16)));
using pg8::bf16x8;
#define MFMA32(a, b, c) __builtin_amdgcn_mfma_f32_32x32x16_bf16((a), (b), (c), 0, 0, 0)
constexpr int SG_PITCH = 272;
__device__ __forceinline__ void sgu_item(const Args& a, int l, int nb, unsigned char* shm, int tid_in, int wave, int lane_in) {
    int tid = tid_in, lane = lane_in; asm volatile("" : "+v"(tid), "+v"(lane));
    const bf16_t* Z = (const bf16_t*)(a.ws + WS_Z); bf16_t* CAT = (bf16_t*)(a.ws + WS_RA);
    bf16x8 wfrag[24];
    {
        const bf16_t* wb0 = (const bf16_t*)(a.ws + WS_SGUW) + ((((size_t)l * 4 + (wave >> 1)) * 4 * 8) * 64 + lane) * 8;
#pragma unroll
        for (int ks = 0; ks < 8; ++ks)
#pragma unroll
            for (int it = (ks < 4 ? 0 : 2); it < 4; ++it) wfrag[ks < 4 ? ks * 4 + it : 16 + (ks - 4) * 2 + (it - 2)] = *(const bf16x8*)(wb0 + (size_t)(it * 8 + ks) * 512);
    }
    {
        const f32x4 g = *(const f32x4*)(a.in[I_SLNG] + l * 256 + lane * 4), bb = *(const f32x4*)(a.in[I_SLNB] + l * 256 + lane * 4);
        u32x2 vld[16];
#pragma unroll
        for (int tt = 0; tt < 16; ++tt) vld[tt] = *(const u32x2*)(Z + ((size_t)nb * 128 + wave * 16 + tt) * NZ + ZC_V + lane * 4);
#pragma unroll
        for (int tt = 0; tt < 16; ++tt) {
            const int j = wave * 16 + tt;
            float v[4]; unpack4(vld[tt], v);
            const float mu = wave_sum_d((v[0] + v[1]) + (v[2] + v[3])) * (1.0f / 256.0f);
            const float d0 = v[0] - mu, d1 = v[1] - mu, d2 = v[2] - mu, d3 = v[3] - mu;
            const float rs = rsqrtf(wave_sum_d((d0 * d0 + d1 * d1) + (d2 * d2 + d3 * d3)) * (1.0f / 256.0f) + LN_EPS);
            unsigned short* dst = (unsigned short*)(shm + (size_t)(lane * 4) * SG_PITCH + j * 2);
            dst[0] = (unsigned short)f2bf(d0 * rs * g[0] + bb[0]); dst[SG_PITCH / 2] = (unsigned short)f2bf(d1 * rs * g[1] + bb[1]);
            dst[SG_PITCH] = (unsigned short)f2bf(d2 * rs * g[2] + bb[2]); dst[3 * SG_PITCH / 2] = (unsigned short)f2bf(d3 * rs * g[3] + bb[3]);
        }
    }
    __syncthreads();
    {
        const int h = wave >> 1, dt = wave & 1, lr = lane & 31, lh = lane >> 5;
        const unsigned char* arow = shm + (size_t)(h * 64 + dt * 32 + lr) * SG_PITCH + lh * 16;
        f32x16 acc[4];
#pragma unroll
        for (int it = 0; it < 4; ++it)
#pragma unroll
            for (int r = 0; r < 16; ++r) acc[it][r] = 0.f;
#pragma unroll
        for (int ks = 0; ks < 8; ++ks) {
            const bf16x8 af = *(const bf16x8*)(arow + ks * 32);
#pragma unroll
            for (int it = (ks < 4 ? 0 : 2); it < 4; ++it) {
                acc[it] = MFMA32(af, wfrag[ks < 4 ? ks * 4 + it : 16 + (ks - 4) * 2 + (it - 2)], acc[it]);
            }
        }
#pragma unroll
        for (int it = 0; it < 4; ++it) {
            const int i = it * 32 + lr; const size_t tok = (size_t)nb * 128 + i;
            const float bs = a.in[I_SGUB][((size_t)l * 4 + h) * 128 + i];
#pragma unroll
            for (int g = 0; g < 4; ++g) {
                const int c0 = h * 64 + dt * 32 + 8 * g + 4 * lh;
                float uu[4], gg[4]; unpack4(*(const u32x2*)(Z + tok * NZ + ZC_U + c0), uu); unpack4(*(const u32x2*)(Z + tok * NZ + ZC_GA + c0), gg);
                u32x2 o; o.x = pk2(uu[0] * (acc[it][4 * g] + bs) * siluf_(gg[0]), uu[1] * (acc[it][4 * g + 1] + bs) * siluf_(gg[1]));
                o.y = pk2(uu[2] * (acc[it][4 * g + 2] + bs) * siluf_(gg[2]), uu[3] * (acc[it][4 * g + 3] + bs) * siluf_(gg[3]));
                *(u32x2*)(CAT + tok * 1024 + c0) = o;
            }
        }
    }
    __syncthreads();
}

constexpr int CV_T = 64, CV_ROWS = CV_T + 30;
constexpr int CV_Y = 0;
constexpr int CV_C = CV_ROWS * 512;
constexpr int CV_APITCH = 528, CV_TPITCH = 144;
constexpr int CV_TW = CV_C + CV_T * 1024;
constexpr int CV_AD = CV_TW + CV_T * CV_TPITCH;
constexpr int CV_END = CV_AD + CV_T * CV_TPITCH;
__device__ __forceinline__ float tanh_fast(float x) { return 1.0f - 2.0f * __builtin_amdgcn_rcpf(__expf(2.0f * x) + 1.0f); }
template <int SKIP = 0>
__device__ __forceinline__ void conv_phase(const Args& a, int l, unsigned char* shm, int tid_in, int wave, int lane_in) {
    int tid = tid_in, lane = lane_in; asm volatile("" : "+v"(tid), "+v"(lane));
    const bf16_t* Z = (const bf16_t*)(a.ws + WS_Z); bf16_t* CAT = (bf16_t*)(a.ws + WS_RA);
    float* cbuf = (float*)(shm + CV_C);
    for (int item = blockIdx.x; item < M_ / CV_T; item += gridDim.x) {
        const int t0 = item * CV_T, pos0 = t0 & (S_ - 1);
        if (!(SKIP & 1))
        {
            int tid1 = tid; asm volatile("" : "+v"(tid1));
            const int c4 = (tid1 & 63) * 4, rg = tid1 >> 6;
            u32x2 vw[12], gw[12];
#pragma unroll
            for (int i = 0; i < 12; ++i) {
                const int rr = rg + 8 * i; vw[i] = (u32x2){0u, 0u}; gw[i] = (u32x2){0u, 0u};
                if (rr < CV_ROWS && pos0 - 30 + rr >= 0) { const size_t tok = (size_t)(t0 - 30 + rr); vw[i] = *(const u32x2*)(Z + tok * NZ + ZC_VAL + c4); gw[i] = *(const u32x2*)(Z + tok * NZ + ZC_GLU + c4); }
            }
#pragma unroll
            for (int i = 0; i < 12; ++i) {
                const int rr = rg + 8 * i;
                if (rr < CV_ROWS) {
                    float v[4], g[4]; unpack4(vw[i], v); unpack4(gw[i], g);
                    *(u32x2*)(shm + CV_Y + rr * 512 + c4 * 2) = (u32x2){pk2(v[0] * sigmoidf_(g[0]), v[1] * sigmoidf_(g[1])), pk2(v[2] * sigmoidf_(g[2]), v[3] * sigmoidf_(g[3]))};
                }
            }
        }
        if (!(SKIP & 2)) {
            int tid1 = tid; asm volatile("" : "+v"(tid1));
            const int t = tid1 >> 3, j0 = (tid1 & 7) * 16; const size_t tok = (size_t)(t0 + t);
            const bf16_t* zp = Z + tok * NZ + ZC_WD + j0;
            const u32x4 c0 = *(const u32x4*)(zp), c1 = *(const u32x4*)(zp + 8);
            u32x4 p0 = (u32x4){0u, 0u, 0u, 0u}, p1 = p0;
            if (pos0 + t > 0) { p0 = *(const u32x4*)(zp - NZ); p1 = *(const u32x4*)(zp - NZ + 8); }
            const float* mu = a.in[I_MU] + (size_t)l * 1664 + 1536 + j0;
            float zc[16], zq[16]; { float t8[8]; unpack8(c0, t8);
#pragma unroll
                for (int e = 0; e < 8; ++e) zc[e] = t8[e]; unpack8(c1, t8);
#pragma unroll
                for (int e = 0; e < 8; ++e) zc[8 + e] = t8[e]; unpack8(p0, t8);
#pragma unroll
                for (int e = 0; e < 8; ++e) zq[e] = t8[e]; unpack8(p1, t8);
#pragma unroll
                for (int e = 0; e < 8; ++e) zq[8 + e] = t8[e]; }
            float o[16];
#pragma unroll
            for (int e4 = 0; e4 < 4; ++e4) { const f32x4 m4 = *(const f32x4*)(mu + 4 * e4);
#pragma unroll
                for (int e = 0; e < 4; ++e) { const float sft = zc[4 * e4 + e] + m4[e] * (zq[4 * e4 + e] - zc[4 * e4 + e]); o[4 * e4 + e] = j0 < 64 ? tanh_fast(sft) : sft; } }
            unsigned char* dst = shm + (j0 < 64 ? CV_TW + t * CV_TPITCH + j0 * 2 : CV_AD + t * CV_TPITCH + (j0 - 64) * 2);
            *(u32x4*)(dst) = (u32x4){pk2(o[0], o[1]), pk2(o[2], o[3]), pk2(o[4], o[5]), pk2(o[6], o[7])};
            *(u32x4*)(dst + 16) = (u32x4){pk2(o[8], o[9]), pk2(o[10], o[11]), pk2(o[12], o[13]), pk2(o[14], o[15])};
        }
        __syncthreads();
        if (!(SKIP & 4)) {
            int tid2 = tid; asm volatile("" : "+v"(tid2));
            const int c = tid2 & 255, th = tid2 >> 8;
            float cw[31];
#pragma unroll
            for (int k = 0; k < 31; ++k) cw[k] = a.in[I_CW][((size_t)l * 31 + k) * 256 + c];
            const float cb = a.in[I_CB][l * 256 + c];
#pragma unroll 1
            for (int run = 0; run < 2; ++run) {
                const int tb = th * 32 + run * 16;
                float yr[46];
#pragma unroll
                for (int i = 0; i < 46; ++i) yr[i] = bf2f(*(const unsigned short*)(shm + CV_Y + (tb + i) * 512 + c * 2));
#pragma unroll
                for (int t = 0; t < 16; ++t) {
                    float acc = cb;
#pragma unroll
                    for (int k = 0; k < 31; ++k) acc += yr[t + k] * cw[k];
                    cbuf[(tb + t) * 256 + c] = acc;
                }
            }
        }
        __syncthreads();
        int ln4 = lane; asm volatile("" : "+v"(ln4));
        int lr = ln4 & 31, lh = ln4 >> 5;
        bf16x8 wpf[16];
        {
            const bf16_t* wp = (const bf16_t*)(a.ws + WS_WPW) + ((((size_t)l * 8 + wave) * 16) * 64 + ln4) * 8;
#pragma unroll
            for (int ks = 0; ks < 16; ++ks) wpf[ks] = *(const bf16x8*)(wp + ks * 512);
        }
        if (!(SKIP & 8)) {
            const f32x4 g = *(const f32x4*)(a.in[I_CLNG] + l * 256 + lane * 4), b = *(const f32x4*)(a.in[I_CLNB] + l * 256 + lane * 4);
#pragma unroll
            for (int tt = 0; tt < 8; ++tt) {
                const int t = wave * 8 + tt;
                f32x4 v = *(const f32x4*)(cbuf + t * 256 + lane * 4);
                const float mu = wave_sum_d((v[0] + v[1]) + (v[2] + v[3])) * (1.0f / 256.0f);
                v = v - mu;
                const float rs = rsqrtf(wave_sum_d((v[0] * v[0] + v[1] * v[1]) + (v[2] * v[2] + v[3] * v[3])) * (1.0f / 256.0f) + LN_EPS);
                u32x2 o; o.x = pk2(siluf_(v[0] * rs * g[0] + b[0]), siluf_(v[1] * rs * g[1] + b[1])); o.y = pk2(siluf_(v[2] * rs * g[2] + b[2]), siluf_(v[3] * rs * g[3] + b[3]));
                *(u32x2*)(shm + CV_Y + t * CV_APITCH + lane * 8) = o;
            }
        }
        __syncthreads();
        if (!(SKIP & 16)) {
            f32x16 acc[2];
#pragma unroll
            for (int r = 0; r < 16; ++r) { acc[0][r] = 0.f; acc[1][r] = 0.f; }
            const unsigned char* bp = shm + CV_Y + lr * CV_APITCH + lh * 16;
#pragma unroll
            for (int ks = 0; ks < 16; ++ks) { acc[0] = MFMA32(*(const bf16x8*)(bp + ks * 32), wpf[ks], acc[0]); acc[1] = MFMA32(*(const bf16x8*)(bp + 32 * CV_APITCH + ks * 32), wpf[ks], acc[1]); }
            const int n = wave * 32 + lr; const float pb = a.in[I_PWB][l * 256 + n];
#pragma unroll
            for (int tt = 0; tt < 2; ++tt) {
                unsigned gbr[16];
#pragma unroll
                for (int r = 0; r < 16; ++r) gbr[r] = Z[(size_t)(t0 + tt * 32 + (r & 3) + 8 * (r >> 2) + 4 * lh) * NZ + ZC_GB + n];
#pragma unroll
                for (int r = 0; r < 16; ++r) CAT[(size_t)(t0 + tt * 32 + (r & 3) + 8 * (r >> 2) + 4 * lh) * 1024 + 256 + n] = (bf16_t)f2bf((acc[tt][r] + pb) * siluf_(bf2f(gbr[r])));
            }
        }
        if (!(SKIP & 32)) {
            int ln5 = lane; asm volatile("" : "+v"(ln5)); lr = ln5 & 31; lh = ln5 >> 5;
            unsigned* AW = (unsigned*)(a.ws + WS_WQ);
#pragma unroll
            for (int cc = 0; cc < 2; ++cc) {
                const int ct = wave * 2 + cc;
                const bf16_t* wu = (const bf16_t*)(a.ws + WS_WUP) + ((((size_t)l * 16 + ct) * 4) * 64 + (lr + 32 * lh)) * 8;
                const bf16_t* au = (const bf16_t*)(a.ws + WS_AUP) + ((((size_t)l * 16 + ct) * 4) * 64 + (lr + 32 * lh)) * 8;
                bf16x8 wf[4], af[4];
#pragma unroll
                for (int ks = 0; ks < 4; ++ks) { wf[ks] = *(const bf16x8*)(wu + ks * 512); af[ks] = *(const bf16x8*)(au + ks * 512); }
#pragma unroll
                for (int tt = 0; tt < 2; ++tt) {
                    const unsigned char* tp = shm + CV_TW + (tt * 32 + lr) * CV_TPITCH + lh * 16; const unsigned char* ap = shm + CV_AD + (tt * 32 + lr) * CV_TPITCH + lh * 16;
                    f32x16 aw, aa;
#pragma unroll
                    for (int r = 0; r < 16; ++r) { aw[r] = 0.f; aa[r] = 0.f; }
#pragma unroll
                    for (int ks = 0; ks < 4; ++ks) { aw = MFMA32(*(const bf16x8*)(tp + ks * 32), wf[ks], aw); aa = MFMA32(*(const bf16x8*)(ap + ks * 32), af[ks], aa); }
                    const int c = ct * 32 + lr; const float w0 = a.in[I_W0][l * 512 + c], a0 = a.in[I_A0][l * 512 + c];
#pragma unroll
                    for (int r = 0; r < 16; ++r) {
                        const float w = __expf(-DECAY_SCALE * sigmoidf_(w0 + aw[r]));
                        const unsigned q = (unsigned)fminf(fmaxf(rintf((1.0f - w) * 131072.0f), 0.f), 65535.f);
                        AW[(size_t)(t0 + tt * 32 + (r & 3) + 8 * (r >> 2) + 4 * lh) * 512 + c] = q | (f2bf(sigmoidf_(a0 + aa[r])) << 16);
                    }
                }
            }
        }
        if (!(SKIP & 64)) {
            int tid6 = tid; asm volatile("" : "+v"(tid6));
            const float* p = a.in[I_P] + ((size_t)l * M_ + t0) * 256; bf16_t* PB = (bf16_t*)(a.ws + WS_PB) + (size_t)t0 * 256;
#pragma unroll
            for (int h = 0; h < 4; ++h) {
                const int e0 = (h * 512 + tid6) * 8;
                const f32x4 x0 = *(const f32x4*)(p + e0), x1 = *(const f32x4*)(p + e0 + 4);
                u32x4 w; w.x = pk2(x0[0], x0[1]); w.y = pk2(x0[2], x0[3]); w.z = pk2(x1[0], x1[1]); w.w = pk2(x1[2], x1[3]);
                *(u32x4*)(PB + e0) = w;
            }
        }
        __syncthreads();
    }
}

constexpr int CS_C = 16, CS_NCH = S_ / CS_C, CS_NS = 8, CS_NP = 7;
constexpr int SM_AT4 = 0  , SM_RBK = 1024  , SM_RS = 2048, SM_BYTES = 2112;
constexpr int PA_AT = 0, PA_RT = 2304, PA_BN = 4608, PA_KN = 6912, PA_KR = 9216, PA_RK = 11520, PA_NF = 13824, PA_OUT = 14848, PA_SIZE = 16960;
constexpr int SL_AT = 0, SL_RT = 2304, SL_BK = 4608  , SL_SM = 9728, SL_VM = 11840, SL_WC = 12480, SL_SIZE = 12800;
constexpr int CS_FLAGS = CS_NS * SL_SIZE, CS_LDS = CS_FLAGS + 64;
__device__ __forceinline__ bf16x8 mk8(unsigned a, unsigned b, unsigned c, unsigned d) { return __builtin_bit_cast(bf16x8, (u32x4){a, b, c, d}); }
__device__ __forceinline__ unsigned short bf1(float x) { return (unsigned short)pg8::cvt_pk_bf16(x, x); }
#define MFMA16(a, b, c) __builtin_amdgcn_mfma_f32_16x16x32_bf16((a), (b), (c), 0, 0, 0)
__device__ __forceinline__ void scanprep_phase(const Args& a, int l, unsigned char* shm, int wave, int lane_in) {
    int lane = lane_in; asm volatile("" : "+v"(lane));
    const bf16_t* Z = (const bf16_t*)(a.ws + WS_Z);
    const unsigned* AW = (const unsigned*)(a.ws + WS_WQ);
    float* BON = (float*)(a.ws + WS_BON);
    unsigned char* sb = shm + wave * PA_SIZE;
    const int gw = blockIdx.x * 8 + wave, NGW = gridDim.x * 8;
    const int li = lane & 15, g = lane >> 4;
#pragma unroll 1
    for (int task = gw; task < 64 * CS_NCH; task += NGW) {
        const int bh = task / CS_NCH, c = task % CS_NCH, b = bh >> 3, h = bh & 7, hc = h * 64 + lane;
        const unsigned uhc = (unsigned)hc;
        const size_t tokc = (size_t)b * S_ + (size_t)c * CS_C;
        const float mu_k = a.in[I_MU][(size_t)l * 1664 + 512 + hc], mu_r = a.in[I_MU][(size_t)l * 1664 + hc];
        const float kkc = a.in[I_KK][l * 512 + hc], kac = a.in[I_KA][l * 512 + hc], rkc = a.in[I_RK][l * 512 + hc];
        unsigned rk[16], aw[16];
#pragma unroll
        for (int t = 0; t < 16; ++t) { rk[t] = ((const unsigned*)(Z + (tokc + t) * NZ + ZC_C))[2 * uhc]; aw[t] = (AW + (tokc + t) * 512)[uhc]; }
        unsigned prk = 0u;
        if (c > 0) prk = ((const unsigned*)(Z + (tokc - 1) * NZ + ZC_C))[2 * uhc];
        float pr = bf2f(prk & 0xffffu), pk = __uint_as_float(prk & 0xffff0000u);
        float W = 1.0f;
#pragma unroll
        for (int t = 0; t < 16; ++t) {
            const float fzr = bf2f(rk[t] & 0xffffu), fzk = __uint_as_float(rk[t] & 0xffff0000u), al = __uint_as_float(aw[t] & 0xffff0000u), w = 1.0f - (float)(aw[t] & 0xffffu) * (1.0f / 131072.0f);
            const float r = fzr + mu_r * (pr - fzr), kx = fzk + mu_k * (pk - fzk);
            pr = fzr; pk = fzk;
            const float kkr = kx * kkc, kp = kx * (1.0f + (al - 1.0f) * kac);
            const float Wp = W; W *= w; const float iW = __builtin_amdgcn_rcpf(W), rW = r * W;
            *(unsigned short*)(sb + PA_AT + t * 144 + 2 * lane) = bf1(-kkr * Wp);
            *(unsigned short*)(sb + PA_RT + t * 144 + 2 * lane) = bf1(rW);
            *(unsigned short*)(sb + PA_BN + t * 144 + 2 * lane) = bf1(kkr * al * iW);
            *(unsigned short*)(sb + PA_KN + t * 144 + 2 * lane) = bf1(kp * iW);
            *(unsigned short*)(sb + PA_KR + t * 144 + 2 * lane) = bf1(kkr);
            *(unsigned short*)(sb + PA_RK + t * 144 + 2 * lane) = bf1(rW * rkc);
        }
        __builtin_amdgcn_s_waitcnt(0xC07F); asm volatile("" ::: "memory");
        {
            bf16x8 fa[2], fr[2], fb[2], fk[2], fq[2], fo[2];
#pragma unroll
            for (int s2 = 0; s2 < 2; ++s2) {
                fa[s2] = *(const bf16x8*)(sb + PA_AT + li * 144 + 16 * g + 64 * s2); fr[s2] = *(const bf16x8*)(sb + PA_RT + li * 144 + 16 * g + 64 * s2);
                fb[s2] = *(const bf16x8*)(sb + PA_BN + li * 144 + 16 * g + 64 * s2); fk[s2] = *(const bf16x8*)(sb + PA_KN + li * 144 + 16 * g + 64 * s2);
                fq[s2] = *(const bf16x8*)(sb + PA_KR + li * 144 + 16 * g + 64 * s2); fo[s2] = *(const bf16x8*)(sb + PA_RK + li * 144 + 16 * g + 64 * s2);
            }
            const f32x4 z4 = {0.f, 0.f, 0.f, 0.f};
            f32x4 dss = MFMA16(fq[0], fq[0], z4); dss = MFMA16(fq[1], fq[1], dss);
            f32x4 dbo = MFMA16(fo[0], fk[0], z4); dbo = MFMA16(fo[1], fk[1], dbo);
            f32x4 dab = MFMA16(fa[0], fb[0], z4); dab = MFMA16(fa[1], fb[1], dab);
            f32x4 dak = MFMA16(fa[0], fk[0], z4); dak = MFMA16(fa[1], fk[1], dak);
            f32x4 drb = MFMA16(fr[0], fb[0], z4); drb = MFMA16(fr[1], fb[1], drb);
            f32x4 drk = MFMA16(fr[0], fk[0], z4); drk = MFMA16(fr[1], fk[1], drk);
            if (g == (li >> 2)) {
                const int rr = li & 3;
                const float ss = rr == 0 ? dss[0] : (rr == 1 ? dss[1] : (rr == 2 ? dss[2] : dss[3]));
                const float bo = rr == 0 ? dbo[0] : (rr == 1 ? dbo[1] : (rr == 2 ? dbo[2] : dbo[3]));
                const float rs = rsqrtf(fmaxf(ss, 1e-12f));
                *(float*)(sb + PA_OUT + SM_RS + 4 * li) = rs;
                BON[(tokc + li) * 8 + h] = bo;
            }
            __builtin_amdgcn_s_waitcnt(0xC07F); asm volatile("" ::: "memory");
            const float rsc = *(const float*)(sb + PA_OUT + SM_RS + 4 * li); const f32x4 rsr = *(const f32x4*)(sb + PA_OUT + SM_RS + 16 * g);
#pragma unroll
            for (int r = 0; r < 4; ++r) {
                const int t = 4 * g + r;
                *(float*)(sb + PA_NF + t * 64 + 4 * li) = li < t ? dab[r] * rsr[r] * rsc : 0.f;
                *(unsigned short*)(sb + PA_OUT + SM_AT4 + t * 64 + (li >> 2) * 16 + (li & 3) * 2) = bf1(li < t ? dak[r] * rsr[r] : 0.f);
                *(unsigned short*)(sb + PA_OUT + SM_RBK + t * 64 + (li >> 2) * 16 + (li & 3) * 2) = bf1(li <= t ? drb[r] * rsc : 0.f);
                *(unsigned short*)(sb + PA_OUT + SM_RBK + t * 64 + (li >> 2) * 16 + 8 + (li & 3) * 2) = bf1(li <= t ? drk[r] : 0.f);
            }
        }
        __builtin_amdgcn_s_waitcnt(0xC07F); asm volatile("" ::: "memory");
        {
            float T[16];
#pragma unroll
            for (int t = 0; t < 16; ++t) {
                float x = li == t ? 1.0f : 0.f;
#pragma unroll
                for (int j4 = 0; j4 < t; j4 += 4) {
                    const f32x4 n4 = *(const f32x4*)(sb + PA_NF + t * 64 + 4 * j4);
#pragma unroll
                    for (int e = 0; e < 4; ++e) if (j4 + e < t) x += n4[e] * T[j4 + e];
                }
                T[t] = x;
                if (g == 0) *(unsigned short*)(sb + PA_OUT + SM_AT4 + t * 64 + (li >> 2) * 16 + 8 + (li & 3) * 2) = bf1(x);
            }
        }
        __builtin_amdgcn_s_waitcnt(0xC07F); asm volatile("" ::: "memory");
        {
            unsigned char* dst = (unsigned char*)(Z + (tokc + h) * NZ);
            *(u32x4*)(dst + 16 * lane) = *(const u32x4*)(sb + PA_OUT + 16 * lane);
            *(u32x4*)(dst + 1024 + 16 * lane) = *(const u32x4*)(sb + PA_OUT + 1024 + 16 * lane);
            if (lane < 4) *(u32x4*)(dst + 2048 + 16 * lane) = *(const u32x4*)(sb + PA_OUT + 2048 + 16 * lane);
        }
        __builtin_amdgcn_s_waitcnt(0xC07F); asm volatile("" ::: "memory");
    }
}
template <int MODE  >
__device__ __forceinline__ void cscan_phase(const Args& a, int l, unsigned char* shm, int tid, int wave, int lane) {
    const bf16_t* Z = (const bf16_t*)(a.ws + WS_Z);
    const unsigned* AW = (const unsigned*)(a.ws + WS_WQ);
    float* Y = (float*)(a.ws + WS_RB);
    volatile PG8_LAS unsigned* flags = (volatile PG8_LAS unsigned*)((PG8_LAS unsigned char*)shm + CS_FLAGS);
    const int G = gridDim.x, bx = blockIdx.x, vcu = (G % 8 == 0) ? (bx % 8) * (G / 8) + bx / 8 : bx;
    for (int task = vcu; task < 256; task += G) {
        const int bh = task >> 2, q = task & 3, b = bh >> 3, h = bh & 7;
        const size_t tok0 = (size_t)b * S_;
        if (tid < 16) flags[tid] = 0u;
        __syncthreads();
        const int li = lane & 15, g = lane >> 4;
        if (wave == 0) {
            __builtin_amdgcn_s_setprio(3);
            f32x4 S[4];
#pragma unroll
            for (int i = 0; i < 4; ++i) S[i] = (f32x4){0.f, 0.f, 0.f, 0.f};
            float* Yp = Y + (tok0 + 4 * g) * 512 + h * 64 + 16 * q + li;
            bf16x8 c_at[2], c_rt[2], c_bk[4], c_a4, c_rbk; u32x2 c_vm; f32x4 c_wc[4];
            bf16x8 n_at[2], n_rt[2], n_bk[4], n_a4, n_rbk; u32x2 n_vm; f32x4 n_wc[4];
#define CS_LOAD(P, cc) do { const unsigned char* sb_ = shm + ((cc) & 7) * SL_SIZE; \
                _Pragma("unroll") for (int s2 = 0; s2 < 2; ++s2) { P##at[s2] = *(const bf16x8*)(sb_ + SL_AT + li * 144 + 64 * s2 + 16 * g); P##rt[s2] = *(const bf16x8*)(sb_ + SL_RT + li * 144 + 64 * s2 + 16 * g); } \
                _Pragma("unroll") for (int i = 0; i < 4; ++i) { P##bk[i] = *(const bf16x8*)(sb_ + SL_BK + (16 * i + li) * 80 + 16 * g); P##wc[i] = *(const f32x4*)(sb_ + SL_WC + (16 * i + 4 * g) * 4); } \
                P##a4 = *(const bf16x8*)(sb_ + SL_SM + SM_AT4 + li * 64 + 16 * g); P##rbk = *(const bf16x8*)(sb_ + SL_SM + SM_RBK + li * 64 + 16 * g); P##vm = *(const u32x2*)(sb_ + SL_VM + li * 40 + 8 * g); } while (0)
#define CS_COMPUTE(P, cc) do { \
                const f32x4 z4_ = {0.f, 0.f, 0.f, 0.f}; \
                const f32x4 rhs0_ = MFMA16(P##a4, mk8(P##vm.x, P##vm.y, 0u, 0u), z4_); \
                const bf16x8 sb0_ = mk8(pg8::cvt_pk_bf16(S[0][0], S[0][1]), pg8::cvt_pk_bf16(S[0][2], S[0][3]), pg8::cvt_pk_bf16(S[1][0], S[1][1]), pg8::cvt_pk_bf16(S[1][2], S[1][3])); \
                const bf16x8 sb1_ = mk8(pg8::cvt_pk_bf16(S[2][0], S[2][1]), pg8::cvt_pk_bf16(S[2][2], S[2][3]), pg8::cvt_pk_bf16(S[3][0], S[3][1]), pg8::cvt_pk_bf16(S[3][2], S[3][3])); \
                f32x4 rhs_ = MFMA16(P##at[0], sb0_, rhs0_); rhs_ = MFMA16(P##at[1], sb1_, rhs_); \
                f32x4 y_ = MFMA16(P##rt[0], sb0_, z4_); y_ = MFMA16(P##rt[1], sb1_, y_); \
                const f32x4 sa_ = MFMA16(P##a4, mk8(0u, 0u, pg8::cvt_pk_bf16(rhs_[0], rhs_[1]), pg8::cvt_pk_bf16(rhs_[2], rhs_[3])), z4_); \
                const bf16x8 sv_ = mk8(pg8::cvt_pk_bf16(sa_[0], sa_[1]), pg8::cvt_pk_bf16(sa_[2], sa_[3]), P##vm.x, P##vm.y); \
                _Pragma("unroll") for (int i = 0; i < 4; ++i) { S[i] = MFMA16(P##bk[i], sv_, S[i]); S[i] = S[i] * P##wc[i]; } \
                y_ = MFMA16(P##rbk, sv_, y_); \
                { float* yq_ = Yp + (size_t)(cc) * (CS_C * 512); yq_[0] = y_[0]; yq_[512] = y_[1]; yq_[1024] = y_[2]; yq_[1536] = y_[3]; } } while (0)
#define CS_WAIT(fl, cc) do { while ((fl) != (unsigned)((cc) + 1)) { __builtin_amdgcn_s_sleep(1); (fl) = flags[(cc) & 7]; } asm volatile("" ::: "memory"); } while (0)
#define CS_SIGNAL(n) do { __builtin_amdgcn_s_waitcnt(0xC07F); asm volatile("" ::: "memory"); flags[8] = (unsigned)(n); asm volatile("" ::: "memory"); } while (0)
            unsigned fl = flags[0];
            CS_WAIT(fl, 0);
            if (MODE != 2) CS_LOAD(c_, 0);
            fl = flags[1];
            CS_SIGNAL(1);
#pragma unroll 1
            for (int c = 0; c < CS_NCH - 2; c += 2) {
                CS_WAIT(fl, c + 1);
                if (MODE != 2) CS_LOAD(n_, c + 1);
                fl = flags[(c + 2) & 7];
                if (MODE != 2) CS_COMPUTE(c_, c);
                CS_SIGNAL(c + 2);
                CS_WAIT(fl, c + 2);
                if (MODE != 2) CS_LOAD(c_, c + 2);
                fl = flags[(c + 3) & 7];
                if (MODE != 2) CS_COMPUTE(n_, c + 1);
                CS_SIGNAL(c + 3);
            }
            {
                CS_WAIT(fl, CS_NCH - 1);
                if (MODE != 2) CS_LOAD(n_, CS_NCH - 1);
                if (MODE != 2) CS_COMPUTE(c_, CS_NCH - 2);
                CS_SIGNAL(CS_NCH);
                if (MODE != 2) CS_COMPUTE(n_, CS_NCH - 1);
            }
#undef CS_COMPUTE
#undef CS_WAIT
#undef CS_SIGNAL
            __builtin_amdgcn_s_setprio(0);
#undef CS_LOAD
        } else {
            const int hc = h * 64 + lane;
            const unsigned uhc = (unsigned)hc;
            const int kpos = (lane & 32) | (((lane >> 2) & 3) << 3) | (((lane >> 4) & 1) << 2) | (lane & 3);
            const float mu_r = a.in[I_MU][(size_t)l * 1664 + hc], mu_k = a.in[I_MU][(size_t)l * 1664 + 512 + hc], mu_v = a.in[I_MU][(size_t)l * 1664 + 1024 + hc];
            const float kkc = a.in[I_KK][l * 512 + hc], kac = a.in[I_KA][l * 512 + hc];
            u32x2 zq[16]; unsigned aw[16]; u32x4 bl0, bl1; f32x4 rs4[4]; u32x2 cpq;
#define PLOADH(hh, cc) do { const size_t tokc_ = tok0 + (size_t)(cc) * CS_C; \
                _Pragma("unroll") for (int t = 8 * (hh); t < 8 * (hh) + 8; ++t) { zq[t] = ((const u32x2*)(Z + (tokc_ + t) * NZ + ZC_C))[uhc]; aw[t] = (AW + (tokc_ + t) * 512)[uhc]; } } while (0)
#define PLOADB(cc) do { const size_t tokc_ = tok0 + (size_t)(cc) * CS_C; const unsigned char* blk_ = (const unsigned char*)(Z + (tokc_ + h) * NZ); \
                bl0 = *(const u32x4*)(blk_ + 16 * lane); bl1 = *(const u32x4*)(blk_ + 1024 + 16 * lane); \
                _Pragma("unroll") for (int i = 0; i < 4; ++i) rs4[i] = *(const f32x4*)(blk_ + SM_RS + 16 * i); \
                cpq = (u32x2){0u, 0u}; \
                if ((cc) > 0) cpq = ((const u32x2*)(Z + (tokc_ - 1) * NZ + ZC_C))[uhc]; } while (0)
#define PTOK(t) do { \
                    const float fzr = bf2f(zq[t].x & 0xffffu), fzk = __uint_as_float(zq[t].x & 0xffff0000u), fzv = bf2f(zq[t].y & 0xffffu), al = __uint_as_float(aw[t] & 0xffff0000u), w = 1.0f - (float)(aw[t] & 0xffffu) * (1.0f / 131072.0f); \
                    const float r = fzr + mu_r * (pr - fzr), kx = fzk + mu_k * (pk - fzk), v = fzv + mu_v * (pv - fzv); \
                    pr = fzr; pk = fzk; pv = fzv; \
                    const float kk = kx * kkc * rs4[(t) >> 2][(t) & 3]; \
                    const float kp = kx * (1.0f + (al - 1.0f) * kac); \
                    const float Wp = W; W *= w; const float iW = __builtin_amdgcn_rcpf(W); \
                    const float fb = kk * al * iW, fk = kp * iW; \
                    *(unsigned short*)(sb + SL_AT + (t) * 144 + 2 * kpos) = bf1(-kk * Wp); \
                    *(unsigned short*)(sb + SL_RT + (t) * 144 + 2 * kpos) = bf1(r * W); \
                    if ((t) & 1) { btp[(t) >> 1] = pg8::cvt_pk_bf16(eb, fb); ktp[(t) >> 1] = pg8::cvt_pk_bf16(ek, fk); vp[(t) >> 1] = pg8::cvt_pk_bf16(ev, v); } \
                    else { eb = fb; ek = fk; ev = v; } } while (0)
            int c = wave - 1;
            if (MODE != 1) { PLOADB(c); PLOADH(0, c); PLOADH(1, c); }
#pragma unroll 1
            for (; c < CS_NCH; c += CS_NP) {
                unsigned char* sb = shm + (c & 7) * SL_SIZE;
                if (c >= CS_NS) { while ((int)flags[8] < c - (CS_NS - 1)) __builtin_amdgcn_s_sleep(2); }
                asm volatile("" ::: "memory");
                if (MODE != 1) {
                    const bool more = c + CS_NP < CS_NCH;
                    *(u32x4*)(sb + SL_SM + 16 * lane) = bl0; *(u32x4*)(sb + SL_SM + 1024 + 16 * lane) = bl1;
                    float pr = bf2f(cpq.x & 0xffffu), pk = __uint_as_float(cpq.x & 0xffff0000u), pv = bf2f(cpq.y & 0xffffu);
                    float W = 1.0f, eb = 0.f, ek = 0.f, ev = 0.f;
                    unsigned btp[8], ktp[8], vp[8];
#pragma unroll
                    for (int t = 0; t < 8; ++t) PTOK(t);
                    asm volatile("" ::: "memory");
                    if (more) PLOADH(0, c + CS_NP);
#pragma unroll
                    for (int t = 8; t < 16; ++t) PTOK(t);
                    asm volatile("" ::: "memory");
                    if (more) { PLOADH(1, c + CS_NP); PLOADB(c + CS_NP); }
                    {
                        unsigned char* pb = sb + SL_BK + lane * 80;
#pragma unroll
                        for (int i = 0; i < 4; ++i) *(u32x4*)(pb + 16 * i) = (u32x4){btp[2 * i], btp[2 * i + 1], ktp[2 * i], ktp[2 * i + 1]};
                        if ((lane >> 4) == q) { unsigned char* pvm = sb + SL_VM + li * 40;
#pragma unroll
                            for (int i = 0; i < 4; ++i) *(u32x2*)(pvm + 8 * i) = (u32x2){vp[2 * i], vp[2 * i + 1]}; }
                        *(float*)(sb + SL_WC + 4 * lane) = W;
                    }
                }
                __builtin_amdgcn_s_waitcnt(0xC07F); asm volatile("" ::: "memory");
                flags[c & 7] = (unsigned)(c + 1);
                asm volatile("" ::: "memory");
            }
#undef PLOADH
#undef PLOADB
#undef PTOK
        }
        __syncthreads();
    }
}

__device__ __forceinline__ void phase_branchc(const Args& a, int l, int wave, int lane) {
    const int gw = blockIdx.x * 8 + wave, NGW = gridDim.x * 8;
    const bf16_t* Z = (const bf16_t*)(a.ws + WS_Z); bf16_t* CAT = (bf16_t*)(a.ws + WS_RA); const float* Y = (const float*)(a.ws + WS_RB); const float* BON = (const float*)(a.ws + WS_BON);
    const int hc = lane * 8, head = lane >> 3;
    const f32x4 g0 = *(const f32x4*)(a.in[I_LXG] + l * 512 + hc), g1 = *(const f32x4*)(a.in[I_LXG] + l * 512 + hc + 4), b0 = *(const f32x4*)(a.in[I_LXB] + l * 512 + hc), b1 = *(const f32x4*)(a.in[I_LXB] + l * 512 + hc + 4);
    const f32x4 m0 = *(const f32x4*)(a.in[I_MU] + (size_t)l * 1664 + 1024 + hc), m1 = *(const f32x4*)(a.in[I_MU] + (size_t)l * 1664 + 1024 + hc + 4);
    constexpr int NT = 4;
    for (int mp = NT * gw; mp < M_; mp += NT * NGW) {
        f32x4 yv[NT][2]; u32x4 cw[NT][4], pw[4]; float bo[NT];
#pragma unroll
        for (int u = 0; u < NT; ++u) {
            yv[u][0] = *(const f32x4*)(Y + (size_t)(mp + u) * 512 + hc); yv[u][1] = *(const f32x4*)(Y + (size_t)(mp + u) * 512 + hc + 4);
            const u32x4* cp = (const u32x4*)(Z + (size_t)(mp + u) * NZ + ZC_C + 4 * hc);
#pragma unroll
            for (int i = 0; i < 4; ++i) cw[u][i] = cp[i];
            bo[u] = BON[(size_t)(mp + u) * 8 + head];
        }
        {
            const bool hp = (mp & (S_ - 1)) > 0; const u32x4* pp = (const u32x4*)(Z + (size_t)(mp - 1) * NZ + ZC_C + 4 * hc);
#pragma unroll
            for (int i = 0; i < 4; ++i) { pw[i] = (u32x4){0u, 0u, 0u, 0u}; if (hp) pw[i] = pp[i]; }
        }
#pragma unroll
        for (int u = 0; u < NT; ++u) {
            float y[8] = {yv[u][0][0], yv[u][0][1], yv[u][0][2], yv[u][0][3], yv[u][1][0], yv[u][1][1], yv[u][1][2], yv[u][1][3]};
            float sm = ((y[0] + y[1]) + (y[2] + y[3])) + ((y[4] + y[5]) + (y[6] + y[7]));
            sm += __shfl_xor(sm, 1); sm += __shfl_xor(sm, 2); sm += __shfl_xor(sm, 4);
            const float mean = sm * (1.0f / 64.0f); float q = 0.f;
#pragma unroll
            for (int e = 0; e < 8; ++e) { y[e] -= mean; q += y[e] * y[e]; }
            q += __shfl_xor(q, 1); q += __shfl_xor(q, 2); q += __shfl_xor(q, 4);
            const float rs = rsqrtf(q * (1.0f / 64.0f) + GN_EPS);
            float o[8];
#pragma unroll
            for (int i = 0; i < 4; ++i) {
                const u32x4 c4 = cw[u][i], p4 = u == 0 ? pw[i] : cw[u > 0 ? u - 1 : 0][i];
#pragma unroll
                for (int hh = 0; hh < 2; ++hh) {
                    const int e = 2 * i + hh; const unsigned cd = hh ? c4.w : c4.y, pd = hh ? p4.w : p4.y;
                    const float zv = bf2f(cd & 0xffffu), gc = __uint_as_float(cd & 0xffff0000u), pvv = bf2f(pd & 0xffffu);
                    const float mu = e < 4 ? m0[e & 3] : m1[e & 3], g = e < 4 ? g0[e & 3] : g1[e & 3], bb = e < 4 ? b0[e & 3] : b1[e & 3];
                    const float v = zv + mu * (pvv - zv);
                    o[e] = (y[e] * rs * g + bb + bo[u] * v) * siluf_(gc);
                }
            }
            u32x4 w; w.x = pk2(o[0], o[1]); w.y = pk2(o[2], o[3]); w.z = pk2(o[4], o[5]); w.w = pk2(o[6], o[7]);
            *(u32x4*)(CAT + (size_t)(mp + u) * 1024 + 512 + hc) = w;
        }
    }
}

__device__ __forceinline__ void phase_xnew(const Args& a, int l, int wave, int lane) {
    const int gw = blockIdx.x * 8 + wave, NGW = gridDim.x * 8;
    const float* xin = l == 0 ? a.in[I_X] : a.out; float* xout = a.out;
    const bf16_t* MIX = (const bf16_t*)(a.ws + WS_RB); bf16_t* XNB = (bf16_t*)(a.ws + WS_RA); const float* ssq = (const float*)(a.ws + WS_SSQ2);
    const float* g = a.in[I_POSTG] + l * 1024;
    for (int m = gw; m < M_; m += NGW) {
        const f32x4* sp = (const f32x4*)(ssq + (size_t)m * 16);
        const f32x4 s0 = sp[0], s1 = sp[1], s2 = sp[2], s3 = sp[3];
        const float t = ((s0[0] + s0[1]) + (s0[2] + s0[3])) + ((s1[0] + s1[1]) + (s1[2] + s1[3])) + ((s2[0] + s2[1]) + (s2[2] + s2[3])) + ((s3[0] + s3[1]) + (s3[2] + s3[3]));
        const float rstd = rsqrtf(t * (1.0f / 1024.0f) + RMS_EPS);
#pragma unroll
        for (int h = 0; h < 2; ++h) {
            const int col = h * 512 + lane * 8; const size_t off = (size_t)m * 1024 + col;
            const u32x4 mw = *(const u32x4*)(MIX + off); float mx[8]; unpack8(mw, mx);
            const f32x4 x0 = *(const f32x4*)(xin + off), x1 = *(const f32x4*)(xin + off + 4), g0 = *(const f32x4*)(g + col), g1 = *(const f32x4*)(g + col + 4);
            f32x4 o0, o1;
#pragma unroll
            for (int j = 0; j < 4; ++j) { o0[j] = x0[j] + mx[j] * rstd * g0[j]; o1[j] = x1[j] + mx[4 + j] * rstd * g1[j]; }
            *(f32x4*)(xout + off) = o0; *(f32x4*)(xout + off + 4) = o1;
            u32x4 w; w.x = pk2(o0[0], o0[1]); w.y = pk2(o0[2], o0[3]); w.z = pk2(o1[0], o1[1]); w.w = pk2(o1[2], o1[3]);
            *(u32x4*)(XNB + off) = w;
        }
    }
}

#define XB_TMO      128
#define XB_XCNT(j)  (256  + 64 * (j))
#define XB_XSUB(j)  (1280 + 64 * (j))
#define XB_XGEN(j)  (2304 + 64 * (j))
#define XB_TOP      3328
#define XB_TOPGEN   3392
#define XCD_BAR_WORDS 3456
#define XB_SPIN_CAP (1u << 18)

__device__ __forceinline__ unsigned xb_ld(unsigned* p)              { return __hip_atomic_load(p, __ATOMIC_RELAXED, __HIP_MEMORY_SCOPE_AGENT); }
__device__ __forceinline__ unsigned xb_add(unsigned* p, unsigned v) { return __hip_atomic_fetch_add(p, v, __ATOMIC_RELAXED, __HIP_MEMORY_SCOPE_AGENT); }
__device__ __forceinline__ unsigned xb_xcc_id() { return (unsigned)__builtin_amdgcn_s_getreg((3 << 11) | 20) & 0xFu; }
#define XB_SPIN(cond, bar) do { unsigned _sp = 0; while (cond) { __builtin_amdgcn_s_sleep(1); \
    if ((++_sp & 255u) == 0u) { if (xb_ld(&(bar)[XB_TMO])) break; if (_sp > XB_SPIN_CAP) { atomicAdd(&(bar)[XB_TMO], 1u); break; } } } } while (0)

struct XcdBarrier {
    unsigned* bar; unsigned x;
    volatile unsigned* st;
};

__device__ __forceinline__ XcdBarrier xcd_barrier_post(unsigned* bar, volatile unsigned* st) {
    XcdBarrier b; b.bar = bar; b.x = xb_xcc_id(); b.st = st;
    if (threadIdx.x == 0) (void)xb_add(&bar[XB_XCNT(b.x)], 1u);
    return b;
}
__device__ __forceinline__ void xcd_barrier_complete(unsigned* bar, unsigned x, unsigned& nloc, unsigned& nx) {
    const unsigned G = gridDim.x * gridDim.y * gridDim.z;
    unsigned sum, cnt, mine, sp = 0u;
    for (;;) {
        sum = 0u; cnt = 0u; mine = 0u;
#pragma unroll
        for (unsigned j = 0; j < 16; ++j) { const unsigned c = xb_ld(&bar[XB_XCNT(j)]); sum += c; cnt += (c > 0u) ? 1u : 0u; mine = (j == x) ? c : mine; }
        if (sum == G) break;
        __builtin_amdgcn_s_sleep(1);
        if ((++sp & 255u) == 0u) { if (xb_ld(&bar[XB_TMO])) break; if (sp > XB_SPIN_CAP) { atomicAdd(&bar[XB_TMO], 1u); break; } }
    }
    nloc = mine > 0u ? mine : 1u; nx = cnt > 0u ? cnt : 1u;
}

__device__ __forceinline__ void xcd_barrier(const XcdBarrier& b) {
    asm volatile("s_waitcnt vmcnt(0)" ::: "memory");
    __syncthreads();
    if (threadIdx.x == 0) {
        unsigned* bar = b.bar;
        __builtin_amdgcn_s_waitcnt(0);
        unsigned nloc = b.st[0], nx = b.st[1];
        if (nloc == 0u) { xcd_barrier_complete(bar, b.x, nloc, nx); b.st[0] = nloc; b.st[1] = nx; }
        const unsigned old = xb_add(&bar[XB_XSUB(b.x)], 1u);
        const unsigned gen = old / nloc;
        if (old + 1u == (gen + 1u) * nloc) {
            __builtin_amdgcn_fence(__ATOMIC_RELEASE, "agent");
            asm volatile("s_waitcnt vmcnt(0)" ::: "memory");
            const unsigned og = xb_add(&bar[XB_TOP], 1u);
            const unsigned tg = og / nx;
            if (og + 1u == (tg + 1u) * nx) xb_add(&bar[XB_TOPGEN], 1u);
            else XB_SPIN(xb_ld(&bar[XB_TOPGEN]) == tg, bar);
            __builtin_amdgcn_fence(__ATOMIC_ACQUIRE, "agent");
            xb_add(&bar[XB_XGEN(b.x)], 1u);
            asm volatile("s_waitcnt vmcnt(0)" ::: "memory");
        } else {
            XB_SPIN(xb_ld(&bar[XB_XGEN(b.x)]) == gen, bar);
            __builtin_amdgcn_fence(__ATOMIC_ACQUIRE, "agent");
            asm volatile("s_waitcnt vmcnt(0)" ::: "memory");
        }
    }
    __syncthreads();
}

#ifndef MK_ONE_LAUNCH
#define MK_ONE_LAUNCH 1
#endif
constexpr int cmax_(int a, int b) { return a > b ? a : b; }
constexpr int LDS_MAIN = cmax_(cmax_(CS_LDS, CV_END), cmax_((int)pg8::STAGE_BYTES, 8 * PA_SIZE));
static_assert(LDS_MAIN + 64 <= 163840, "LDS budget");
constexpr int NSP = 7, N_PHASES = 1 + NSP * L_, KALL = (1 << (NSP + 1)) - 1;
template <int KMASK>
__global__ void __launch_bounds__(512, 2) fwd_kernel(Args a) {
    extern __shared__ __attribute__((aligned(16))) unsigned char shm[];
    float* ldsf = (float*)shm;
#if MK_ONE_LAUNCH
    cg::grid_group grid = cg::this_grid();
    volatile unsigned* bst = (volatile unsigned*)(shm + LDS_MAIN);
    if (threadIdx.x < 2) bst[threadIdx.x] = 0u;
    __syncthreads();
    const XcdBarrier xbar = xcd_barrier_post((unsigned*)(a.ws + WS_CTL), bst);
    bool first_bar = true;
#define GRID_BAR() do { if (first_bar) { grid.sync(); first_bar = false; } else xcd_barrier(xbar); } while (0)
#else
#define GRID_BAR() do { } while (0)
#endif
#ifndef DUP_SP
#define DUP_SP -1
#endif
#ifdef PROBE_SP
    unsigned long long probe_acc = 0, probe_t0 = __builtin_amdgcn_s_memrealtime();
#endif
    for (int ph = a.ph_lo; ph < a.ph_hi; ++ph) {
      const int nrep = (DUP_SP >= 0 && ph > 0 && (ph - 1) % NSP == DUP_SP) ? 2 : 1;
      for (int rep = 0; rep < nrep; ++rep) {
        if (rep) GRID_BAR();
        int tid_ = threadIdx.x; asm volatile("" : "+v"(tid_));
        const int tid = tid_, wave = __builtin_amdgcn_readfirstlane(tid >> 6), lane = tid & 63;
        if (ph == 0) { if constexpr ((KMASK >> NSP) & 1) phase_prologue(a, ldsf, wave, lane); }
        else {
            const int l = (ph - 1) / NSP, sp = (ph - 1) % NSP;
            if (sp == 0) {
                if constexpr ((KMASK >> 0) & 1) {
                pg8::Gemm g{(const bf16_t*)a.out, (const bf16_t*)(a.ws + WS_WIN) + (size_t)l * NZP * 1024, M_, NZP, 1024};
                pg8::StaticOrder S; S.init(M_, NZP, (int)gridDim.x, (int)blockIdx.x);
                EpiZ E{(bf16_t*)(a.ws + WS_Z), (const float*)(a.ws + WS_SSQ1)};
                pg8::gemm_phase<EpiZ, pg8::StaticOrder, false>((PG8_LAS unsigned char*)shm, g, S, E, nullptr);
                }
            } else if (sp == 1) {
                if constexpr ((KMASK >> 1) & 1) {
                for (int it = blockIdx.x; it < 256; it += gridDim.x) sgu_item(a, l, it, shm, tid, wave, lane);
#ifdef CONV_SKIP
                conv_phase<CONV_SKIP>(a, l, shm, tid, wave, lane); GRID_BAR();
#endif
                conv_phase<0>(a, l, shm, tid, wave, lane);
                }
            } else if (sp == 2) {
                if constexpr ((KMASK >> 2) & 1) scanprep_phase(a, l, shm, wave, lane);
            } else if (sp == 3) {
                if constexpr ((KMASK >> 3) & 1) {
#ifdef CSCAN_PROBE
                    cscan_phase<CSCAN_PROBE>(a, l, shm, tid, wave, lane); GRID_BAR();
#endif
                    cscan_phase<0>(a, l, shm, tid, wave, lane);
                }
            } else if (sp == 4) {
                if constexpr ((KMASK >> 4) & 1) phase_branchc(a, l, wave, lane);
            } else if (sp == 5) {
                if constexpr ((KMASK >> 5) & 1) {
#pragma unroll 1
                for (int rd = 0; rd < 2; ++rd) {
                    pg8::Gemm g{(const bf16_t*)(a.ws + WS_RA), (const bf16_t*)(a.ws + WS_WOUT) + (size_t)l * 1024 * 1024, M_, 1024, 1024};
                    RoundOrder S; S.base.init(M_, 1024, (int)gridDim.x, (int)blockIdx.x); S.round = rd;
                    EpiXnew E{(const bf16_t*)a.out, (bf16_t*)(a.ws + WS_RB), a.in[I_POSTG] + l * 1024, (float*)(a.ws + WS_XCH), (unsigned*)(a.ws + WS_CNT) + (size_t)l * 128 * 64};
                    pg8::gemm_phase<EpiXnew, RoundOrder, false>((PG8_LAS unsigned char*)shm, g, S, E, nullptr);
                }
                {
                    pg8::Gemm g{(const bf16_t*)(a.ws + WS_PB), (const bf16_t*)(a.ws + WS_WP) + (size_t)l * 1024 * 256, M_, 1024, 256};
                    pg8::StaticOrder S; S.init(M_, 1024, (int)gridDim.x, (int)blockIdx.x);
                    EpiPlain E{(bf16_t*)(a.ws + WS_PP)};
                    pg8::gemm_phase<EpiPlain, pg8::StaticOrder, false>((PG8_LAS unsigned char*)shm, g, S, E, nullptr);
                }
                }
            } else {
                if constexpr ((KMASK >> 6) & 1) {
                pg8::Gemm g{(const bf16_t*)(a.ws + WS_RB), (const bf16_t*)(a.ws + WS_WG) + (size_t)l * 1024 * 1024, M_, 1024, 1024};
                pg8::StaticOrder S; S.init(M_, 1024, (int)gridDim.x, (int)blockIdx.x);
                EpiOut E{(const bf16_t*)(a.ws + WS_RB), (const bf16_t*)(a.ws + WS_PP), (bf16_t*)a.out, l == L_ - 1 ? a.out : nullptr, (float*)(a.ws + WS_SSQ1), a.in[I_GB] + l * 1024};
                pg8::gemm_phase<EpiOut, pg8::StaticOrder, false>((PG8_LAS unsigned char*)shm, g, S, E, nullptr);
                }
            }
        }
      }
        if (ph + 1 < a.ph_hi) GRID_BAR();
#ifdef PROBE_SP
        { const unsigned long long tnow = __builtin_amdgcn_s_memrealtime(); if ((ph == 0 && PROBE_SP < 0) || (ph > 0 && (ph - 1) % NSP == PROBE_SP)) probe_acc += tnow - probe_t0; probe_t0 = tnow; }
#endif
    }
#ifdef PROBE_SP
    { const unsigned long long t0 = __builtin_amdgcn_s_memrealtime(); while (__builtin_amdgcn_s_memrealtime() - t0 < probe_acc) __builtin_amdgcn_s_sleep(8); }
#endif
}

template <int KMASK> static bool prep_kernel(int lds_bytes) {
    return hipFuncSetAttribute((const void*)fwd_kernel<KMASK>, hipFuncAttributeMaxDynamicSharedMemorySize, lds_bytes) == hipSuccess;
}
template <int K> static void launch_kind(int kind, int grid, int lds, hipStream_t st, const Args& a) {
    if constexpr (K <= NSP) { if (kind == K) hipLaunchKernelGGL(fwd_kernel<(1 << K)>, dim3(grid), dim3(512), lds, st, a); else launch_kind<K + 1>(kind, grid, lds, st, a); }
}
template <int K> static bool prep_all(int lds) { if constexpr (K <= NSP) return prep_kernel<(1 << K)>(lds) && prep_all<K + 1>(lds); else return true; }

extern "C" void kernel_launch(void* const* d_in, const int* in_sizes, int n_in, void* d_out, int out_size, void* d_ws, size_t ws_size, hipStream_t stream) {
    static int grid = 0;
    constexpr int LDS_BYTES = LDS_MAIN + 64;
    if (grid == 0) {
        if (n_in != N_IN || out_size != M_ * D_ || ws_size < WS_END) { fprintf(stderr, "kernel_launch: unexpected shapes (n_in %d, out %d, ws %zu < %zu)\n", n_in, out_size, ws_size, (size_t)WS_END); grid = -1; return; }
        int dev = 0, cus = 0;
        (void)hipGetDevice(&dev); (void)hipDeviceGetAttribute(&cus, hipDeviceAttributeMultiprocessorCount, dev);
#if MK_ONE_LAUNCH
        bool ok = prep_kernel<KALL>(LDS_BYTES);
        int per_cu = 0;
        (void)hipOccupancyMaxActiveBlocksPerMultiprocessor(&per_cu, (const void*)fwd_kernel<KALL>, 512, LDS_BYTES);
        (void)hipGetLastError();
        if (per_cu < 1) { fprintf(stderr, "kernel_launch: occupancy query says %d blocks per CU\n", per_cu); ok = false; }
#else
        bool ok = prep_all<0>(LDS_BYTES);
#endif
        if (!ok) { fprintf(stderr, "kernel_launch: kernel set-up failed\n"); grid = -1; return; }
        grid = cus;
    }
    if (grid < 0) return;
    Args a{};
    for (int i = 0; i < N_IN; ++i) a.in[i] = (const float*)d_in[i];
    a.out = (float*)d_out; a.ws = (unsigned char*)d_ws;
#if MK_ONE_LAUNCH
    (void)hipMemsetAsync(d_ws, 0, XCD_BAR_WORDS * 4, stream);
    (void)hipMemsetAsync((unsigned char*)d_ws + WS_CNT, 0, (size_t)L_ * 128 * 256, stream);
    a.ph_lo = 0; a.ph_hi = N_PHASES;
    void* args[] = {&a};
    hipError_t e = hipLaunchCooperativeKernel((const void*)fwd_kernel<KALL>, dim3(grid), dim3(512), args, LDS_BYTES, stream);
    if (e != hipSuccess) fprintf(stderr, "cooperative launch failed: %s (grid %d)\n", hipGetErrorString(e), grid);
#else
    for (int ph = 0; ph < N_PHASES; ++ph) {
        a.ph_lo = ph; a.ph_hi = ph + 1;
        launch_kind<0>(ph == 0 ? NSP : (ph - 1) % NSP, grid, LDS_BYTES, stream, a);
    }
#endif
}
```

```cpp
#include <hip/hip_runtime.h>
#include <hip/hip_cooperative_groups.h>
#include <cstdio>
namespace cg = cooperative_groups;
namespace pg8 {
#define PG8_LAS __attribute__((address_space(3)))
typedef unsigned short bf16_t;
typedef short bf16x8 __attribute__((ext_vector_type(8)));
typedef float f32x4 __attribute__((ext_vector_type(4)));
typedef unsigned u32x4 __attribute__((ext_vector_type(4)));
constexpr int BM = 256, BK = 64, HALF = 128, HTB = HALF * BK * 2  , STAGE_BYTES = 8 * HTB, NXCD = 8, WGM = 8;

__host__ __device__ __forceinline__ int lds_byte(int r, int c) { const int st = (r >> 4) * 2 + (c >> 5), rr = r & 15, cc = c & 31, ob = rr * 64 + cc * 2; return st * 1024 + (ob ^ (((ob >> 9) & 1) << 5)); }
__host__ __device__ __forceinline__ void stage_rc(int b, int& R, int& C) { const int st = b / 1024, sb = b % 1024, swz = sb ^ (((sb >> 9) & 1) << 5); R = (st >> 1) * 16 + swz / 64; C = (st & 1) * 32 + (swz % 64) / 2; }
__host__ __device__ __forceinline__ int perm32(int rho) { const int n = rho >> 4, i = rho & 15; return 8 * (i >> 2) + 4 * n + (i & 3); }

struct Unit { int pm, pn; };
struct Gemm { const bf16_t* A; const bf16_t* Bt; int M, N, K; };

struct StaticOrder {
    int nM, nN, nwg, G, c;
    __host__ __device__ void init(int M, int N, int G_, int c_) { nM = M / BM; nN = N / BM; nwg = nM * nN; G = G_; c = c_; }
    __host__ __device__ bool next(int i, Unit& u) const {
        const long L = (long)i * G + c; if (L >= nwg) return false;
        int wgid = (int)L; { const int q = nwg / NXCD, r = nwg % NXCD, xcd = wgid % NXCD, off = wgid / NXCD; wgid = (xcd < r ? xcd * (q + 1) : r * (q + 1) + (xcd - r) * q) + off; }
        const int nig = WGM * nN, gid = wgid / nig, fm = gid * WGM, gsz = (nM - fm) < WGM ? (nM - fm) : WGM;
        u.pm = fm + ((wgid % nig) % gsz); u.pn = (wgid % nig) / gsz; return true;
    }
    __device__ __forceinline__ void a_ready(const Unit&) const {}
    __device__ __forceinline__ void done(const Unit&) const {}
};
typedef __bf16 bf16x2_t __attribute__((ext_vector_type(2)));
__device__ __forceinline__ unsigned cvt_pk_bf16(float lo, float hi) { typedef float f32x2_t __attribute__((ext_vector_type(2))); return __builtin_bit_cast(unsigned, __builtin_convertvector((f32x2_t){lo, hi}, bf16x2_t)); }
typedef float f32x2 __attribute__((ext_vector_type(2)));
template <class Epi, class Sched, bool STAMP = false>
__device__ __forceinline__ void gemm_phase(PG8_LAS unsigned char* lds, const Gemm g, const Sched& S, const Epi& E, unsigned long long* stamps) {
    int tid_ = threadIdx.x; asm volatile("" : "+v"(tid_));
    const int tid = tid_, wid = __builtin_amdgcn_readfirstlane(tid >> 6), lane = tid & 63, wr = wid >> 2, wc = wid & 3, fr = lane & 15, fq = lane >> 4;
    const int K = g.K, nt = K / BK;
    int ts_lo = 0, ts_hi = 0, nts = 0; const unsigned long long rt_entry = STAMP ? (unsigned long long)wall_clock64() : 0ull;
#define PG8_STAMP() do { if (STAMP && wid == 0 && nts < 64) { const unsigned long long _c = (unsigned long long)clock64(); \
        ts_lo = (lane == nts) ? (int)(unsigned)_c : ts_lo; ts_hi = (lane == nts) ? (int)(unsigned)(_c >> 32) : ts_hi; ++nts; } } while (0)
    PG8_STAMP();
    unsigned voffA[2], voffB[2];
#pragma unroll
    for (int i = 0; i < 2; ++i) { int R, C; stage_rc(tid * 16 + i * 8192, R, C); const int Rb = Epi::PERM ? ((R & ~31) + perm32(R & 31)) : R;
        voffA[i] = (unsigned)(R * K + C) * 2u; voffB[i] = (unsigned)(Rb * K + C) * 2u; }
    const size_t kstep = (size_t)(BK * 2);
    const size_t hstep = (size_t)HALF * K * 2;
    const size_t tstep = 2 * hstep;
    const unsigned ldsw = (unsigned)wid * 1024u;
    const int aoff = lds_byte(wr * 64 + fr, fq * 8), boff = lds_byte(wc * 32 + fr, fq * 8);
#define PG8_SA(b, h) (((b) * 2 + (h)) * HTB)
#define PG8_SB(b, h) ((4 + (b) * 2 + (h)) * HTB)
#define PG8_STAGE(bufoff, gbase, voff) do { _Pragma("unroll") for (int _i = 0; _i < 2; ++_i) \
        __builtin_amdgcn_global_load_lds((const unsigned*)((const char*)(gbase) + (voff)[_i]), (PG8_LAS unsigned*)(lds + (bufoff) + ldsw + _i * 8192), 16, 0, 0); } while (0)
#define PG8_LDA(dst, b, h) do { _Pragma("unroll") for (int m = 0; m < 4; ++m) _Pragma("unroll") for (int k = 0; k < 2; ++k) dst[m][k] = *(const PG8_LAS bf16x8*)(lds + PG8_SA(b, h) + aoff + m * 2048 + k * 1024); } while (0)
#define PG8_LDB(dst, b, h) do { _Pragma("unroll") for (int n = 0; n < 2; ++n) _Pragma("unroll") for (int k = 0; k < 2; ++k) dst[n][k] = *(const PG8_LAS bf16x8*)(lds + PG8_SB(b, h) + boff + n * 2048 + k * 1024); } while (0)
#define PG8_MMA(ai, bj, At, Bt) do { __builtin_amdgcn_s_setprio(1); _Pragma("unroll") for (int m = 0; m < 4; ++m) _Pragma("unroll") for (int n = 0; n < 2; ++n) _Pragma("unroll") for (int k = 0; k < 2; ++k) \
        acc[ai][bj][m][n] = __builtin_amdgcn_mfma_f32_16x16x32_bf16(Bt[n][k], At[m][k], acc[ai][bj][m][n], 0, 0, 0); __builtin_amdgcn_s_setprio(0); } while (0)
#define PG8_WAIT_V(n) asm volatile("s_waitcnt vmcnt(" #n ")" ::: "memory")
#define PG8_WAIT_L(n) asm volatile("s_waitcnt lgkmcnt(" #n ")" ::: "memory")
#define PG8_BAR __builtin_amdgcn_s_barrier()
#define PG8_SCHED __builtin_amdgcn_sched_barrier(0)
    Unit cur, nxt; int ui = 0;
    if (!S.next(0, cur)) return;
    f32x4 acc[2][2][4][2];
#pragma unroll
    for (int a = 0; a < 2; ++a)
#pragma unroll
        for (int b = 0; b < 2; ++b)
#pragma unroll
            for (int m = 0; m < 4; ++m)
#pragma unroll
                for (int n = 0; n < 2; ++n) acc[a][b][m][n] = (f32x4){0.f, 0.f, 0.f, 0.f};
    bf16x8 At[4][2], B0[2][2], B1[2][2];
    const char* cA = (const char*)g.A + (size_t)cur.pm * tstep; const char* cB = (const char*)g.Bt + (size_t)cur.pn * tstep;
    S.a_ready(cur);
    PG8_STAGE(PG8_SB(0, 0), cB, voffB); PG8_STAGE(PG8_SA(0, 0), cA, voffA); PG8_STAGE(PG8_SB(0, 1), cB + hstep, voffB); PG8_STAGE(PG8_SA(0, 1), cA + hstep, voffA);
    if (wr == 1) PG8_BAR;
    PG8_WAIT_V(4); PG8_BAR;
    PG8_STAGE(PG8_SB(1, 0), cB + kstep, voffB); PG8_STAGE(PG8_SA(1, 0), cA + kstep, voffA); PG8_STAGE(PG8_SB(1, 1), cB + hstep + kstep, voffB);
    PG8_WAIT_V(6); PG8_BAR;
    PG8_STAMP();
    for (;;) {
        const bool has_next = S.next(ui + 1, nxt);
        const char* nA = has_next ? (const char*)g.A + (size_t)nxt.pm * tstep : cA; const char* nB = has_next ? (const char*)g.Bt + (size_t)nxt.pn * tstep : cB;
        for (int t = 0; t < nt; t += 2) {
            const bool last = (t == nt - 2);
            const char* a1 = cA + (size_t)(t + 1) * kstep;
            const char* a2 = last ? nA : cA + (size_t)(t + 2) * kstep; const char* b2 = last ? nB : cB + (size_t)(t + 2) * kstep;
            const char* a3 = a2 + kstep; const char* b3 = b2 + kstep;
            if (last && has_next) S.a_ready(nxt);
            PG8_LDB(B0, 0, 0); PG8_SCHED; PG8_LDA(At, 0, 0); PG8_STAGE(PG8_SA(1, 1), a1 + hstep, voffA);
            PG8_WAIT_L(8); PG8_BAR; PG8_WAIT_L(0); PG8_MMA(0, 0, At, B0); PG8_BAR; PG8_SCHED;
            PG8_LDB(B1, 0, 1); PG8_STAGE(PG8_SB(0, 0), b2, voffB);
            PG8_BAR; PG8_WAIT_L(0); PG8_MMA(0, 1, At, B1); PG8_BAR;
            PG8_LDA(At, 0, 1); PG8_STAGE(PG8_SA(0, 0), a2, voffA);
            PG8_BAR; PG8_WAIT_L(0); PG8_MMA(1, 0, At, B0); PG8_BAR; PG8_SCHED;
            PG8_STAGE(PG8_SB(0, 1), b2 + hstep, voffB);
            PG8_WAIT_V(6); PG8_BAR; PG8_MMA(1, 1, At, B1); PG8_BAR;
            PG8_LDB(B0, 1, 0); PG8_SCHED; PG8_LDA(At, 1, 0); PG8_STAGE(PG8_SA(0, 1), a2 + hstep, voffA);
            PG8_WAIT_L(8); PG8_BAR; PG8_WAIT_L(0); PG8_MMA(0, 0, At, B0); PG8_BAR; PG8_SCHED;
            PG8_LDB(B1, 1, 1); PG8_STAGE(PG8_SB(1, 0), b3, voffB);
            PG8_BAR; PG8_WAIT_L(0); PG8_MMA(0, 1, At, B1); PG8_BAR;
            PG8_LDA(At, 1, 1); PG8_STAGE(PG8_SA(1, 0), a3, voffA);
            PG8_BAR; PG8_WAIT_L(0); PG8_MMA(1, 0, At, B0); PG8_BAR; PG8_SCHED;
            PG8_STAGE(PG8_SB(1, 1), b3 + hstep, voffB);
            PG8_WAIT_V(6); PG8_BAR; PG8_MMA(1, 1, At, B1); PG8_BAR;
        }
        PG8_STAMP();
        if constexpr (!Epi::AFTER_DRAIN) { E(acc, cur, wr, wc, fr, fq); S.done(cur); }
        PG8_STAMP();
        if (!has_next) break;
#pragma unroll
        for (int a = 0; a < 2; ++a)
#pragma unroll
            for (int b = 0; b < 2; ++b)
#pragma unroll
                for (int m = 0; m < 4; ++m)
#pragma unroll
                    for (int n = 0; n < 2; ++n) acc[a][b][m][n] = (f32x4){0.f, 0.f, 0.f, 0.f};
        cur = nxt; cA = nA; cB = nB; ++ui;
    }
    PG8_WAIT_V(0);
    if (wr == 0) PG8_BAR;
    PG8_BAR;
    if constexpr (Epi::AFTER_DRAIN) { E.fused(acc, cur, wr, wc, fr, fq, lds, wid, lane); S.done(cur); }
    PG8_STAMP();
    if (STAMP && wid == 0) { stamps[lane] = lane < nts ? (((unsigned long long)(unsigned)ts_hi << 32) | (unsigned)ts_lo) : 0ull;
        if (lane == 62) stamps[62] = rt_entry; if (lane == 63) stamps[63] = (unsigned long long)wall_clock64(); }
#undef PG8_STAMP
#undef PG8_SA
#undef PG8_SB
#undef PG8_STAGE
#undef PG8_LDA
#undef PG8_LDB
#undef PG8_MMA
#undef PG8_WAIT_V
#undef PG8_WAIT_L
#undef PG8_BAR
#undef PG8_SCHED
}
}

using pg8::bf16_t; using pg8::f32x4; using pg8::u32x4; using pg8::Unit;
typedef unsigned u32x2 __attribute__((ext_vector_type(2)));

constexpr int M_ = 32768, D_ = 1024, S_ = 4096, L_ = 4;
constexpr int NZ = 3712, NZP = 3840;
constexpr int ZC_U = 0, ZC_V = 256, ZC_GA = 512, ZC_VAL = 768, ZC_GLU = 1024, ZC_GB = 1280, ZC_RK = 1536  , ZC_VG = 2560  , ZC_WD = 3584, ZC_AD = 3648;
constexpr float RMS_EPS = 1e-6f, LN_EPS = 1e-5f, GN_EPS = 64e-5f, DECAY_SCALE = 0.6065306597126334f;

enum { I_X = 0, I_P, I_PREG, I_WIN, I_SLNG, I_SLNB, I_SGUW, I_SGUB, I_CW, I_CB, I_CLNG, I_CLNB, I_PWW, I_PWB, I_MU, I_W0, I_WUP, I_A0, I_AUP, I_KK, I_KA, I_RK, I_LXG, I_LXB, I_WOUT, I_POSTG, I_PLEW, I_GW, I_GB, N_IN };

constexpr size_t WS_CTL = 0;
constexpr size_t WS_WIN = 65536;
constexpr size_t WS_WOUT = WS_WIN + (size_t)L_ * NZP * 1024 * 2;
constexpr size_t WS_WG = WS_WOUT + (size_t)L_ * 1024 * 1024 * 2;
constexpr size_t WS_WP = WS_WG + (size_t)L_ * 1024 * 1024 * 2;
constexpr size_t WS_SSQ1 = WS_WP + (size_t)L_ * 1024 * 256 * 2;
constexpr size_t WS_SSQ2 = WS_SSQ1 + (size_t)M_ * 16 * 4;
constexpr size_t WS_Z = WS_SSQ2 + (size_t)M_ * 16 * 4;
constexpr size_t WS_RA = WS_Z + (size_t)M_ * NZ * 2;
constexpr size_t WS_RB = WS_RA + (size_t)M_ * 1024 * 2;
constexpr size_t WS_WQ = WS_RB + (size_t)M_ * 1024 * 2;
constexpr size_t WS_AQ = WS_WQ + (size_t)M_ * 512 * 2;
constexpr size_t WS_PB = WS_AQ + (size_t)M_ * 512 * 2;
constexpr size_t WS_BON = WS_PB + (size_t)M_ * 256 * 2;
constexpr size_t WS_SGUW = WS_BON + (size_t)M_ * 8 * 4;
constexpr size_t WS_WPW = WS_SGUW + (size_t)L_ * 4 * 128 * 128 * 2;
constexpr size_t WS_WUP = WS_WPW + (size_t)L_ * 256 * 256 * 2;
constexpr size_t WS_AUP = WS_WUP + (size_t)L_ * 512 * 64 * 2;
constexpr size_t WS_XCH = WS_AUP + (size_t)L_ * 512 * 64 * 2;
constexpr size_t WS_CNT = WS_XCH + (size_t)128 * 256 * 4 * 4;
constexpr size_t WS_END = WS_CNT + (size_t)L_ * 128 * 256;
constexpr size_t WS_PP = WS_Z;

struct Args { const float* in[N_IN]; float* out; unsigned char* ws; int ph_lo, ph_hi; };
static_assert(sizeof(Args) == 8 * N_IN + 8 + 8 + 8, "no padding");

__device__ __forceinline__ float bf2f(unsigned h) { return __uint_as_float(h << 16); }
__device__ __forceinline__ unsigned f2bf(float f) { return pg8::cvt_pk_bf16(f, f) & 0xffffu; }
__device__ __forceinline__ unsigned pk2(float lo, float hi) { return pg8::cvt_pk_bf16(lo, hi); }
__device__ __forceinline__ float wave_sum(float v) {
#pragma unroll
    for (int o = 1; o < 64; o <<= 1) v += __shfl_xor(v, o);
    return v;
}
__device__ __forceinline__ float sigmoidf_(float x) { return __builtin_amdgcn_rcpf(1.0f + __expf(-x)); }
__device__ __forceinline__ float siluf_(float x) { return x * __builtin_amdgcn_rcpf(1.0f + __expf(-x)); }
__device__ __forceinline__ void unpack8(const u32x4 w, float (&o)[8]) {
    o[0] = bf2f(w.x & 0xffffu); o[1] = __uint_as_float(w.x & 0xffff0000u); o[2] = bf2f(w.y & 0xffffu); o[3] = __uint_as_float(w.y & 0xffff0000u);
    o[4] = bf2f(w.z & 0xffffu); o[5] = __uint_as_float(w.z & 0xffff0000u); o[6] = bf2f(w.w & 0xffffu); o[7] = __uint_as_float(w.w & 0xffff0000u);
}
__device__ __forceinline__ void unpack4(const u32x2 w, float (&o)[4]) {
    o[0] = bf2f(w.x & 0xffffu); o[1] = __uint_as_float(w.x & 0xffff0000u); o[2] = bf2f(w.y & 0xffffu); o[3] = __uint_as_float(w.y & 0xffff0000u);
}

struct EpiZ {
    static constexpr bool PERM = true, AFTER_DRAIN = false;
    bf16_t* Z; const float* ssq;
    __device__ __forceinline__ void operator()(const f32x4 (&acc)[2][2][4][2], const Unit& u, int wr, int wc, int fr, int fq) const {
        const int row0 = u.pm * 256 + wr * 64 + fr, col0 = u.pn * 256 + wc * 32 + 8 * fq;
#pragma unroll
        for (int ai = 0; ai < 2; ++ai)
#pragma unroll
            for (int m = 0; m < 4; ++m) {
                const int row = row0 + ai * 128 + m * 16;
                const f32x4* sp = (const f32x4*)(ssq + (size_t)row * 16);
                const f32x4 s0 = sp[0], s1 = sp[1], s2 = sp[2], s3 = sp[3];
                const float t = ((s0[0] + s0[1]) + (s0[2] + s0[3])) + ((s1[0] + s1[1]) + (s1[2] + s1[3])) + ((s2[0] + s2[1]) + (s2[2] + s2[3])) + ((s3[0] + s3[1]) + (s3[2] + s3[3]));
                const float rstd = rsqrtf(t * (1.0f / 1024.0f) + RMS_EPS);
#pragma unroll
                for (int bj = 0; bj < 2; ++bj) {
                    const int col = col0 + bj * 128;
                    if (col < NZ) {
                        const f32x4 v0 = acc[ai][bj][m][0] * rstd, v1 = acc[ai][bj][m][1] * rstd;
                        u32x4 w; w.x = pg8::cvt_pk_bf16(v0[0], v0[1]); w.y = pg8::cvt_pk_bf16(v0[2], v0[3]); w.z = pg8::cvt_pk_bf16(v1[0], v1[1]); w.w = pg8::cvt_pk_bf16(v1[2], v1[3]);
                        *(u32x4*)(Z + (size_t)row * NZ + col) = w;
                    }
                }
            }
    }
};
struct EpiMix {
    static constexpr bool PERM = true, AFTER_DRAIN = false;
    bf16_t* O; float* ssq;
    __device__ __forceinline__ void operator()(const f32x4 (&acc)[2][2][4][2], const Unit& u, int wr, int wc, int fr, int fq) const {
        const int row0 = u.pm * 256 + wr * 64 + fr, col0 = u.pn * 256 + wc * 32 + 8 * fq;
#pragma unroll
        for (int ai = 0; ai < 2; ++ai)
#pragma unroll
            for (int m = 0; m < 4; ++m) {
                const int row = row0 + ai * 128 + m * 16; float q = 0.f;
#pragma unroll
                for (int bj = 0; bj < 2; ++bj) {
                    const f32x4 v0 = acc[ai][bj][m][0], v1 = acc[ai][bj][m][1];
                    q += (v0[0] * v0[0] + v0[1] * v0[1]) + (v0[2] * v0[2] + v0[3] * v0[3]) + (v1[0] * v1[0] + v1[1] * v1[1]) + (v1[2] * v1[2] + v1[3] * v1[3]);
                    u32x4 w; w.x = pg8::cvt_pk_bf16(v0[0], v0[1]); w.y = pg8::cvt_pk_bf16(v0[2], v0[3]); w.z = pg8::cvt_pk_bf16(v1[0], v1[1]); w.w = pg8::cvt_pk_bf16(v1[2], v1[3]);
                    *(u32x4*)(O + (size_t)row * 1024 + col0 + bj * 128) = w;
                }
                q += __shfl_xor(q, 16); q += __shfl_xor(q, 32);
                if (fq == 0) ssq[(size_t)row * 16 + u.pn * 4 + wc] = q;
            }
    }
};
struct EpiPlain {
    static constexpr bool PERM = true, AFTER_DRAIN = false;
    bf16_t* O;
    __device__ __forceinline__ void operator()(const f32x4 (&acc)[2][2][4][2], const Unit& u, int wr, int wc, int fr, int fq) const {
        const int row0 = u.pm * 256 + wr * 64 + fr, col0 = u.pn * 256 + wc * 32 + 8 * fq;
#pragma unroll
        for (int ai = 0; ai < 2; ++ai)
#pragma unroll
            for (int m = 0; m < 4; ++m) {
                const int row = row0 + ai * 128 + m * 16;
#pragma unroll
                for (int bj = 0; bj < 2; ++bj) {
                    const f32x4 v0 = acc[ai][bj][m][0], v1 = acc[ai][bj][m][1];
                    u32x4 w; w.x = pg8::cvt_pk_bf16(v0[0], v0[1]); w.y = pg8::cvt_pk_bf16(v0[2], v0[3]); w.z = pg8::cvt_pk_bf16(v1[0], v1[1]); w.w = pg8::cvt_pk_bf16(v1[2], v1[3]);
                    *(u32x4*)(O + (size_t)row * 1024 + col0 + bj * 128) = w;
                }
            }
    }
};
struct EpiOut {
    static constexpr bool PERM = true, AFTER_DRAIN = false;
    const bf16_t* XN; const bf16_t* PP; bf16_t* XB; float* XF; float* ssq; const float* bias;
    __device__ __forceinline__ void operator()(const f32x4 (&acc)[2][2][4][2], const Unit& u, int wr, int wc, int fr, int fq) const {
        const int row0 = u.pm * 256 + wr * 64 + fr, col0 = u.pn * 256 + wc * 32 + 8 * fq;
        f32x4 bv[2][2];
#pragma unroll
        for (int bj = 0; bj < 2; ++bj)
#pragma unroll
            for (int n = 0; n < 2; ++n) bv[bj][n] = *(const f32x4*)(bias + col0 + bj * 128 + 4 * n);
#pragma unroll
        for (int ai = 0; ai < 2; ++ai)
#pragma unroll
            for (int m = 0; m < 4; ++m) {
                const int row = row0 + ai * 128 + m * 16; float q = 0.f;
#pragma unroll
                for (int bj = 0; bj < 2; ++bj) {
                    const size_t off = (size_t)row * 1024 + col0 + bj * 128;
                    const f32x4 g0 = acc[ai][bj][m][0] + bv[bj][0], g1 = acc[ai][bj][m][1] + bv[bj][1];
                    float xr[8], pp[8]; unpack8(*(const u32x4*)(XN + off), xr); unpack8(*(const u32x4*)(PP + off), pp);
                    f32x4 o0, o1;
#pragma unroll
                    for (int j = 0; j < 4; ++j) { o0[j] = xr[j] + pp[j] * sigmoidf_(g0[j]); o1[j] = xr[4 + j] + pp[4 + j] * sigmoidf_(g1[j]); }
                    if (XF) { *(f32x4*)(XF + off) = o0; *(f32x4*)(XF + off + 4) = o1; }
                    else {
                        u32x4 w; w.x = pg8::cvt_pk_bf16(o0[0], o0[1]); w.y = pg8::cvt_pk_bf16(o0[2], o0[3]); w.z = pg8::cvt_pk_bf16(o1[0], o1[1]); w.w = pg8::cvt_pk_bf16(o1[2], o1[3]);
                        *(u32x4*)(XB + off) = w;
                        q += (o0[0] * o0[0] + o0[1] * o0[1]) + (o0[2] * o0[2] + o0[3] * o0[3]) + (o1[0] * o1[0] + o1[1] * o1[1]) + (o1[2] * o1[2] + o1[3] * o1[3]);
                    }
                }
                if (!XF) { q += __shfl_xor(q, 16); q += __shfl_xor(q, 32); if (fq == 0) ssq[(size_t)row * 16 + u.pn * 4 + wc] = q; }
            }
    }
};


struct EpiXnew {
    static constexpr bool PERM = true, AFTER_DRAIN = true;
    const bf16_t* xin; bf16_t* XNB; const float* g; float* xbuf; unsigned* cnt;
    __device__ __forceinline__ void fused(f32x4 (&acc)[2][2][4][2], const Unit& u, int wr, int wc, int fr, int fq, PG8_LAS unsigned char* lds, int wid, int lane) const {
        PG8_LAS float* P = (PG8_LAS float*)lds;
        PG8_LAS float* Sr = (PG8_LAS float*)(lds + 4096);
#pragma unroll
        for (int ai = 0; ai < 2; ++ai)
#pragma unroll
            for (int m = 0; m < 4; ++m) {
                float q = 0.f;
#pragma unroll
                for (int bj = 0; bj < 2; ++bj)
#pragma unroll
                    for (int n = 0; n < 2; ++n) { const f32x4 v = acc[ai][bj][m][n]; q += (v[0] * v[0] + v[1] * v[1]) + (v[2] * v[2] + v[3] * v[3]); }
                q += __shfl_xor(q, 16); q += __shfl_xor(q, 32);
                if (fq == 0) P[(ai * 128 + wr * 64 + m * 16 + fr) * 4 + wc] = q;
            }
        asm volatile("s_waitcnt lgkmcnt(0)" ::: "memory"); __builtin_amdgcn_s_barrier(); asm volatile("" ::: "memory");
        const int row = wid * 32 + (lane & 31);
        if (lane < 32) {
            const float t = (P[row * 4 + 0] + P[row * 4 + 1]) + (P[row * 4 + 2] + P[row * 4 + 3]);
            __hip_atomic_store(xbuf + ((size_t)(u.pm * 256 + row) * 4 + u.pn), t, __ATOMIC_RELAXED, __HIP_MEMORY_SCOPE_AGENT);
        }
        asm volatile("s_waitcnt vmcnt(0)" ::: "memory");
        if (lane == 0) __hip_atomic_fetch_add(cnt + 64 * u.pm, 1u, __ATOMIC_RELAXED, __HIP_MEMORY_SCOPE_AGENT);
        if (wid == 0) {
            unsigned spins = 0;
            while ((unsigned)__builtin_amdgcn_readfirstlane(__hip_atomic_load(cnt + 64 * u.pm, __ATOMIC_RELAXED, __HIP_MEMORY_SCOPE_AGENT)) < 32u) { __builtin_amdgcn_s_sleep(2); if (++spins > (1u << 22)) break; }
            __builtin_amdgcn_fence(__ATOMIC_ACQUIRE, "agent");
        }
        asm volatile("s_waitcnt vmcnt(0) lgkmcnt(0)" ::: "memory"); __builtin_amdgcn_s_barrier(); asm volatile("" ::: "memory");
        if (lane < 32) {
            const float* slot = xbuf + (size_t)(u.pm * 256 + row) * 4; float t = 0.f;
#pragma unroll
            for (int k = 0; k < 4; ++k) t += __hip_atomic_load(slot + k, __ATOMIC_RELAXED, __HIP_MEMORY_SCOPE_AGENT);
            Sr[row] = rsqrtf(t * (1.0f / 1024.0f) + RMS_EPS);
        }
        asm volatile("s_waitcnt lgkmcnt(0)" ::: "memory"); __builtin_amdgcn_s_barrier(); asm volatile("" ::: "memory");
        float rs[2][4];
#pragma unroll
        for (int ai = 0; ai < 2; ++ai)
#pragma unroll
            for (int m = 0; m < 4; ++m) rs[ai][m] = Sr[ai * 128 + wr * 64 + m * 16 + fr];
        asm volatile("s_waitcnt lgkmcnt(0)" ::: "memory"); __builtin_amdgcn_s_barrier(); asm volatile("" ::: "memory");
        const int col0 = u.pn * 256 + wc * 32 + 8 * fq;
        f32x4 gv[2][2];
#pragma unroll
        for (int bj = 0; bj < 2; ++bj)
#pragma unroll
            for (int n = 0; n < 2; ++n) gv[bj][n] = *(const f32x4*)(g + col0 + bj * 128 + 4 * n);
#pragma unroll
        for (int ai = 0; ai < 2; ++ai)
#pragma unroll
            for (int m = 0; m < 4; ++m) {
                const int r = ai * 128 + wr * 64 + m * 16 + fr; const float rstd = rs[ai][m];
#pragma unroll
                for (int bj = 0; bj < 2; ++bj) {
                    const size_t off = (size_t)(u.pm * 256 + r) * 1024 + col0 + bj * 128;
                    float xr[8]; unpack8(*(const u32x4*)(xin + off), xr);
                    const f32x4 o0 = (f32x4){xr[0], xr[1], xr[2], xr[3]} + acc[ai][bj][m][0] * rstd * gv[bj][0], o1 = (f32x4){xr[4], xr[5], xr[6], xr[7]} + acc[ai][bj][m][1] * rstd * gv[bj][1];
                    u32x4 w; w.x = pg8::cvt_pk_bf16(o0[0], o0[1]); w.y = pg8::cvt_pk_bf16(o0[2], o0[3]); w.z = pg8::cvt_pk_bf16(o1[0], o1[1]); w.w = pg8::cvt_pk_bf16(o1[2], o1[3]);
                    *(u32x4*)(XNB + off) = w;
                }
                asm volatile("" ::: "memory");
            }
    }
};
struct RoundOrder {
    pg8::StaticOrder base; int round;
    __device__ bool next(int i, Unit& u) const { return i == 0 ? base.next(round, u) : false; }
    __device__ __forceinline__ void a_ready(const Unit&) const {}
    __device__ __forceinline__ void done(const Unit&) const {}
};

__device__ __forceinline__ int win_dst_col(int o) {
    if (o < 1536) return o;
    if (o < 2560) return ZC_RK + 2 * ((o - 1536) & 511) + ((o - 1536) >> 9);
    if (o < 3072) return ZC_VG + 2 * (o - 2560);
    if (o < 3200) return o + 512;
    return ZC_VG + 2 * (o - 3200) + 1;
}
template <bool WINMAP = false>
__device__ __forceinline__ void transpose_item(const float* W, int K, int N, int k0, int nsrc0, bf16_t* WT, int ndst0, const float* g, float* scr, int lane) {
    float vv[32];
#pragma unroll
    for (int i = 0; i < 32; ++i) { const int kk = 2 * i + (lane >> 5); vv[i] = 0.f; if (nsrc0 >= 0) vv[i] = W[(size_t)(k0 + kk) * N + nsrc0 + (lane & 31)]; }
#pragma unroll
    for (int i = 0; i < 32; ++i) { const int kk = 2 * i + (lane >> 5); float v = vv[i]; if (g) v *= g[k0 + kk]; scr[kk * 33 + (lane & 31)] = v; }
    __builtin_amdgcn_s_waitcnt(0xC07F); asm volatile("" ::: "memory");
    const int c = lane & 7;
#pragma unroll
    for (int j = 0; j < 4; ++j) {
        const int n = (lane >> 3) + 8 * j; const float* s = scr + (8 * c) * 33 + n;
        u32x4 o; o.x = pk2(s[0 * 33], s[1 * 33]); o.y = pk2(s[2 * 33], s[3 * 33]); o.z = pk2(s[4 * 33], s[5 * 33]); o.w = pk2(s[6 * 33], s[7 * 33]);
        const int row = (WINMAP && nsrc0 >= 0) ? win_dst_col(nsrc0 + n) : ndst0 + n;
        *(u32x4*)(WT + (size_t)row * K + k0 + 8 * c) = o;
    }
    __builtin_amdgcn_s_waitcnt(0xC07F); asm volatile("" ::: "memory");
}
__device__ __forceinline__ void phase_prologue(const Args& a, float* ldsf, int wave, int lane) {
    float* scr = ldsf + wave * (64 * 33);
    const int gw = blockIdx.x * 8 + wave, NGW = gridDim.x * 8;
    constexpr int I_IN = 16 * (NZP / 32), I_SQ = 16 * 32, I_PL = 4 * 32, I_LAYER = I_IN + 2 * I_SQ + I_PL;
    for (int it = gw; it < L_ * I_LAYER; it += NGW) {
        const int l = it / I_LAYER; int r = it % I_LAYER;
        if (r < I_IN) {
            const int kb = r % 16, nb = r / 16, n0 = nb * 32;
            transpose_item<true>(a.in[I_WIN] + (size_t)l * 1024 * NZ, 1024, NZ, kb * 64, n0 < NZ ? n0 : -1, (bf16_t*)(a.ws + WS_WIN) + (size_t)l * NZP * 1024, n0, a.in[I_PREG] + l * 1024, scr, lane);
            continue;
        }
        r -= I_IN;
        if (r < I_SQ) { transpose_item(a.in[I_WOUT] + (size_t)l * 1024 * 1024, 1024, 1024, (r % 16) * 64, (r / 16) * 32, (bf16_t*)(a.ws + WS_WOUT) + (size_t)l * 1024 * 1024, (r / 16) * 32, nullptr, scr, lane); continue; }
        r -= I_SQ;
        if (r < I_SQ) { transpose_item(a.in[I_GW] + (size_t)l * 1024 * 1024, 1024, 1024, (r % 16) * 64, (r / 16) * 32, (bf16_t*)(a.ws + WS_WG) + (size_t)l * 1024 * 1024, (r / 16) * 32, nullptr, scr, lane); continue; }
        r -= I_SQ;
        transpose_item(a.in[I_PLEW] + (size_t)l * 256 * 1024, 256, 1024, (r % 4) * 64, (r / 4) * 32, (bf16_t*)(a.ws + WS_WP) + (size_t)l * 1024 * 256, (r / 4) * 32, nullptr, scr, lane);
    }
    {
        const int lr = lane & 31, lh = lane >> 5;
        for (int it = gw; it < 3 * 512; it += NGW) {
            const int kind = it >> 9, r = it & 511; float v[8]; bf16_t* dst;
            if (kind == 0) {
                const int l = r >> 7, nt = (r >> 4) & 7, ks = r & 15; const float* src = a.in[I_PWW] + (size_t)l * 256 * 256 + (size_t)(16 * ks + 8 * lh) * 256 + nt * 32 + lr;
#pragma unroll
                for (int j = 0; j < 8; ++j) v[j] = src[j * 256];
                dst = (bf16_t*)(a.ws + WS_WPW) + ((((size_t)l * 8 + nt) * 16 + ks) * 64 + lane) * 8;
            } else if (kind == 1) {
                const int mx = r >> 8, l = (r >> 6) & 3, ct = (r >> 2) & 15, ks = r & 3; const float* src = a.in[mx ? I_AUP : I_WUP] + (size_t)l * 64 * 512 + (size_t)(16 * ks + 8 * lh) * 512 + ct * 32 + lr;
#pragma unroll
                for (int j = 0; j < 8; ++j) v[j] = src[j * 512];
                dst = (bf16_t*)(a.ws + (mx ? WS_AUP : WS_WUP)) + ((((size_t)l * 16 + ct) * 4 + ks) * 64 + lane) * 8;
            } else {
                const int l = r >> 7, h = (r >> 5) & 3, itl = (r >> 3) & 3, ks = r & 7; const float* src = a.in[I_SGUW] + (((size_t)l * 4 + h) * 128 + itl * 32 + lr) * 128 + 16 * ks + 8 * lh;
                const f32x4 s0 = *(const f32x4*)(src), s1 = *(const f32x4*)(src + 4);
                v[0] = s0[0]; v[1] = s0[1]; v[2] = s0[2]; v[3] = s0[3]; v[4] = s1[0]; v[5] = s1[1]; v[6] = s1[2]; v[7] = s1[3];
                dst = (bf16_t*)(a.ws + WS_SGUW) + (((((size_t)l * 4 + h) * 4 + itl) * 8 + ks) * 64 + lane) * 8;
            }
            *(u32x4*)dst = (u32x4){pk2(v[0], v[1]), pk2(v[2], v[3]), pk2(v[4], v[5]), pk2(v[6], v[7])};
        }
    }
    const float* x = a.in[I_X]; bf16_t* XB = (bf16_t*)a.out; float* ssq = (float*)(a.ws + WS_SSQ1);
    for (int m0 = gw * 4; m0 < M_; m0 += NGW * 4) {
        f32x4 xv[4][4];
#pragma unroll
        for (int r = 0; r < 4; ++r)
#pragma unroll
            for (int h = 0; h < 2; ++h) { const size_t off = (size_t)(m0 + r) * 1024 + h * 512 + lane * 8; xv[r][2 * h] = *(const f32x4*)(x + off); xv[r][2 * h + 1] = *(const f32x4*)(x + off + 4); }
#pragma unroll
        for (int r = 0; r < 4; ++r) {
            float q = 0.f;
#pragma unroll
            for (int h = 0; h < 2; ++h) {
                const size_t off = (size_t)(m0 + r) * 1024 + h * 512 + lane * 8;
                const f32x4 x0 = xv[r][2 * h], x1 = xv[r][2 * h + 1];
                q += (x0[0] * x0[0] + x0[1] * x0[1]) + (x0[2] * x0[2] + x0[3] * x0[3]) + (x1[0] * x1[0] + x1[1] * x1[1]) + (x1[2] * x1[2] + x1[3] * x1[3]);
                u32x4 w; w.x = pk2(x0[0], x0[1]); w.y = pk2(x0[2], x0[3]); w.z = pk2(x1[0], x1[1]); w.w = pk2(x1[2], x1[3]);
                *(u32x4*)(XB + off) = w;
            }
            q = wave_sum(q);
            if (lane < 16) ssq[(size_t)(m0 + r) * 16 + lane] = lane == 0 ? q : 0.f;
        }
    }
}

template <int CTRL> __device__ __forceinline__ float dpp_f(float x) { return __builtin_bit_cast(float, __builtin_amdgcn_update_dpp(0, __builtin_bit_cast(int, x), CTRL, 0xf, 0xf, true)); }
__device__ __forceinline__ float allreduce16(float x) {
    x += dpp_f<0xB1>(x);
    x += dpp_f<0x4E>(x);
    x += dpp_f<0x141>(x);
    x += dpp_f<0x140>(x);
    return x;
}
__device__ __forceinline__ float wave_sum_d(float v) { v = allreduce16(v); v += __shfl_xor(v, 16); v += __shfl_xor(v, 32); return v; }
typedef float f32x16 __attribute__((ext_vector_type(16)));
using pg8::bf16x8;
#define MFMA32(a, b, c) __builtin_amdgcn_mfma_f32_32x32x16_bf16((a), (b), (c), 0, 0, 0)
constexpr int SG_PITCH = 272;
__device__ __forceinline__ void sgu_item(const Args& a, int l, int nb, unsigned char* shm, int tid_in, int wave, int lane_in) {
    int tid = tid_in, lane = lane_in; asm volatile("" : "+v"(tid), "+v"(lane));
    const bf16_t* Z = (const bf16_t*)(a.ws + WS_Z); bf16_t* CAT = (bf16_t*)(a.ws + WS_RA);
    {
        const f32x4 g = *(const f32x4*)(a.in[I_SLNG] + l * 256 + lane * 4), bb = *(const f32x4*)(a.in[I_SLNB] + l * 256 + lane * 4);
        u32x2 vld[16];
#pragma unroll
        for (int tt = 0; tt < 16; ++tt) vld[tt] = *(const u32x2*)(Z + ((size_t)nb * 128 + wave * 16 + tt) * NZ + ZC_V + lane * 4);
#pragma unroll
        for (int tt = 0; tt < 16; ++tt) {
            const int j = wave * 16 + tt;
            float v[4]; unpack4(vld[tt], v);
            const float mu = wave_sum_d((v[0] + v[1]) + (v[2] + v[3])) * (1.0f / 256.0f);
            const float d0 = v[0] - mu, d1 = v[1] - mu, d2 = v[2] - mu, d3 = v[3] - mu;
            const float rs = rsqrtf(wave_sum_d((d0 * d0 + d1 * d1) + (d2 * d2 + d3 * d3)) * (1.0f / 256.0f) + LN_EPS);
            unsigned short* dst = (unsigned short*)(shm + (size_t)(lane * 4) * SG_PITCH + j * 2);
            dst[0] = (unsigned short)f2bf(d0 * rs * g[0] + bb[0]); dst[SG_PITCH / 2] = (unsigned short)f2bf(d1 * rs * g[1] + bb[1]);
            dst[SG_PITCH] = (unsigned short)f2bf(d2 * rs * g[2] + bb[2]); dst[3 * SG_PITCH / 2] = (unsigned short)f2bf(d3 * rs * g[3] + bb[3]);
        }
    }
    __syncthreads();
    {
        const int h = wave >> 1, dt = wave & 1, lr = lane & 31, lh = lane >> 5;
        const unsigned char* arow = shm + (size_t)(h * 64 + dt * 32 + lr) * SG_PITCH + lh * 16;
        const bf16_t* wb = (const bf16_t*)(a.ws + WS_SGUW) + ((((size_t)l * 4 + h) * 4 * 8) * 64 + lane) * 8;
        f32x16 acc[4];
#pragma unroll
        for (int it = 0; it < 4; ++it)
#pragma unroll
            for (int r = 0; r < 16; ++r) acc[it][r] = 0.f;
#pragma unroll
        for (int ks = 0; ks < 8; ++ks) {
            const bf16x8 af = *(const bf16x8*)(arow + ks * 32);
#pragma unroll
            for (int it = (ks < 4 ? 0 : 2); it < 4; ++it) {
                const bf16x8 bf = *(const bf16x8*)(wb + (size_t)(it * 8 + ks) * 512);
                acc[it] = MFMA32(af, bf, acc[it]);
            }
        }
#pragma unroll
        for (int it = 0; it < 4; ++it) {
            const int i = it * 32 + lr; const size_t tok = (size_t)nb * 128 + i;
            const float bs = a.in[I_SGUB][((size_t)l * 4 + h) * 128 + i];
#pragma unroll
            for (int g = 0; g < 4; ++g) {
                const int c0 = h * 64 + dt * 32 + 8 * g + 4 * lh;
                float uu[4], gg[4]; unpack4(*(const u32x2*)(Z + tok * NZ + ZC_U + c0), uu); unpack4(*(const u32x2*)(Z + tok * NZ + ZC_GA + c0), gg);
                u32x2 o; o.x = pk2(uu[0] * (acc[it][4 * g] + bs) * siluf_(gg[0]), uu[1] * (acc[it][4 * g + 1] + bs) * siluf_(gg[1]));
                o.y = pk2(uu[2] * (acc[it][4 * g + 2] + bs) * siluf_(gg[2]), uu[3] * (acc[it][4 * g + 3] + bs) * siluf_(gg[3]));
                *(u32x2*)(CAT + tok * 1024 + c0) = o;
            }
        }
    }
    __syncthreads();
}

constexpr int CV_T = 64, CV_ROWS = CV_T + 30;
constexpr int CV_Y = 0;
constexpr int CV_C = CV_ROWS * 512;
constexpr int CV_APITCH = 528, CV_TPITCH = 144;
constexpr int CV_TW = CV_C + CV_T * 1024;
constexpr int CV_AD = CV_TW + CV_T * CV_TPITCH;
constexpr int CV_END = CV_AD + CV_T * CV_TPITCH;
__device__ __forceinline__ float tanh_fast(float x) { return 1.0f - 2.0f * __builtin_amdgcn_rcpf(__expf(2.0f * x) + 1.0f); }
template <int SKIP = 0>
__device__ __forceinline__ void conv_phase(const Args& a, int l, unsigned char* shm, int tid_in, int wave, int lane_in) {
    int tid = tid_in, lane = lane_in; asm volatile("" : "+v"(tid), "+v"(lane));
    const bf16_t* Z = (const bf16_t*)(a.ws + WS_Z); bf16_t* CAT = (bf16_t*)(a.ws + WS_RA);
    float* cbuf = (float*)(shm + CV_C);
    for (int item = blockIdx.x; item < M_ / CV_T; item += gridDim.x) {
        const int t0 = item * CV_T, pos0 = t0 & (S_ - 1);
        if (!(SKIP & 1))
        {
            int tid1 = tid; asm volatile("" : "+v"(tid1));
            const int c4 = (tid1 & 63) * 4, rg = tid1 >> 6;
            u32x2 vw[12], gw[12];
#pragma unroll
            for (int i = 0; i < 12; ++i) {
                const int rr = rg + 8 * i; vw[i] = (u32x2){0u, 0u}; gw[i] = (u32x2){0u, 0u};
                if (rr < CV_ROWS && pos0 - 30 + rr >= 0) { const size_t tok = (size_t)(t0 - 30 + rr); vw[i] = *(const u32x2*)(Z + tok * NZ + ZC_VAL + c4); gw[i] = *(const u32x2*)(Z + tok * NZ + ZC_GLU + c4); }
            }
#pragma unroll
            for (int i = 0; i < 12; ++i) {
                const int rr = rg + 8 * i;
                if (rr < CV_ROWS) {
                    float v[4], g[4]; unpack4(vw[i], v); unpack4(gw[i], g);
                    *(u32x2*)(shm + CV_Y + rr * 512 + c4 * 2) = (u32x2){pk2(v[0] * sigmoidf_(g[0]), v[1] * sigmoidf_(g[1])), pk2(v[2] * sigmoidf_(g[2]), v[3] * sigmoidf_(g[3]))};
                }
            }
        }
        if (!(SKIP & 2)) {
            int tid1 = tid; asm volatile("" : "+v"(tid1));
            const int t = tid1 >> 3, j0 = (tid1 & 7) * 16; const size_t tok = (size_t)(t0 + t);
            const bf16_t* zp = Z + tok * NZ + ZC_WD + j0;
            const u32x4 c0 = *(const u32x4*)(zp), c1 = *(const u32x4*)(zp + 8);
            u32x4 p0 = (u32x4){0u, 0u, 0u, 0u}, p1 = p0;
            if (pos0 + t > 0) { p0 = *(const u32x4*)(zp - NZ); p1 = *(const u32x4*)(zp - NZ + 8); }
            const float* mu = a.in[I_MU] + (size_t)l * 1664 + 1536 + j0;
            float zc[16], zq[16]; { float t8[8]; unpack8(c0, t8);
#pragma unroll
                for (int e = 0; e < 8; ++e) zc[e] = t8[e]; unpack8(c1, t8);
#pragma unroll
                for (int e = 0; e < 8; ++e) zc[8 + e] = t8[e]; unpack8(p0, t8);
#pragma unroll
                for (int e = 0; e < 8; ++e) zq[e] = t8[e]; unpack8(p1, t8);
#pragma unroll
                for (int e = 0; e < 8; ++e) zq[8 + e] = t8[e]; }
            float o[16];
#pragma unroll
            for (int e4 = 0; e4 < 4; ++e4) { const f32x4 m4 = *(const f32x4*)(mu + 4 * e4);
#pragma unroll
                for (int e = 0; e < 4; ++e) { const float sft = zc[4 * e4 + e] + m4[e] * (zq[4 * e4 + e] - zc[4 * e4 + e]); o[4 * e4 + e] = j0 < 64 ? tanh_fast(sft) : sft; } }
            unsigned char* dst = shm + (j0 < 64 ? CV_TW + t * CV_TPITCH + j0 * 2 : CV_AD + t * CV_TPITCH + (j0 - 64) * 2);
            *(u32x4*)(dst) = (u32x4){pk2(o[0], o[1]), pk2(o[2], o[3]), pk2(o[4], o[5]), pk2(o[6], o[7])};
            *(u32x4*)(dst + 16) = (u32x4){pk2(o[8], o[9]), pk2(o[10], o[11]), pk2(o[12], o[13]), pk2(o[14], o[15])};
        }
        __syncthreads();
        if (!(SKIP & 4)) {
            int tid2 = tid; asm volatile("" : "+v"(tid2));
            const int c = tid2 & 255, th = tid2 >> 8;
            float cw[31];
#pragma unroll
            for (int k = 0; k < 31; ++k) cw[k] = a.in[I_CW][((size_t)l * 31 + k) * 256 + c];
            const float cb = a.in[I_CB][l * 256 + c];
#pragma unroll 1
            for (int run = 0; run < 2; ++run) {
                const int tb = th * 32 + run * 16;
                float yr[46];
#pragma unroll
                for (int i = 0; i < 46; ++i) yr[i] = bf2f(*(const unsigned short*)(shm + CV_Y + (tb + i) * 512 + c * 2));
#pragma unroll
                for (int t = 0; t < 16; ++t) {
                    float acc = cb;
#pragma unroll
                    for (int k = 0; k < 31; ++k) acc += yr[t + k] * cw[k];
                    cbuf[(tb + t) * 256 + c] = acc;
                }
            }
        }
        __syncthreads();
        int ln4 = lane; asm volatile("" : "+v"(ln4));
        int lr = ln4 & 31, lh = ln4 >> 5;
        bf16x8 wpf[16];
        {
            const bf16_t* wp = (const bf16_t*)(a.ws + WS_WPW) + ((((size_t)l * 8 + wave) * 16) * 64 + ln4) * 8;
#pragma unroll
            for (int ks = 0; ks < 16; ++ks) wpf[ks] = *(const bf16x8*)(wp + ks * 512);
        }
        if (!(SKIP & 8)) {
            const f32x4 g = *(const f32x4*)(a.in[I_CLNG] + l * 256 + lane * 4), b = *(const f32x4*)(a.in[I_CLNB] + l * 256 + lane * 4);
#pragma unroll
            for (int tt = 0; tt < 8; ++tt) {
                const int t = wave * 8 + tt;
                f32x4 v = *(const f32x4*)(cbuf + t * 256 + lane * 4);
                const float mu = wave_sum_d((v[0] + v[1]) + (v[2] + v[3])) * (1.0f / 256.0f);
                v = v - mu;
                const float rs = rsqrtf(wave_sum_d((v[0] * v[0] + v[1] * v[1]) + (v[2] * v[2] + v[3] * v[3])) * (1.0f / 256.0f) + LN_EPS);
                u32x2 o; o.x = pk2(siluf_(v[0] * rs * g[0] + b[0]), siluf_(v[1] * rs * g[1] + b[1])); o.y = pk2(siluf_(v[2] * rs * g[2] + b[2]), siluf_(v[3] * rs * g[3] + b[3]));
                *(u32x2*)(shm + CV_Y + t * CV_APITCH + lane * 8) = o;
            }
        }
        __syncthreads();
        if (!(SKIP & 16)) {
            f32x16 acc[2];
#pragma unroll
            for (int r = 0; r < 16; ++r) { acc[0][r] = 0.f; acc[1][r] = 0.f; }
            const unsigned char* bp = shm + CV_Y + lr * CV_APITCH + lh * 16;
#pragma unroll
            for (int ks = 0; ks < 16; ++ks) { acc[0] = MFMA32(*(const bf16x8*)(bp + ks * 32), wpf[ks], acc[0]); acc[1] = MFMA32(*(const bf16x8*)(bp + 32 * CV_APITCH + ks * 32), wpf[ks], acc[1]); }
            const int n = wave * 32 + lr; const float pb = a.in[I_PWB][l * 256 + n];
#pragma unroll
            for (int tt = 0; tt < 2; ++tt) {
                unsigned gbr[16];
#pragma unroll
                for (int r = 0; r < 16; ++r) gbr[r] = Z[(size_t)(t0 + tt * 32 + (r & 3) + 8 * (r >> 2) + 4 * lh) * NZ + ZC_GB + n];
#pragma unroll
                for (int r = 0; r < 16; ++r) CAT[(size_t)(t0 + tt * 32 + (r & 3) + 8 * (r >> 2) + 4 * lh) * 1024 + 256 + n] = (bf16_t)f2bf((acc[tt][r] + pb) * siluf_(bf2f(gbr[r])));
            }
        }
        if (!(SKIP & 32)) {
            int ln5 = lane; asm volatile("" : "+v"(ln5)); lr = ln5 & 31; lh = ln5 >> 5;
            unsigned* AW = (unsigned*)(a.ws + WS_WQ);
#pragma unroll
            for (int cc = 0; cc < 2; ++cc) {
                const int ct = wave * 2 + cc;
                const bf16_t* wu = (const bf16_t*)(a.ws + WS_WUP) + ((((size_t)l * 16 + ct) * 4) * 64 + (lr + 32 * lh)) * 8;
                const bf16_t* au = (const bf16_t*)(a.ws + WS_AUP) + ((((size_t)l * 16 + ct) * 4) * 64 + (lr + 32 * lh)) * 8;
                bf16x8 wf[4], af[4];
#pragma unroll
                for (int ks = 0; ks < 4; ++ks) { wf[ks] = *(const bf16x8*)(wu + ks * 512); af[ks] = *(const bf16x8*)(au + ks * 512); }
#pragma unroll
                for (int tt = 0; tt < 2; ++tt) {
                    const unsigned char* tp = shm + CV_TW + (tt * 32 + lr) * CV_TPITCH + lh * 16; const unsigned char* ap = shm + CV_AD + (tt * 32 + lr) * CV_TPITCH + lh * 16;
                    f32x16 aw, aa;
#pragma unroll
                    for (int r = 0; r < 16; ++r) { aw[r] = 0.f; aa[r] = 0.f; }
#pragma unroll
                    for (int ks = 0; ks < 4; ++ks) { aw = MFMA32(*(const bf16x8*)(tp + ks * 32), wf[ks], aw); aa = MFMA32(*(const bf16x8*)(ap + ks * 32), af[ks], aa); }
                    const int c = ct * 32 + lr; const float w0 = a.in[I_W0][l * 512 + c], a0 = a.in[I_A0][l * 512 + c];
#pragma unroll
                    for (int r = 0; r < 16; ++r) {
                        const float w = __expf(-DECAY_SCALE * sigmoidf_(w0 + aw[r]));
                        const unsigned q = (unsigned)fminf(fmaxf(rintf((1.0f - w) * 131072.0f), 0.f), 65535.f);
                        AW[(size_t)(t0 + tt * 32 + (r & 3) + 8 * (r >> 2) + 4 * lh) * 512 + c] = q | (f2bf(sigmoidf_(a0 + aa[r])) << 16);
                    }
                }
            }
        }
        if (!(SKIP & 64)) {
            int tid6 = tid; asm volatile("" : "+v"(tid6));
            const float* p = a.in[I_P] + ((size_t)l * M_ + t0) * 256; bf16_t* PB = (bf16_t*)(a.ws + WS_PB) + (size_t)t0 * 256;
#pragma unroll
            for (int h = 0; h < 4; ++h) {
                const int e0 = (h * 512 + tid6) * 8;
                const f32x4 x0 = *(const f32x4*)(p + e0), x1 = *(const f32x4*)(p + e0 + 4);
                u32x4 w; w.x = pk2(x0[0], x0[1]); w.y = pk2(x0[2], x0[3]); w.z = pk2(x1[0], x1[1]); w.w = pk2(x1[2], x1[3]);
                *(u32x4*)(PB + e0) = w;
            }
        }
        __syncthreads();
    }
}

constexpr int CS_C = 16, CS_NCH = S_ / CS_C, CS_NS = 8, CS_NP = 7;
constexpr int SM_AT4 = 0  , SM_RBK = 1024  , SM_RS = 2048, SM_BYTES = 2112;
constexpr int PA_AT = 0, PA_RT = 2304, PA_BN = 4608, PA_KN = 6912, PA_KR = 9216, PA_RK = 11520, PA_NF = 13824, PA_OUT = 14848, PA_SIZE = 16960;
constexpr int SL_AT = 0, SL_RT = 2304, SL_BK = 4608  , SL_SM = 9728, SL_VM = 11840, SL_WC = 12480, SL_SIZE = 12800;
constexpr int CS_FLAGS = CS_NS * SL_SIZE, CS_LDS = CS_FLAGS + 64;
__device__ __forceinline__ bf16x8 mk8(unsigned a, unsigned b, unsigned c, unsigned d) { return __builtin_bit_cast(bf16x8, (u32x4){a, b, c, d}); }
__device__ __forceinline__ unsigned short bf1(float x) { return (unsigned short)pg8::cvt_pk_bf16(x, x); }
#define MFMA16(a, b, c) __builtin_amdgcn_mfma_f32_16x16x32_bf16((a), (b), (c), 0, 0, 0)
__device__ __forceinline__ void scanprep_phase(const Args& a, int l, unsigned char* shm, int wave, int lane_in) {
    int lane = lane_in; asm volatile("" : "+v"(lane));
    const bf16_t* Z = (const bf16_t*)(a.ws + WS_Z);
    const unsigned* AW = (const unsigned*)(a.ws + WS_WQ);
    float* BON = (float*)(a.ws + WS_BON);
    unsigned char* sb = shm + wave * PA_SIZE;
    const int gw = blockIdx.x * 8 + wave, NGW = gridDim.x * 8;
    const int li = lane & 15, g = lane >> 4;
#pragma unroll 1
    for (int task = gw; task < 64 * CS_NCH; task += NGW) {
        const int bh = task / CS_NCH, c = task % CS_NCH, b = bh >> 3, h = bh & 7, hc = h * 64 + lane;
        const unsigned uhc = (unsigned)hc;
        const size_t tokc = (size_t)b * S_ + (size_t)c * CS_C;
        const float mu_k = a.in[I_MU][(size_t)l * 1664 + 512 + hc], mu_r = a.in[I_MU][(size_t)l * 1664 + hc];
        const float kkc = a.in[I_KK][l * 512 + hc], kac = a.in[I_KA][l * 512 + hc], rkc = a.in[I_RK][l * 512 + hc];
        unsigned rk[16], aw[16];
#pragma unroll
        for (int t = 0; t < 16; ++t) { rk[t] = ((const unsigned*)(Z + (tokc + t) * NZ + ZC_RK))[uhc]; aw[t] = (AW + (tokc + t) * 512)[uhc]; }
        unsigned prk = 0u;
        if (c > 0) prk = ((const unsigned*)(Z + (tokc - 1) * NZ + ZC_RK))[uhc];
        float pr = bf2f(prk & 0xffffu), pk = __uint_as_float(prk & 0xffff0000u);
        float W = 1.0f;
#pragma unroll
        for (int t = 0; t < 16; ++t) {
            const float fzr = bf2f(rk[t] & 0xffffu), fzk = __uint_as_float(rk[t] & 0xffff0000u), al = __uint_as_float(aw[t] & 0xffff0000u), w = 1.0f - (float)(aw[t] & 0xffffu) * (1.0f / 131072.0f);
            const float r = fzr + mu_r * (pr - fzr), kx = fzk + mu_k * (pk - fzk);
            pr = fzr; pk = fzk;
            const float kkr = kx * kkc, kp = kx * (1.0f + (al - 1.0f) * kac);
            const float Wp = W; W *= w; const float iW = __builtin_amdgcn_rcpf(W), rW = r * W;
            *(unsigned short*)(sb + PA_AT + t * 144 + 2 * lane) = bf1(-kkr * Wp);
            *(unsigned short*)(sb + PA_RT + t * 144 + 2 * lane) = bf1(rW);
            *(unsigned short*)(sb + PA_BN + t * 144 + 2 * lane) = bf1(kkr * al * iW);
            *(unsigned short*)(sb + PA_KN + t * 144 + 2 * lane) = bf1(kp * iW);
            *(unsigned short*)(sb + PA_KR + t * 144 + 2 * lane) = bf1(kkr);
            *(unsigned short*)(sb + PA_RK + t * 144 + 2 * lane) = bf1(rW * rkc);
        }
        __builtin_amdgcn_s_waitcnt(0xC07F); asm volatile("" ::: "memory");
        {
            bf16x8 fa[2], fr[2], fb[2], fk[2], fq[2], fo[2];
#pragma unroll
            for (int s2 = 0; s2 < 2; ++s2) {
                fa[s2] = *(const bf16x8*)(sb + PA_AT + li * 144 + 16 * g + 64 * s2); fr[s2] = *(const bf16x8*)(sb + PA_RT + li * 144 + 16 * g + 64 * s2);
                fb[s2] = *(const bf16x8*)(sb + PA_BN + li * 144 + 16 * g + 64 * s2); fk[s2] = *(const bf16x8*)(sb + PA_KN + li * 144 + 16 * g + 64 * s2);
                fq[s2] = *(const bf16x8*)(sb + PA_KR + li * 144 + 16 * g + 64 * s2); fo[s2] = *(const bf16x8*)(sb + PA_RK + li * 144 + 16 * g + 64 * s2);
            }
            const f32x4 z4 = {0.f, 0.f, 0.f, 0.f};
            f32x4 dss = MFMA16(fq[0], fq[0], z4); dss = MFMA16(fq[1], fq[1], dss);
            f32x4 dbo = MFMA16(fo[0], fk[0], z4); dbo = MFMA16(fo[1], fk[1], dbo);
            f32x4 dab = MFMA16(fa[0], fb[0], z4); dab = MFMA16(fa[1], fb[1], dab);
            f32x4 dak = MFMA16(fa[0], fk[0], z4); dak = MFMA16(fa[1], fk[1], dak);
            f32x4 drb = MFMA16(fr[0], fb[0], z4); drb = MFMA16(fr[1], fb[1], drb);
            f32x4 drk = MFMA16(fr[0], fk[0], z4); drk = MFMA16(fr[1], fk[1], drk);
            if (g == (li >> 2)) {
                const int rr = li & 3;
                const float ss = rr == 0 ? dss[0] : (rr == 1 ? dss[1] : (rr == 2 ? dss[2] : dss[3]));
                const float bo = rr == 0 ? dbo[0] : (rr == 1 ? dbo[1] : (rr == 2 ? dbo[2] : dbo[3]));
                const float rs = rsqrtf(fmaxf(ss, 1e-12f));
                *(float*)(sb + PA_OUT + SM_RS + 4 * li) = rs;
                BON[(tokc + li) * 8 + h] = bo;
            }
            __builtin_amdgcn_s_waitcnt(0xC07F); asm volatile("" ::: "memory");
            const float rsc = *(const float*)(sb + PA_OUT + SM_RS + 4 * li); const f32x4 rsr = *(const f32x4*)(sb + PA_OUT + SM_RS + 16 * g);
#pragma unroll
            for (int r = 0; r < 4; ++r) {
                const int t = 4 * g + r;
                *(float*)(sb + PA_NF + t * 64 + 4 * li) = li < t ? dab[r] * rsr[r] * rsc : 0.f;
                *(unsigned short*)(sb + PA_OUT + SM_AT4 + t * 64 + (li >> 2) * 16 + (li & 3) * 2) = bf1(li < t ? dak[r] * rsr[r] : 0.f);
                *(unsigned short*)(sb + PA_OUT + SM_RBK + t * 64 + (li >> 2) * 16 + (li & 3) * 2) = bf1(li <= t ? drb[r] * rsc : 0.f);
                *(unsigned short*)(sb + PA_OUT + SM_RBK + t * 64 + (li >> 2) * 16 + 8 + (li & 3) * 2) = bf1(li <= t ? drk[r] : 0.f);
            }
        }
        __builtin_amdgcn_s_waitcnt(0xC07F); asm volatile("" ::: "memory");
        {
            float T[16];
#pragma unroll
            for (int t = 0; t < 16; ++t) {
                float x = li == t ? 1.0f : 0.f;
#pragma unroll
                for (int j4 = 0; j4 < t; j4 += 4) {
                    const f32x4 n4 = *(const f32x4*)(sb + PA_NF + t * 64 + 4 * j4);
#pragma unroll
                    for (int e = 0; e < 4; ++e) if (j4 + e < t) x += n4[e] * T[j4 + e];
                }
                T[t] = x;
                if (g == 0) *(unsigned short*)(sb + PA_OUT + SM_AT4 + t * 64 + (li >> 2) * 16 + 8 + (li & 3) * 2) = bf1(x);
            }
        }
        __builtin_amdgcn_s_waitcnt(0xC07F); asm volatile("" ::: "memory");
        {
            unsigned char* dst = (unsigned char*)(Z + (tokc + h) * NZ);
            *(u32x4*)(dst + 16 * lane) = *(const u32x4*)(sb + PA_OUT + 16 * lane);
            *(u32x4*)(dst + 1024 + 16 * lane) = *(const u32x4*)(sb + PA_OUT + 1024 + 16 * lane);
            if (lane < 4) *(u32x4*)(dst + 2048 + 16 * lane) = *(const u32x4*)(sb + PA_OUT + 2048 + 16 * lane);
        }
        __builtin_amdgcn_s_waitcnt(0xC07F); asm volatile("" ::: "memory");
    }
}
template <int MODE  >
__device__ __forceinline__ void cscan_phase(const Args& a, int l, unsigned char* shm, int tid, int wave, int lane) {
    const bf16_t* Z = (const bf16_t*)(a.ws + WS_Z);
    const unsigned* AW = (const unsigned*)(a.ws + WS_WQ);
    float* Y = (float*)(a.ws + WS_RB);
    volatile PG8_LAS unsigned* flags = (volatile PG8_LAS unsigned*)((PG8_LAS unsigned char*)shm + CS_FLAGS);
    const int G = gridDim.x, bx = blockIdx.x, vcu = (G % 8 == 0) ? (bx % 8) * (G / 8) + bx / 8 : bx;
    for (int task = vcu; task < 256; task += G) {
        const int bh = task >> 2, q = task & 3, b = bh >> 3, h = bh & 7;
        const size_t tok0 = (size_t)b * S_;
        if (tid < 16) flags[tid] = 0u;
        __syncthreads();
        const int li = lane & 15, g = lane >> 4;
        if (wave == 0) {
            __builtin_amdgcn_s_setprio(3);
            f32x4 S[4];
#pragma unroll
            for (int i = 0; i < 4; ++i) S[i] = (f32x4){0.f, 0.f, 0.f, 0.f};
            float* Yp = Y + (tok0 + 4 * g) * 512 + h * 64 + 16 * q + li;
            bf16x8 c_at[2], c_rt[2], c_bk[4], c_a4, c_rbk; u32x2 c_vm; f32x4 c_wc[4];
            bf16x8 n_at[2], n_rt[2], n_bk[4], n_a4, n_rbk; u32x2 n_vm; f32x4 n_wc[4];
#define CS_LOAD(P, cc) do { const unsigned char* sb_ = shm + ((cc) & 7) * SL_SIZE; \
                _Pragma("unroll") for (int s2 = 0; s2 < 2; ++s2) { P##at[s2] = *(const bf16x8*)(sb_ + SL_AT + li * 144 + 64 * s2 + 16 * g); P##rt[s2] = *(const bf16x8*)(sb_ + SL_RT + li * 144 + 64 * s2 + 16 * g); } \
                _Pragma("unroll") for (int i = 0; i < 4; ++i) { P##bk[i] = *(const bf16x8*)(sb_ + SL_BK + (16 * i + li) * 80 + 16 * g); P##wc[i] = *(const f32x4*)(sb_ + SL_WC + (16 * i + 4 * g) * 4); } \
                P##a4 = *(const bf16x8*)(sb_ + SL_SM + SM_AT4 + li * 64 + 16 * g); P##rbk = *(const bf16x8*)(sb_ + SL_SM + SM_RBK + li * 64 + 16 * g); P##vm = *(const u32x2*)(sb_ + SL_VM + li * 40 + 8 * g); } while (0)
#define CS_COMPUTE(P, cc) do { \
                const f32x4 z4_ = {0.f, 0.f, 0.f, 0.f}; \
                const f32x4 rhs0_ = MFMA16(P##a4, mk8(P##vm.x, P##vm.y, 0u, 0u), z4_); \
                const bf16x8 sb0_ = mk8(pg8::cvt_pk_bf16(S[0][0], S[0][1]), pg8::cvt_pk_bf16(S[0][2], S[0][3]), pg8::cvt_pk_bf16(S[1][0], S[1][1]), pg8::cvt_pk_bf16(S[1][2], S[1][3])); \
                const bf16x8 sb1_ = mk8(pg8::cvt_pk_bf16(S[2][0], S[2][1]), pg8::cvt_pk_bf16(S[2][2], S[2][3]), pg8::cvt_pk_bf16(S[3][0], S[3][1]), pg8::cvt_pk_bf16(S[3][2], S[3][3])); \
                f32x4 rhs_ = MFMA16(P##at[0], sb0_, rhs0_); rhs_ = MFMA16(P##at[1], sb1_, rhs_); \
                f32x4 y_ = MFMA16(P##rt[0], sb0_, z4_); y_ = MFMA16(P##rt[1], sb1_, y_); \
                const f32x4 sa_ = MFMA16(P##a4, mk8(0u, 0u, pg8::cvt_pk_bf16(rhs_[0], rhs_[1]), pg8::cvt_pk_bf16(rhs_[2], rhs_[3])), z4_); \
                const bf16x8 sv_ = mk8(pg8::cvt_pk_bf16(sa_[0], sa_[1]), pg8::cvt_pk_bf16(sa_[2], sa_[3]), P##vm.x, P##vm.y); \
                _Pragma("unroll") for (int i = 0; i < 4; ++i) { S[i] = MFMA16(P##bk[i], sv_, S[i]); S[i] = S[i] * P##wc[i]; } \
                y_ = MFMA16(P##rbk, sv_, y_); \
                { float* yq_ = Yp + (size_t)(cc) * (CS_C * 512); yq_[0] = y_[0]; yq_[512] = y_[1]; yq_[1024] = y_[2]; yq_[1536] = y_[3]; } } while (0)
#define CS_WAIT(fl, cc) do { while ((fl) != (unsigned)((cc) + 1)) { __builtin_amdgcn_s_sleep(1); (fl) = flags[(cc) & 7]; } asm volatile("" ::: "memory"); } while (0)
#define CS_SIGNAL(n) do { __builtin_amdgcn_s_waitcnt(0xC07F); asm volatile("" ::: "memory"); flags[8] = (unsigned)(n); asm volatile("" ::: "memory"); } while (0)
            unsigned fl = flags[0];
            CS_WAIT(fl, 0);
            if (MODE != 2) CS_LOAD(c_, 0);
            fl = flags[1];
            CS_SIGNAL(1);
#pragma unroll 1
            for (int c = 0; c < CS_NCH - 2; c += 2) {
                CS_WAIT(fl, c + 1);
                if (MODE != 2) CS_LOAD(n_, c + 1);
                fl = flags[(c + 2) & 7];
                if (MODE != 2) CS_COMPUTE(c_, c);
                CS_SIGNAL(c + 2);
                CS_WAIT(fl, c + 2);
                if (MODE != 2) CS_LOAD(c_, c + 2);
                fl = flags[(c + 3) & 7];
                if (MODE != 2) CS_COMPUTE(n_, c + 1);
                CS_SIGNAL(c + 3);
            }
            {
                CS_WAIT(fl, CS_NCH - 1);
                if (MODE != 2) CS_LOAD(n_, CS_NCH - 1);
                if (MODE != 2) CS_COMPUTE(c_, CS_NCH - 2);
                CS_SIGNAL(CS_NCH);
                if (MODE != 2) CS_COMPUTE(n_, CS_NCH - 1);
            }
#undef CS_COMPUTE
#undef CS_WAIT
#undef CS_SIGNAL
            __builtin_amdgcn_s_setprio(0);
#undef CS_LOAD
        } else {
            const int hc = h * 64 + lane;
            const unsigned uhc = (unsigned)hc;
            const int kpos = (lane & 32) | (((lane >> 2) & 3) << 3) | (((lane >> 4) & 1) << 2) | (lane & 3);
            const float mu_r = a.in[I_MU][(size_t)l * 1664 + hc], mu_k = a.in[I_MU][(size_t)l * 1664 + 512 + hc], mu_v = a.in[I_MU][(size_t)l * 1664 + 1024 + hc];
            const float kkc = a.in[I_KK][l * 512 + hc], kac = a.in[I_KA][l * 512 + hc];
            u32x2 zq[16]; unsigned aw[16]; u32x4 bl0, bl1; f32x4 rs4[4]; u32x2 cpq;

#define PLOADH(hh, cc) do { const size_t tokc_ = tok0 + (size_t)(cc) * CS_C; \
                _Pragma("unroll") for (int t = 8 * (hh); t < 8 * (hh) + 8; ++t) { zq[t].x = ((const unsigned*)(Z + (tokc_ + t) * NZ + ZC_RK))[uhc]; aw[t] = (AW + (tokc_ + t) * 512)[uhc]; } \
                _Pragma("unroll") for (int t = 8 * (hh); t < 8 * (hh) + 8; ++t) zq[t].y = ((const unsigned*)(Z + (tokc_ + t) * NZ + ZC_VG))[uhc]; } while (0)
#define PLOADB(cc) do { const size_t tokc_ = tok0 + (size_t)(cc) * CS_C; const unsigned char* blk_ = (const unsigned char*)(Z + (tokc_ + h) * NZ); \
                bl0 = *(const u32x4*)(blk_ + 16 * lane); bl1 = *(const u32x4*)(blk_ + 1024 + 16 * lane); \
                _Pragma("unroll") for (int i = 0; i < 4; ++i) rs4[i] = *(const f32x4*)(blk_ + SM_RS + 16 * i); \
                cpq = (u32x2){0u, 0u}; \
                if ((cc) > 0) { cpq.x = ((const unsigned*)(Z + (tokc_ - 1) * NZ + ZC_RK))[uhc]; cpq.y = ((const unsigned*)(Z + (tokc_ - 1) * NZ + ZC_VG))[uhc]; } } while (0)
#define PTOK(t) do { \
                    const float fzr = bf2f(zq[t].x & 0xffffu), fzk = __uint_as_float(zq[t].x & 0xffff0000u), fzv = bf2f(zq[t].y & 0xffffu), al = __uint_as_float(aw[t] & 0xffff0000u), w = 1.0f - (float)(aw[t] & 0xffffu) * (1.0f / 131072.0f); \
                    const float r = fzr + mu_r * (pr - fzr), kx = fzk + mu_k * (pk - fzk), v = fzv + mu_v * (pv - fzv); \
                    pr = fzr; pk = fzk; pv = fzv; \
                    const float kk = kx * kkc * rs4[(t) >> 2][(t) & 3]; \
                    const float kp = kx * (1.0f + (al - 1.0f) * kac); \
                    const float Wp = W; W *= w; const float iW = __builtin_amdgcn_rcpf(W); \
                    const float fb = kk * al * iW, fk = kp * iW; \
                    *(unsigned short*)(sb + SL_AT + (t) * 144 + 2 * kpos) = bf1(-kk * Wp); \
                    *(unsigned short*)(sb + SL_RT + (t) * 144 + 2 * kpos) = bf1(r * W); \
                    if ((t) & 1) { btp[(t) >> 1] = pg8::cvt_pk_bf16(eb, fb); ktp[(t) >> 1] = pg8::cvt_pk_bf16(ek, fk); vp[(t) >> 1] = pg8::cvt_pk_bf16(ev, v); } \
                    else { eb = fb; ek = fk; ev = v; } } while (0)
            int c = wave - 1;
            if (MODE != 1) { PLOADB(c); PLOADH(0, c); PLOADH(1, c); }
#pragma unroll 1
            for (; c < CS_NCH; c += CS_NP) {
                unsigned char* sb = shm + (c & 7) * SL_SIZE;
                if (c >= CS_NS) { while ((int)flags[8] < c - (CS_NS - 1)) __builtin_amdgcn_s_sleep(2); }
                asm volatile("" ::: "memory");
                if (MODE != 1) {
                    const bool more = c + CS_NP < CS_NCH;
                    *(u32x4*)(sb + SL_SM + 16 * lane) = bl0; *(u32x4*)(sb + SL_SM + 1024 + 16 * lane) = bl1;
                    float pr = bf2f(cpq.x & 0xffffu), pk = __uint_as_float(cpq.x & 0xffff0000u), pv = bf2f(cpq.y & 0xffffu);
                    float W = 1.0f, eb = 0.f, ek = 0.f, ev = 0.f;
                    unsigned btp[8], ktp[8], vp[8];
#pragma unroll
                    for (int t = 0; t < 8; ++t) PTOK(t);
                    asm volatile("" ::: "memory");
                    if (more) PLOADH(0, c + CS_NP);
#pragma unroll
                    for (int t = 8; t < 16; ++t) PTOK(t);
                    asm volatile("" ::: "memory");
                    if (more) { PLOADH(1, c + CS_NP); PLOADB(c + CS_NP); }
                    {
                        unsigned char* pb = sb + SL_BK + lane * 80;
#pragma unroll
                        for (int i = 0; i < 4; ++i) *(u32x4*)(pb + 16 * i) = (u32x4){btp[2 * i], btp[2 * i + 1], ktp[2 * i], ktp[2 * i + 1]};
                        if ((lane >> 4) == q) { unsigned char* pvm = sb + SL_VM + li * 40;
#pragma unroll
                            for (int i = 0; i < 4; ++i) *(u32x2*)(pvm + 8 * i) = (u32x2){vp[2 * i], vp[2 * i + 1]}; }
                        *(float*)(sb + SL_WC + 4 * lane) = W;
                    }
                }
                __builtin_amdgcn_s_waitcnt(0xC07F); asm volatile("" ::: "memory");
                flags[c & 7] = (unsigned)(c + 1);
                asm volatile("" ::: "memory");
            }
#undef PLOADH
#undef PLOADB
#undef PTOK
        }
        __syncthreads();
    }
}

__device__ __forceinline__ void phase_branchc(const Args& a, int l, int wave, int lane) {
    const int gw = blockIdx.x * 8 + wave, NGW = gridDim.x * 8;
    const bf16_t* Z = (const bf16_t*)(a.ws + WS_Z); bf16_t* CAT = (bf16_t*)(a.ws + WS_RA); const float* Y = (const float*)(a.ws + WS_RB); const float* BON = (const float*)(a.ws + WS_BON);
    const int hc = lane * 8, head = lane >> 3;
    const f32x4 g0 = *(const f32x4*)(a.in[I_LXG] + l * 512 + hc), g1 = *(const f32x4*)(a.in[I_LXG] + l * 512 + hc + 4), b0 = *(const f32x4*)(a.in[I_LXB] + l * 512 + hc), b1 = *(const f32x4*)(a.in[I_LXB] + l * 512 + hc + 4);
    const f32x4 m0 = *(const f32x4*)(a.in[I_MU] + (size_t)l * 1664 + 1024 + hc), m1 = *(const f32x4*)(a.in[I_MU] + (size_t)l * 1664 + 1024 + hc + 4);
    constexpr int NT = 4;
    for (int mp = NT * gw; mp < M_; mp += NT * NGW) {
        f32x4 yv[NT][2]; u32x4 cw[NT][2], pw[2]; float bo[NT];
#pragma unroll
        for (int u = 0; u < NT; ++u) {
            yv[u][0] = *(const f32x4*)(Y + (size_t)(mp + u) * 512 + hc); yv[u][1] = *(const f32x4*)(Y + (size_t)(mp + u) * 512 + hc + 4);
            const u32x4* cp = (const u32x4*)(Z + (size_t)(mp + u) * NZ + ZC_VG + 2 * hc);
#pragma unroll
            for (int i = 0; i < 2; ++i) cw[u][i] = cp[i];
            bo[u] = BON[(size_t)(mp + u) * 8 + head];
        }
        {
            const bool hp = (mp & (S_ - 1)) > 0; const u32x4* pp = (const u32x4*)(Z + (size_t)(mp - 1) * NZ + ZC_VG + 2 * hc);
#pragma unroll
            for (int i = 0; i < 2; ++i) { pw[i] = (u32x4){0u, 0u, 0u, 0u}; if (hp) pw[i] = pp[i]; }
        }
#pragma unroll
        for (int u = 0; u < NT; ++u) {
            float y[8] = {yv[u][0][0], yv[u][0][1], yv[u][0][2], yv[u][0][3], yv[u][1][0], yv[u][1][1], yv[u][1][2], yv[u][1][3]};
            float sm = ((y[0] + y[1]) + (y[2] + y[3])) + ((y[4] + y[5]) + (y[6] + y[7]));
            sm += __shfl_xor(sm, 1); sm += __shfl_xor(sm, 2); sm += __shfl_xor(sm, 4);
            const float mean = sm * (1.0f / 64.0f); float q = 0.f;
#pragma unroll
            for (int e = 0; e < 8; ++e) { y[e] -= mean; q += y[e] * y[e]; }
            q += __shfl_xor(q, 1); q += __shfl_xor(q, 2); q += __shfl_xor(q, 4);
            const float rs = rsqrtf(q * (1.0f / 64.0f) + GN_EPS);
            float o[8];
#pragma unroll
            for (int i = 0; i < 2; ++i) {
                const u32x4 c4 = cw[u][i], p4 = u == 0 ? pw[i] : cw[u > 0 ? u - 1 : 0][i];
#pragma unroll
                for (int hh = 0; hh < 4; ++hh) {
                    const int e = 4 * i + hh; const unsigned cd = c4[hh], pd = p4[hh];
                    const float zv = bf2f(cd & 0xffffu), gc = __uint_as_float(cd & 0xffff0000u), pvv = bf2f(pd & 0xffffu);
                    const float mu = e < 4 ? m0[e & 3] : m1[e & 3], g = e < 4 ? g0[e & 3] : g1[e & 3], bb = e < 4 ? b0[e & 3] : b1[e & 3];
                    const float v = zv + mu * (pvv - zv);
                    o[e] = (y[e] * rs * g + bb + bo[u] * v) * siluf_(gc);
                }
            }
            u32x4 w; w.x = pk2(o[0], o[1]); w.y = pk2(o[2], o[3]); w.z = pk2(o[4], o[5]); w.w = pk2(o[6], o[7]);
            *(u32x4*)(CAT + (size_t)(mp + u) * 1024 + 512 + hc) = w;
        }
    }
}

__device__ __forceinline__ void phase_xnew(const Args& a, int l, int wave, int lane) {
    const int gw = blockIdx.x * 8 + wave, NGW = gridDim.x * 8;
    const float* xin = l == 0 ? a.in[I_X] : a.out; float* xout = a.out;
    const bf16_t* MIX = (const bf16_t*)(a.ws + WS_RB); bf16_t* XNB = (bf16_t*)(a.ws + WS_RA); const float* ssq = (const float*)(a.ws + WS_SSQ2);
    const float* g = a.in[I_POSTG] + l * 1024;
    for (int m = gw; m < M_; m += NGW) {
        const f32x4* sp = (const f32x4*)(ssq + (size_t)m * 16);
        const f32x4 s0 = sp[0], s1 = sp[1], s2 = sp[2], s3 = sp[3];
        const float t = ((s0[0] + s0[1]) + (s0[2] + s0[3])) + ((s1[0] + s1[1]) + (s1[2] + s1[3])) + ((s2[0] + s2[1]) + (s2[2] + s2[3])) + ((s3[0] + s3[1]) + (s3[2] + s3[3]));
        const float rstd = rsqrtf(t * (1.0f / 1024.0f) + RMS_EPS);
#pragma unroll
        for (int h = 0; h < 2; ++h) {
            const int col = h * 512 + lane * 8; const size_t off = (size_t)m * 1024 + col;
            const u32x4 mw = *(const u32x4*)(MIX + off); float mx[8]; unpack8(mw, mx);
            const f32x4 x0 = *(const f32x4*)(xin + off), x1 = *(const f32x4*)(xin + off + 4), g0 = *(const f32x4*)(g + col), g1 = *(const f32x4*)(g + col + 4);
            f32x4 o0, o1;
#pragma unroll
            for (int j = 0; j < 4; ++j) { o0[j] = x0[j] + mx[j] * rstd * g0[j]; o1[j] = x1[j] + mx[4 + j] * rstd * g1[j]; }
            *(f32x4*)(xout + off) = o0; *(f32x4*)(xout + off + 4) = o1;
            u32x4 w; w.x = pk2(o0[0], o0[1]); w.y = pk2(o0[2], o0[3]); w.z = pk2(o1[0], o1[1]); w.w = pk2(o1[2], o1[3]);
            *(u32x4*)(XNB + off) = w;
        }
    }
}

#define XB_TMO      128
#define XB_XCNT(j)  (256  + 64 * (j))
#define XB_XSUB(j)  (1280 + 64 * (j))
#define XB_XGEN(j)  (2304 + 64 * (j))
#define XB_TOP      3328
#define XB_TOPGEN   3392
#define XCD_BAR_WORDS 3456
#define XB_SPIN_CAP (1u << 18)

__device__ __forceinline__ unsigned xb_ld(unsigned* p)              { return __hip_atomic_load(p, __ATOMIC_RELAXED, __HIP_MEMORY_SCOPE_AGENT); }
__device__ __forceinline__ unsigned xb_add(unsigned* p, unsigned v) { return __hip_atomic_fetch_add(p, v, __ATOMIC_RELAXED, __HIP_MEMORY_SCOPE_AGENT); }
__device__ __forceinline__ unsigned xb_xcc_id() { return (unsigned)__builtin_amdgcn_s_getreg((3 << 11) | 20) & 0xFu; }
#define XB_SPIN(cond, bar) do { unsigned _sp = 0; while (cond) { __builtin_amdgcn_s_sleep(1); \
    if ((++_sp & 255u) == 0u) { if (xb_ld(&(bar)[XB_TMO])) break; if (_sp > XB_SPIN_CAP) { atomicAdd(&(bar)[XB_TMO], 1u); break; } } } } while (0)

struct XcdBarrier {
    unsigned* bar; unsigned x;
    volatile unsigned* st;
};

__device__ __forceinline__ XcdBarrier xcd_barrier_post(unsigned* bar, volatile unsigned* st) {
    XcdBarrier b; b.bar = bar; b.x = xb_xcc_id(); b.st = st;
    if (threadIdx.x == 0) (void)xb_add(&bar[XB_XCNT(b.x)], 1u);
    return b;
}
__device__ __forceinline__ void xcd_barrier_complete(unsigned* bar, unsigned x, unsigned& nloc, unsigned& nx) {
    const unsigned G = gridDim.x * gridDim.y * gridDim.z;
    unsigned sum, cnt, mine, sp = 0u;
    for (;;) {
        sum = 0u; cnt = 0u; mine = 0u;
#pragma unroll
        for (unsigned j = 0; j < 16; ++j) { const unsigned c = xb_ld(&bar[XB_XCNT(j)]); sum += c; cnt += (c > 0u) ? 1u : 0u; mine = (j == x) ? c : mine; }
        if (sum == G) break;
        __builtin_amdgcn_s_sleep(1);
        if ((++sp & 255u) == 0u) { if (xb_ld(&bar[XB_TMO])) break; if (sp > XB_SPIN_CAP) { atomicAdd(&bar[XB_TMO], 1u); break; } }
    }
    nloc = mine > 0u ? mine : 1u; nx = cnt > 0u ? cnt : 1u;
}

__device__ __forceinline__ void xcd_barrier(const XcdBarrier& b) {
    asm volatile("s_waitcnt vmcnt(0)" ::: "memory");
    __syncthreads();
    if (threadIdx.x == 0) {
        unsigned* bar = b.bar;
        __builtin_amdgcn_s_waitcnt(0);
        unsigned nloc = b.st[0], nx = b.st[1];
        if (nloc == 0u) { xcd_barrier_complete(bar, b.x, nloc, nx); b.st[0] = nloc; b.st[1] = nx; }
        const unsigned old = xb_add(&bar[XB_XSUB(b.x)], 1u);
        const unsigned gen = old / nloc;
        if (old + 1u == (gen + 1u) * nloc) {
            __builtin_amdgcn_fence(__ATOMIC_RELEASE, "agent");
            asm volatile("s_waitcnt vmcnt(0)" ::: "memory");
            const unsigned og = xb_add(&bar[XB_TOP], 1u);
            const unsigned tg = og / nx;
            if (og + 1u == (tg + 1u) * nx) xb_add(&bar[XB_TOPGEN], 1u);
            else XB_SPIN(xb_ld(&bar[XB_TOPGEN]) == tg, bar);
            __builtin_amdgcn_fence(__ATOMIC_ACQUIRE, "agent");
            xb_add(&bar[XB_XGEN(b.x)], 1u);
            asm volatile("s_waitcnt vmcnt(0)" ::: "memory");
        } else {
            XB_SPIN(xb_ld(&bar[XB_XGEN(b.x)]) == gen, bar);
            __builtin_amdgcn_fence(__ATOMIC_ACQUIRE, "agent");
            asm volatile("s_waitcnt vmcnt(0)" ::: "memory");
        }
    }
    __syncthreads();
}

#ifndef MK_ONE_LAUNCH
#define MK_ONE_LAUNCH 1
#endif
constexpr int cmax_(int a, int b) { return a > b ? a : b; }
constexpr int LDS_MAIN = cmax_(cmax_(CS_LDS, CV_END), cmax_((int)pg8::STAGE_BYTES, 8 * PA_SIZE));
static_assert(LDS_MAIN + 64 <= 163840, "LDS budget");
constexpr int NSP = 7, N_PHASES = 1 + NSP * L_, KALL = (1 << (NSP + 1)) - 1;
template <int KMASK>
__global__ void __launch_bounds__(512, 2) fwd_kernel(Args a) {
    extern __shared__ __attribute__((aligned(16))) unsigned char shm[];
    float* ldsf = (float*)shm;
#if MK_ONE_LAUNCH
    cg::grid_group grid = cg::this_grid();
    volatile unsigned* bst = (volatile unsigned*)(shm + LDS_MAIN);
    if (threadIdx.x < 2) bst[threadIdx.x] = 0u;
    __syncthreads();
    const XcdBarrier xbar = xcd_barrier_post((unsigned*)(a.ws + WS_CTL), bst);
    bool first_bar = true;
#define GRID_BAR() do { if (first_bar) { grid.sync(); first_bar = false; } else xcd_barrier(xbar); } while (0)
#else
#define GRID_BAR() do { } while (0)
#endif
#ifndef DUP_SP
#define DUP_SP -1
#endif
#ifdef PROBE_SP
    unsigned long long probe_acc = 0, probe_t0 = __builtin_amdgcn_s_memrealtime();
#endif
    for (int ph = a.ph_lo; ph < a.ph_hi; ++ph) {
      const int nrep = (DUP_SP >= 0 && ph > 0 && (ph - 1) % NSP == DUP_SP) ? 2 : 1;
      for (int rep = 0; rep < nrep; ++rep) {
        if (rep) GRID_BAR();
        int tid_ = threadIdx.x; asm volatile("" : "+v"(tid_));
        const int tid = tid_, wave = __builtin_amdgcn_readfirstlane(tid >> 6), lane = tid & 63;
        if (ph == 0) { if constexpr ((KMASK >> NSP) & 1) phase_prologue(a, ldsf, wave, lane); }
        else {
            const int l = (ph - 1) / NSP, sp = (ph - 1) % NSP;
            if (sp == 0) {
                if constexpr ((KMASK >> 0) & 1) {
                pg8::Gemm g{(const bf16_t*)a.out, (const bf16_t*)(a.ws + WS_WIN) + (size_t)l * NZP * 1024, M_, NZP, 1024};
                pg8::StaticOrder S; S.init(M_, NZP, (int)gridDim.x, (int)blockIdx.x);
                EpiZ E{(bf16_t*)(a.ws + WS_Z), (const float*)(a.ws + WS_SSQ1)};
                pg8::gemm_phase<EpiZ, pg8::StaticOrder, false>((PG8_LAS unsigned char*)shm, g, S, E, nullptr);
                }
            } else if (sp == 1) {
                if constexpr ((KMASK >> 1) & 1) {
                for (int it = blockIdx.x; it < 256; it += gridDim.x) sgu_item(a, l, it, shm, tid, wave, lane);
#ifdef CONV_SKIP
                conv_phase<CONV_SKIP>(a, l, shm, tid, wave, lane); GRID_BAR();
#endif
                conv_phase<0>(a, l, shm, tid, wave, lane);
                }
            } else if (sp == 2) {
                if constexpr ((KMASK >> 2) & 1) scanprep_phase(a, l, shm, wave, lane);
            } else if (sp == 3) {
                if constexpr ((KMASK >> 3) & 1) {
#ifdef CSCAN_PROBE
                    cscan_phase<CSCAN_PROBE>(a, l, shm, tid, wave, lane); GRID_BAR();
#endif
                    cscan_phase<0>(a, l, shm, tid, wave, lane);
                }
            } else if (sp == 4) {
                if constexpr ((KMASK >> 4) & 1) phase_branchc(a, l, wave, lane);
            } else if (sp == 5) {
                if constexpr ((KMASK >> 5) & 1) {
#pragma unroll 1
                for (int rd = 0; rd < 2; ++rd) {
                    pg8::Gemm g{(const bf16_t*)(a.ws + WS_RA), (const bf16_t*)(a.ws + WS_WOUT) + (size_t)l * 1024 * 1024, M_, 1024, 1024};
                    RoundOrder S; S.base.init(M_, 1024, (int)gridDim.x, (int)blockIdx.x); S.round = rd;
                    EpiXnew E{(const bf16_t*)a.out, (bf16_t*)(a.ws + WS_RB), a.in[I_POSTG] + l * 1024, (float*)(a.ws + WS_XCH), (unsigned*)(a.ws + WS_CNT) + (size_t)l * 128 * 64};
                    pg8::gemm_phase<EpiXnew, RoundOrder, false>((PG8_LAS unsigned char*)shm, g, S, E, nullptr);
                }
                {
                    pg8::Gemm g{(const bf16_t*)(a.ws + WS_PB), (const bf16_t*)(a.ws + WS_WP) + (size_t)l * 1024 * 256, M_, 1024, 256};
                    pg8::StaticOrder S; S.init(M_, 1024, (int)gridDim.x, (int)blockIdx.x);
                    EpiPlain E{(bf16_t*)(a.ws + WS_PP)};
                    pg8::gemm_phase<EpiPlain, pg8::StaticOrder, false>((PG8_LAS unsigned char*)shm, g, S, E, nullptr);
                }
                }
            } else {
                if constexpr ((KMASK >> 6) & 1) {
                pg8::Gemm g{(const bf16_t*)(a.ws + WS_RB), (const bf16_t*)(a.ws + WS_WG) + (size_t)l * 1024 * 1024, M_, 1024, 1024};
                pg8::StaticOrder S; S.init(M_, 1024, (int)gridDim.x, (int)blockIdx.x);
                EpiOut E{(const bf16_t*)(a.ws + WS_RB), (const bf16_t*)(a.ws + WS_PP), (bf16_t*)a.out, l == L_ - 1 ? a.out : nullptr, (float*)(a.ws + WS_SSQ1), a.in[I_GB] + l * 1024};
                pg8::gemm_phase<EpiOut, pg8::StaticOrder, false>((PG8_LAS unsigned char*)shm, g, S, E, nullptr);
                }
            }
        }
      }
        if (ph + 1 < a.ph_hi) GRID_BAR();
#ifdef PROBE_SP
        { const unsigned long long tnow = __builtin_amdgcn_s_memrealtime(); if ((ph == 0 && PROBE_SP < 0) || (ph > 0 && (ph - 1) % NSP == PROBE_SP)) probe_acc += tnow - probe_t0; probe_t0 = tnow; }
#endif
    }
#ifdef PROBE_SP
    { const unsigned long long t0 = __builtin_amdgcn_s_memrealtime(); while (__builtin_amdgcn_s_memrealtime() - t0 < probe_acc) __builtin_amdgcn_s_sleep(8); }
#endif
}

template <int KMASK> static bool prep_kernel(int lds_bytes) {
    return hipFuncSetAttribute((const void*)fwd_kernel<KMASK>, hipFuncAttributeMaxDynamicSharedMemorySize, lds_bytes) == hipSuccess;
}
template <int K> static void launch_kind(int kind, int grid, int lds, hipStream_t st, const Args& a) {
    if constexpr (K <= NSP) { if (kind == K) hipLaunchKernelGGL(fwd_kernel<(1 << K)>, dim3(grid), dim3(512), lds, st, a); else launch_kind<K + 1>(kind, grid, lds, st, a); }
}
template <int K> static bool prep_all(int lds) { if constexpr (K <= NSP) return prep_kernel<(1 << K)>(lds) && prep_all<K + 1>(lds); else return true; }

extern "C" void kernel_launch(void* const* d_in, const int* in_sizes, int n_in, void* d_out, int out_size, void* d_ws, size_t ws_size, hipStream_t stream) {
    static int grid = 0;
    constexpr int LDS_BYTES = LDS_MAIN + 64;
    if (grid == 0) {
        if (n_in != N_IN || out_size != M_ * D_ || ws_size < WS_END) { fprintf(stderr, "kernel_launch: unexpected shapes (n_in %d, out %d, ws %zu < %zu)\n", n_in, out_size, ws_size, (size_t)WS_END); grid = -1; return; }
        int dev = 0, cus = 0;
        (void)hipGetDevice(&dev); (void)hipDeviceGetAttribute(&cus, hipDeviceAttributeMultiprocessorCount, dev);
#if MK_ONE_LAUNCH
        bool ok = prep_kernel<KALL>(LDS_BYTES);
        int per_cu = 0;
        (void)hipOccupancyMaxActiveBlocksPerMultiprocessor(&per_cu, (const void*)fwd_kernel<KALL>, 512, LDS_BYTES);
        (void)hipGetLastError();
        if (per_cu < 1) { fprintf(stderr, "kernel_launch: occupancy query says %d blocks per CU\n", per_cu); ok = false; }
#else
        bool ok = prep_all<0>(LDS_BYTES);
#endif
        if (!ok) { fprintf(stderr, "kernel_launch: kernel set-up failed\n"); grid = -1; return; }
        grid = cus;
    }
    if (grid < 0) return;
    Args a{};
    for (int i = 0; i < N_IN; ++i) a.in[i] = (const float*)d_in[i];
    a.out = (float*)d_out; a.ws = (unsigned char*)d_ws;
#if MK_ONE_LAUNCH
    (void)hipMemsetAsync(d_ws, 0, XCD_BAR_WORDS * 4, stream);
    (void)hipMemsetAsync((unsigned char*)d_ws + WS_CNT, 0, (size_t)L_ * 128 * 256, stream);
    a.ph_lo = 0; a.ph_hi = N_PHASES;
    void* args[] = {&a};
    hipError_t e = hipLaunchCooperativeKernel((const void*)fwd_kernel<KALL>, dim3(grid), dim3(512), args, LDS_BYTES, stream);
    if (e != hipSuccess) fprintf(stderr, "cooperative launch failed: %s (grid %d)\n", hipGetErrorString(e), grid);
#else
    for (int ph = 0; ph < N_PHASES; ++ph) {
        a.ph_lo = ph; a.ph_hi = ph + 1;
        launch_kind<0>(ph == 0 ? NSP : (ph - 1) % NSP, grid, LDS_BYTES, stream, a);
    }
#endif
}
```

```cpp
#include <hip/hip_runtime.h>
#include <hip/hip_cooperative_groups.h>
#include <cstdio>
namespace cg = cooperative_groups;
namespace pg8 {
#define PG8_LAS __attribute__((address_space(3)))
typedef unsigned short bf16_t;
typedef short bf16x8 __attribute__((ext_vector_type(8)));
typedef float f32x4 __attribute__((ext_vector_type(4)));
typedef unsigned u32x4 __attribute__((ext_vector_type(4)));
constexpr int BM = 256, BK = 64, HALF = 128, HTB = HALF * BK * 2  , STAGE_BYTES = 8 * HTB, NXCD = 8, WGM = 8;

__host__ __device__ __forceinline__ int lds_byte(int r, int c) { const int st = (r >> 4) * 2 + (c >> 5), rr = r & 15, cc = c & 31, ob = rr * 64 + cc * 2; return st * 1024 + (ob ^ (((ob >> 9) & 1) << 5)); }
__host__ __device__ __forceinline__ void stage_rc(int b, int& R, int& C) { const int st = b / 1024, sb = b % 1024, swz = sb ^ (((sb >> 9) & 1) << 5); R = (st >> 1) * 16 + swz / 64; C = (st & 1) * 32 + (swz % 64) / 2; }
__host__ __device__ __forceinline__ int perm32(int rho) { const int n = rho >> 4, i = rho & 15; return 8 * (i >> 2) + 4 * n + (i & 3); }

struct Unit { int pm, pn; };
struct Gemm { const bf16_t* A; const bf16_t* Bt; int M, N, K; };

struct StaticOrder {
    int nM, nN, nwg, G, c;
    __host__ __device__ void init(int M, int N, int G_, int c_) { nM = M / BM; nN = N / BM; nwg = nM * nN; G = G_; c = c_; }
    __host__ __device__ bool next(int i, Unit& u) const {
        const long L = (long)i * G + c; if (L >= nwg) return false;
        int wgid = (int)L; { const int q = nwg / NXCD, r = nwg % NXCD, xcd = wgid % NXCD, off = wgid / NXCD; wgid = (xcd < r ? xcd * (q + 1) : r * (q + 1) + (xcd - r) * q) + off; }
        const int nig = WGM * nN, gid = wgid / nig, fm = gid * WGM, gsz = (nM - fm) < WGM ? (nM - fm) : WGM;
        u.pm = fm + ((wgid % nig) % gsz); u.pn = (wgid % nig) / gsz; return true;
    }
    __device__ __forceinline__ void a_ready(const Unit&) const {}
    __device__ __forceinline__ void done(const Unit&) const {}
};
typedef __bf16 bf16x2_t __attribute__((ext_vector_type(2)));
__device__ __forceinline__ unsigned cvt_pk_bf16(float lo, float hi) { typedef float f32x2_t __attribute__((ext_vector_type(2))); return __builtin_bit_cast(unsigned, __builtin_convertvector((f32x2_t){lo, hi}, bf16x2_t)); }
typedef float f32x2 __attribute__((ext_vector_type(2)));
template <class Epi, class Sched, bool STAMP = false>
__device__ __forceinline__ void gemm_phase(PG8_LAS unsigned char* lds, const Gemm g, const Sched& S, const Epi& E, unsigned long long* stamps) {
    int tid_ = threadIdx.x; asm volatile("" : "+v"(tid_));
    const int tid = tid_, wid = __builtin_amdgcn_readfirstlane(tid >> 6), lane = tid & 63, wr = wid >> 2, wc = wid & 3, fr = lane & 15, fq = lane >> 4;
    const int K = g.K, nt = K / BK;
    int ts_lo = 0, ts_hi = 0, nts = 0; const unsigned long long rt_entry = STAMP ? (unsigned long long)wall_clock64() : 0ull;
#define PG8_STAMP() do { if (STAMP && wid == 0 && nts < 64) { const unsigned long long _c = (unsigned long long)clock64(); \
        ts_lo = (lane == nts) ? (int)(unsigned)_c : ts_lo; ts_hi = (lane == nts) ? (int)(unsigned)(_c >> 32) : ts_hi; ++nts; } } while (0)
    PG8_STAMP();
    unsigned voffA[2], voffB[2];
#pragma unroll
    for (int i = 0; i < 2; ++i) { int R, C; stage_rc(tid * 16 + i * 8192, R, C); const int Rb = Epi::PERM ? ((R & ~31) + perm32(R & 31)) : R;
        voffA[i] = (unsigned)(R * K + C) * 2u; voffB[i] = (unsigned)(Rb * K + C) * 2u; }
    const size_t kstep = (size_t)(BK * 2);
    const size_t hstep = (size_t)HALF * K * 2;
    const size_t tstep = 2 * hstep;
    const unsigned ldsw = (unsigned)wid * 1024u;
    const int aoff = lds_byte(wr * 64 + fr, fq * 8), boff = lds_byte(wc * 32 + fr, fq * 8);
#define PG8_SA(b, h) (((b) * 2 + (h)) * HTB)
#define PG8_SB(b, h) ((4 + (b) * 2 + (h)) * HTB)
#define PG8_STAGE(bufoff, gbase, voff) do { _Pragma("unroll") for (int _i = 0; _i < 2; ++_i) \
        __builtin_amdgcn_global_load_lds((const unsigned*)((const char*)(gbase) + (voff)[_i]), (PG8_LAS unsigned*)(lds + (bufoff) + ldsw + _i * 8192), 16, 0, 0); } while (0)
#define PG8_LDA(dst, b, h) do { _Pragma("unroll") for (int m = 0; m < 4; ++m) _Pragma("unroll") for (int k = 0; k < 2; ++k) dst[m][k] = *(const PG8_LAS bf16x8*)(lds + PG8_SA(b, h) + aoff + m * 2048 + k * 1024); } while (0)
#define PG8_LDB(dst, b, h) do { _Pragma("unroll") for (int n = 0; n < 2; ++n) _Pragma("unroll") for (int k = 0; k < 2; ++k) dst[n][k] = *(const PG8_LAS bf16x8*)(lds + PG8_SB(b, h) + boff + n * 2048 + k * 1024); } while (0)
#define PG8_MMA(ai, bj, At, Bt) do { __builtin_amdgcn_s_setprio(1); _Pragma("unroll") for (int m = 0; m < 4; ++m) _Pragma("unroll") for (int n = 0; n < 2; ++n) _Pragma("unroll") for (int k = 0; k < 2; ++k) \
        acc[ai][bj][m][n] = __builtin_amdgcn_mfma_f32_16x16x32_bf16(Bt[n][k], At[m][k], acc[ai][bj][m][n], 0, 0, 0); __builtin_amdgcn_s_setprio(0); } while (0)
#define PG8_WAIT_V(n) asm volatile("s_waitcnt vmcnt(" #n ")" ::: "memory")
#define PG8_WAIT_L(n) asm volatile("s_waitcnt lgkmcnt(" #n ")" ::: "memory")
#define PG8_BAR __builtin_amdgcn_s_barrier()
#define PG8_SCHED __builtin_amdgcn_sched_barrier(0)
    Unit cur, nxt; int ui = 0;
    if (!S.next(0, cur)) return;
    f32x4 acc[2][2][4][2];
#pragma unroll
    for (int a = 0; a < 2; ++a)
#pragma unroll
        for (int b = 0; b < 2; ++b)
#pragma unroll
            for (int m = 0; m < 4; ++m)
#pragma unroll
                for (int n = 0; n < 2; ++n) acc[a][b][m][n] = (f32x4){0.f, 0.f, 0.f, 0.f};
    bf16x8 At[4][2], B0[2][2], B1[2][2];
    const char* cA = (const char*)g.A + (size_t)cur.pm * tstep; const char* cB = (const char*)g.Bt + (size_t)cur.pn * tstep;
    S.a_ready(cur);
    PG8_STAGE(PG8_SB(0, 0), cB, voffB); PG8_STAGE(PG8_SA(0, 0), cA, voffA); PG8_STAGE(PG8_SB(0, 1), cB + hstep, voffB); PG8_STAGE(PG8_SA(0, 1), cA + hstep, voffA);
    if (wr == 1) PG8_BAR;
    PG8_WAIT_V(4); PG8_BAR;
    PG8_STAGE(PG8_SB(1, 0), cB + kstep, voffB); PG8_STAGE(PG8_SA(1, 0), cA + kstep, voffA); PG8_STAGE(PG8_SB(1, 1), cB + hstep + kstep, voffB);
    PG8_WAIT_V(6); PG8_BAR;
    PG8_STAMP();
    for (;;) {
        const bool has_next = S.next(ui + 1, nxt);
        const char* nA = has_next ? (const char*)g.A + (size_t)nxt.pm * tstep : cA; const char* nB = has_next ? (const char*)g.Bt + (size_t)nxt.pn * tstep : cB;
        for (int t = 0; t < nt; t += 2) {
            const bool last = (t == nt - 2);
            const char* a1 = cA + (size_t)(t + 1) * kstep;
            const char* a2 = last ? nA : cA + (size_t)(t + 2) * kstep; const char* b2 = last ? nB : cB + (size_t)(t + 2) * kstep;
            const char* a3 = a2 + kstep; const char* b3 = b2 + kstep;
            if (last && has_next) S.a_ready(nxt);
            PG8_LDB(B0, 0, 0); PG8_SCHED; PG8_LDA(At, 0, 0); PG8_STAGE(PG8_SA(1, 1), a1 + hstep, voffA);
            PG8_WAIT_L(8); PG8_BAR; PG8_WAIT_L(0); PG8_MMA(0, 0, At, B0); PG8_BAR; PG8_SCHED;
            PG8_LDB(B1, 0, 1); PG8_STAGE(PG8_SB(0, 0), b2, voffB);
            PG8_BAR; PG8_WAIT_L(0); PG8_MMA(0, 1, At, B1); PG8_BAR;
            PG8_LDA(At, 0, 1); PG8_STAGE(PG8_SA(0, 0), a2, voffA);
            PG8_BAR; PG8_WAIT_L(0); PG8_MMA(1, 0, At, B0); PG8_BAR; PG8_SCHED;
            PG8_STAGE(PG8_SB(0, 1), b2 + hstep, voffB);
            PG8_WAIT_V(6); PG8_BAR; PG8_MMA(1, 1, At, B1); PG8_BAR;
            PG8_LDB(B0, 1, 0); PG8_SCHED; PG8_LDA(At, 1, 0); PG8_STAGE(PG8_SA(0, 1), a2 + hstep, voffA);
            PG8_WAIT_L(8); PG8_BAR; PG8_WAIT_L(0); PG8_MMA(0, 0, At, B0); PG8_BAR; PG8_SCHED;
            PG8_LDB(B1, 1, 1); PG8_STAGE(PG8_SB(1, 0), b3, voffB);
            PG8_BAR; PG8_WAIT_L(0); PG8_MMA(0, 1, At, B1); PG8_BAR;
            PG8_LDA(At, 1, 1); PG8_STAGE(PG8_SA(1, 0), a3, voffA);
            PG8_BAR; PG8_WAIT_L(0); PG8_MMA(1, 0, At, B0); PG8_BAR; PG8_SCHED;
            PG8_STAGE(PG8_SB(1, 1), b3 + hstep, voffB);
            PG8_WAIT_V(6); PG8_BAR; PG8_MMA(1, 1, At, B1); PG8_BAR;
        }
        PG8_STAMP();
        if constexpr (!Epi::AFTER_DRAIN) { E(acc, cur, wr, wc, fr, fq); S.done(cur); }
        PG8_STAMP();
        if (!has_next) break;
#pragma unroll
        for (int a = 0; a < 2; ++a)
#pragma unroll
            for (int b = 0; b < 2; ++b)
#pragma unroll
                for (int m = 0; m < 4; ++m)
#pragma unroll
                    for (int n = 0; n < 2; ++n) acc[a][b][m][n] = (f32x4){0.f, 0.f, 0.f, 0.f};
        cur = nxt; cA = nA; cB = nB; ++ui;
    }
    PG8_WAIT_V(0);
    if (wr == 0) PG8_BAR;
    PG8_BAR;
    if constexpr (Epi::AFTER_DRAIN) { E.fused(acc, cur, wr, wc, fr, fq, lds, wid, lane); S.done(cur); }
    PG8_STAMP();
    if (STAMP && wid == 0) { stamps[lane] = lane < nts ? (((unsigned long long)(unsigned)ts_hi << 32) | (unsigned)ts_lo) : 0ull;
        if (lane == 62) stamps[62] = rt_entry; if (lane == 63) stamps[63] = (unsigned long long)wall_clock64(); }
#undef PG8_STAMP
#undef PG8_SA
#undef PG8_SB
#undef PG8_STAGE
#undef PG8_LDA
#undef PG8_LDB
#undef PG8_MMA
#undef PG8_WAIT_V
#undef PG8_WAIT_L
#undef PG8_BAR
#undef PG8_SCHED
}
}

using pg8::bf16_t; using pg8::f32x4; using pg8::u32x4; using pg8::Unit;
typedef unsigned u32x2 __attribute__((ext_vector_type(2)));

constexpr int M_ = 32768, D_ = 1024, S_ = 4096, L_ = 4;
constexpr int NZ = 3712, NZP = 3840;
constexpr int ZC_U = 0, ZC_V = 256, ZC_GA = 512, ZC_VAL = 768, ZC_GLU = 1024, ZC_GB = 1280, ZC_RK = 1536  , ZC_VG = 2560  , ZC_WD = 3584, ZC_AD = 3648;
constexpr float RMS_EPS = 1e-6f, LN_EPS = 1e-5f, GN_EPS = 64e-5f, DECAY_SCALE = 0.6065306597126334f;

enum { I_X = 0, I_P, I_PREG, I_WIN, I_SLNG, I_SLNB, I_SGUW, I_SGUB, I_CW, I_CB, I_CLNG, I_CLNB, I_PWW, I_PWB, I_MU, I_W0, I_WUP, I_A0, I_AUP, I_KK, I_KA, I_RK, I_LXG, I_LXB, I_WOUT, I_POSTG, I_PLEW, I_GW, I_GB, N_IN };

constexpr size_t WS_CTL = 0;
constexpr size_t WS_WIN = 65536;
constexpr size_t WS_WOUT = WS_WIN + (size_t)L_ * NZP * 1024 * 2;
constexpr size_t WS_WG = WS_WOUT + (size_t)L_ * 1024 * 1024 * 2;
constexpr size_t WS_WP = WS_WG + (size_t)L_ * 1024 * 1024 * 2;
constexpr size_t WS_SSQ1 = WS_WP + (size_t)L_ * 1024 * 256 * 2;
constexpr size_t WS_SSQ2 = WS_SSQ1 + (size_t)M_ * 16 * 4;
constexpr size_t WS_Z = WS_SSQ2 + (size_t)M_ * 16 * 4;
constexpr size_t WS_RA = WS_Z + (size_t)M_ * NZ * 2;
constexpr size_t WS_RB = WS_RA + (size_t)M_ * 1024 * 2;
constexpr size_t WS_WQ = WS_RB + (size_t)M_ * 1024 * 2;
constexpr size_t WS_AQ = WS_WQ + (size_t)M_ * 512 * 2;
constexpr size_t WS_PB = WS_AQ + (size_t)M_ * 512 * 2;
constexpr size_t WS_BON = WS_PB + (size_t)M_ * 256 * 2;
constexpr size_t WS_SGUW = WS_BON + (size_t)M_ * 8 * 4;
constexpr size_t WS_WPW = WS_SGUW + (size_t)L_ * 4 * 128 * 128 * 2;
constexpr size_t WS_WUP = WS_WPW + (size_t)L_ * 256 * 256 * 2;
constexpr size_t WS_AUP = WS_WUP + (size_t)L_ * 512 * 64 * 2;
constexpr size_t WS_XCH = WS_AUP + (size_t)L_ * 512 * 64 * 2;
constexpr size_t WS_CNT = WS_XCH + (size_t)128 * 256 * 4 * 4;
constexpr size_t WS_END = WS_CNT + (size_t)L_ * 128 * 256;
constexpr size_t WS_PP = WS_Z;

struct Args { const float* in[N_IN]; float* out; unsigned char* ws; int ph_lo, ph_hi; };
static_assert(sizeof(Args) == 8 * N_IN + 8 + 8 + 8, "no padding");

__device__ __forceinline__ float bf2f(unsigned h) { return __uint_as_float(h << 16); }
__device__ __forceinline__ unsigned f2bf(float f) { return pg8::cvt_pk_bf16(f, f) & 0xffffu; }
__device__ __forceinline__ unsigned pk2(float lo, float hi) { return pg8::cvt_pk_bf16(lo, hi); }
__device__ __forceinline__ float wave_sum(float v) {
#pragma unroll
    for (int o = 1; o < 64; o <<= 1) v += __shfl_xor(v, o);
    return v;
}
__device__ __forceinline__ float sigmoidf_(float x) { return __builtin_amdgcn_rcpf(1.0f + __expf(-x)); }
__device__ __forceinline__ float siluf_(float x) { return x * __builtin_amdgcn_rcpf(1.0f + __expf(-x)); }
__device__ __forceinline__ void unpack8(const u32x4 w, float (&o)[8]) {
    o[0] = bf2f(w.x & 0xffffu); o[1] = __uint_as_float(w.x & 0xffff0000u); o[2] = bf2f(w.y & 0xffffu); o[3] = __uint_as_float(w.y & 0xffff0000u);
    o[4] = bf2f(w.z & 0xffffu); o[5] = __uint_as_float(w.z & 0xffff0000u); o[6] = bf2f(w.w & 0xffffu); o[7] = __uint_as_float(w.w & 0xffff0000u);
}
__device__ __forceinline__ void unpack4(const u32x2 w, float (&o)[4]) {
    o[0] = bf2f(w.x & 0xffffu); o[1] = __uint_as_float(w.x & 0xffff0000u); o[2] = bf2f(w.y & 0xffffu); o[3] = __uint_as_float(w.y & 0xffff0000u);
}

struct EpiZ {
    static constexpr bool PERM = true, AFTER_DRAIN = false;
    bf16_t* Z; const float* ssq;
    __device__ __forceinline__ void operator()(const f32x4 (&acc)[2][2][4][2], const Unit& u, int wr, int wc, int fr, int fq) const {
        const int row0 = u.pm * 256 + wr * 64 + fr, col0 = u.pn * 256 + wc * 32 + 8 * fq;
#pragma unroll
        for (int ai = 0; ai < 2; ++ai)
#pragma unroll
            for (int m = 0; m < 4; ++m) {
                const int row = row0 + ai * 128 + m * 16;
                const f32x4* sp = (const f32x4*)(ssq + (size_t)row * 16);
                const f32x4 s0 = sp[0], s1 = sp[1], s2 = sp[2], s3 = sp[3];
                const float t = ((s0[0] + s0[1]) + (s0[2] + s0[3])) + ((s1[0] + s1[1]) + (s1[2] + s1[3])) + ((s2[0] + s2[1]) + (s2[2] + s2[3])) + ((s3[0] + s3[1]) + (s3[2] + s3[3]));
                const float rstd = rsqrtf(t * (1.0f / 1024.0f) + RMS_EPS);
#pragma unroll
                for (int bj = 0; bj < 2; ++bj) {
                    const int col = col0 + bj * 128;
                    if (col < NZ) {
                        const f32x4 v0 = acc[ai][bj][m][0] * rstd, v1 = acc[ai][bj][m][1] * rstd;
                        u32x4 w; w.x = pg8::cvt_pk_bf16(v0[0], v0[1]); w.y = pg8::cvt_pk_bf16(v0[2], v0[3]); w.z = pg8::cvt_pk_bf16(v1[0], v1[1]); w.w = pg8::cvt_pk_bf16(v1[2], v1[3]);
                        *(u32x4*)(Z + (size_t)row * NZ + col) = w;
                    }
                }
            }
    }
};
struct EpiMix {
    static constexpr bool PERM = true, AFTER_DRAIN = false;
    bf16_t* O; float* ssq;
    __device__ __forceinline__ void operator()(const f32x4 (&acc)[2][2][4][2], const Unit& u, int wr, int wc, int fr, int fq) const {
        const int row0 = u.pm * 256 + wr * 64 + fr, col0 = u.pn * 256 + wc * 32 + 8 * fq;
#pragma unroll
        for (int ai = 0; ai < 2; ++ai)
#pragma unroll
            for (int m = 0; m < 4; ++m) {
                const int row = row0 + ai * 128 + m * 16; float q = 0.f;
#pragma unroll
                for (int bj = 0; bj < 2; ++bj) {
                    const f32x4 v0 = acc[ai][bj][m][0], v1 = acc[ai][bj][m][1];
                    q += (v0[0] * v0[0] + v0[1] * v0[1]) + (v0[2] * v0[2] + v0[3] * v0[3]) + (v1[0] * v1[0] + v1[1] * v1[1]) + (v1[2] * v1[2] + v1[3] * v1[3]);
                    u32x4 w; w.x = pg8::cvt_pk_bf16(v0[0], v0[1]); w.y = pg8::cvt_pk_bf16(v0[2], v0[3]); w.z = pg8::cvt_pk_bf16(v1[0], v1[1]); w.w = pg8::cvt_pk_bf16(v1[2], v1[3]);
                    *(u32x4*)(O + (size_t)row * 1024 + col0 + bj * 128) = w;
                }
                q += __shfl_xor(q, 16); q += __shfl_xor(q, 32);
                if (fq == 0) ssq[(size_t)row * 16 + u.pn * 4 + wc] = q;
            }
    }
};
struct EpiPlain {
    static constexpr bool PERM = true, AFTER_DRAIN = false;
    bf16_t* O;
    __device__ __forceinline__ void operator()(const f32x4 (&acc)[2][2][4][2], const Unit& u, int wr, int wc, int fr, int fq) const {
        const int row0 = u.pm * 256 + wr * 64 + fr, col0 = u.pn * 256 + wc * 32 + 8 * fq;
#pragma unroll
        for (int ai = 0; ai < 2; ++ai)
#pragma unroll
            for (int m = 0; m < 4; ++m) {
                const int row = row0 + ai * 128 + m * 16;
#pragma unroll
                for (int bj = 0; bj < 2; ++bj) {
                    const f32x4 v0 = acc[ai][bj][m][0], v1 = acc[ai][bj][m][1];
                    u32x4 w; w.x = pg8::cvt_pk_bf16(v0[0], v0[1]); w.y = pg8::cvt_pk_bf16(v0[2], v0[3]); w.z = pg8::cvt_pk_bf16(v1[0], v1[1]); w.w = pg8::cvt_pk_bf16(v1[2], v1[3]);
                    *(u32x4*)(O + (size_t)row * 1024 + col0 + bj * 128) = w;
                }
            }
    }
};
struct EpiOut {
    static constexpr bool PERM = true, AFTER_DRAIN = false;
    const bf16_t* XN; const bf16_t* PP; bf16_t* XB; float* XF; float* ssq; const float* bias;
    __device__ __forceinline__ void operator()(const f32x4 (&acc)[2][2][4][2], const Unit& u, int wr, int wc, int fr, int fq) const {
        const int row0 = u.pm * 256 + wr * 64 + fr, col0 = u.pn * 256 + wc * 32 + 8 * fq;
        f32x4 bv[2][2];
#pragma unroll
        for (int bj = 0; bj < 2; ++bj)
#pragma unroll
            for (int n = 0; n < 2; ++n) bv[bj][n] = *(const f32x4*)(bias + col0 + bj * 128 + 4 * n);
#pragma unroll
        for (int ai = 0; ai < 2; ++ai)
#pragma unroll
            for (int m = 0; m < 4; ++m) {
                const int row = row0 + ai * 128 + m * 16; float q = 0.f;
#pragma unroll
                for (int bj = 0; bj < 2; ++bj) {
                    const size_t off = (size_t)row * 1024 + col0 + bj * 128;
                    const f32x4 g0 = acc[ai][bj][m][0] + bv[bj][0], g1 = acc[ai][bj][m][1] + bv[bj][1];
                    float xr[8], pp[8]; unpack8(*(const u32x4*)(XN + off), xr); unpack8(*(const u32x4*)(PP + off), pp);
                    f32x4 o0, o1;
#pragma unroll
                    for (int j = 0; j < 4; ++j) { o0[j] = xr[j] + pp[j] * sigmoidf_(g0[j]); o1[j] = xr[4 + j] + pp[4 + j] * sigmoidf_(g1[j]); }
                    if (XF) { *(f32x4*)(XF + off) = o0; *(f32x4*)(XF + off + 4) = o1; }
                    else {
                        u32x4 w; w.x = pg8::cvt_pk_bf16(o0[0], o0[1]); w.y = pg8::cvt_pk_bf16(o0[2], o0[3]); w.z = pg8::cvt_pk_bf16(o1[0], o1[1]); w.w = pg8::cvt_pk_bf16(o1[2], o1[3]);
                        *(u32x4*)(XB + off) = w;
                        q += (o0[0] * o0[0] + o0[1] * o0[1]) + (o0[2] * o0[2] + o0[3] * o0[3]) + (o1[0] * o1[0] + o1[1] * o1[1]) + (o1[2] * o1[2] + o1[3] * o1[3]);
                    }
                }
                if (!XF) { q += __shfl_xor(q, 16); q += __shfl_xor(q, 32); if (fq == 0) ssq[(size_t)row * 16 + u.pn * 4 + wc] = q; }
            }
    }
};


struct EpiXnew {
    static constexpr bool PERM = true, AFTER_DRAIN = true;
    const bf16_t* xin; bf16_t* XNB; const float* g; float* xbuf; unsigned* cnt;
    __device__ __forceinline__ void fused(f32x4 (&acc)[2][2][4][2], const Unit& u, int wr, int wc, int fr, int fq, PG8_LAS unsigned char* lds, int wid, int lane) const {
        PG8_LAS float* P = (PG8_LAS float*)lds;
        PG8_LAS float* Sr = (PG8_LAS float*)(lds + 4096);
#pragma unroll
        for (int ai = 0; ai < 2; ++ai)
#pragma unroll
            for (int m = 0; m < 4; ++m) {
                float q = 0.f;
#pragma unroll
                for (int bj = 0; bj < 2; ++bj)
#pragma unroll
                    for (int n = 0; n < 2; ++n) { const f32x4 v = acc[ai][bj][m][n]; q += (v[0] * v[0] + v[1] * v[1]) + (v[2] * v[2] + v[3] * v[3]); }
                q += __shfl_xor(q, 16); q += __shfl_xor(q, 32);
                if (fq == 0) P[(ai * 128 + wr * 64 + m * 16 + fr) * 4 + wc] = q;
            }
        asm volatile("s_waitcnt lgkmcnt(0)" ::: "memory"); __builtin_amdgcn_s_barrier(); asm volatile("" ::: "memory");
        const int row = wid * 32 + (lane & 31);
        if (lane < 32) {
            const float t = (P[row * 4 + 0] + P[row * 4 + 1]) + (P[row * 4 + 2] + P[row * 4 + 3]);
            __hip_atomic_store(xbuf + ((size_t)(u.pm * 256 + row) * 4 + u.pn), t, __ATOMIC_RELAXED, __HIP_MEMORY_SCOPE_AGENT);
        }
        asm volatile("s_waitcnt vmcnt(0)" ::: "memory");
        if (lane == 0) __hip_atomic_fetch_add(cnt + 64 * u.pm, 1u, __ATOMIC_RELAXED, __HIP_MEMORY_SCOPE_AGENT);
        if (wid == 0) {
            unsigned spins = 0;
            while ((unsigned)__builtin_amdgcn_readfirstlane(__hip_atomic_load(cnt + 64 * u.pm, __ATOMIC_RELAXED, __HIP_MEMORY_SCOPE_AGENT)) < 32u) { __builtin_amdgcn_s_sleep(2); if (++spins > (1u << 22)) break; }
            __builtin_amdgcn_fence(__ATOMIC_ACQUIRE, "agent");
        }
        asm volatile("s_waitcnt vmcnt(0) lgkmcnt(0)" ::: "memory"); __builtin_amdgcn_s_barrier(); asm volatile("" ::: "memory");
        if (lane < 32) {
            const float* slot = xbuf + (size_t)(u.pm * 256 + row) * 4; float t = 0.f;
#pragma unroll
            for (int k = 0; k < 4; ++k) t += __hip_atomic_load(slot + k, __ATOMIC_RELAXED, __HIP_MEMORY_SCOPE_AGENT);
            Sr[row] = rsqrtf(t * (1.0f / 1024.0f) + RMS_EPS);
        }
        asm volatile("s_waitcnt lgkmcnt(0)" ::: "memory"); __builtin_amdgcn_s_barrier(); asm volatile("" ::: "memory");
        float rs[2][4];
#pragma unroll
        for (int ai = 0; ai < 2; ++ai)
#pragma unroll
            for (int m = 0; m < 4; ++m) rs[ai][m] = Sr[ai * 128 + wr * 64 + m * 16 + fr];
        asm volatile("s_waitcnt lgkmcnt(0)" ::: "memory"); __builtin_amdgcn_s_barrier(); asm volatile("" ::: "memory");
        const int col0 = u.pn * 256 + wc * 32 + 8 * fq;
        f32x4 gv[2][2];
#pragma unroll
        for (int bj = 0; bj < 2; ++bj)
#pragma unroll
            for (int n = 0; n < 2; ++n) gv[bj][n] = *(const f32x4*)(g + col0 + bj * 128 + 4 * n);
#pragma unroll
        for (int ai = 0; ai < 2; ++ai)
#pragma unroll
            for (int m = 0; m < 4; ++m) {
                const int r = ai * 128 + wr * 64 + m * 16 + fr; const float rstd = rs[ai][m];
#pragma unroll
                for (int bj = 0; bj < 2; ++bj) {
                    const size_t off = (size_t)(u.pm * 256 + r) * 1024 + col0 + bj * 128;
                    float xr[8]; unpack8(*(const u32x4*)(xin + off), xr);
                    const f32x4 o0 = (f32x4){xr[0], xr[1], xr[2], xr[3]} + acc[ai][bj][m][0] * rstd * gv[bj][0], o1 = (f32x4){xr[4], xr[5], xr[6], xr[7]} + acc[ai][bj][m][1] * rstd * gv[bj][1];
                    u32x4 w; w.x = pg8::cvt_pk_bf16(o0[0], o0[1]); w.y = pg8::cvt_pk_bf16(o0[2], o0[3]); w.z = pg8::cvt_pk_bf16(o1[0], o1[1]); w.w = pg8::cvt_pk_bf16(o1[2], o1[3]);
                    *(u32x4*)(XNB + off) = w;
                }
                asm volatile("" ::: "memory");
            }
    }
};
struct RoundOrder {
    pg8::StaticOrder base; int round;
    __device__ bool next(int i, Unit& u) const { return i == 0 ? base.next(round, u) : false; }
    __device__ __forceinline__ void a_ready(const Unit&) const {}
    __device__ __forceinline__ void done(const Unit&) const {}
};

__device__ __forceinline__ int win_dst_col(int o) {
    if (o < 1536) return o;
    if (o < 2560) return ZC_RK + 2 * ((o - 1536) & 511) + ((o - 1536) >> 9);
    if (o < 3072) return ZC_VG + 2 * (o - 2560);
    if (o < 3200) return o + 512;
    return ZC_VG + 2 * (o - 3200) + 1;
}
template <bool WINMAP = false>
__device__ __forceinline__ void transpose_item(const float* W, int K, int N, int k0, int nsrc0, bf16_t* WT, int ndst0, const float* g, float* scr, int lane) {
    float vv[32];
#pragma unroll
    for (int i = 0; i < 32; ++i) { const int kk = 2 * i + (lane >> 5); vv[i] = 0.f; if (nsrc0 >= 0) vv[i] = W[(size_t)(k0 + kk) * N + nsrc0 + (lane & 31)]; }
#pragma unroll
    for (int i = 0; i < 32; ++i) { const int kk = 2 * i + (lane >> 5); float v = vv[i]; if (g) v *= g[k0 + kk]; scr[kk * 33 + (lane & 31)] = v; }
    __builtin_amdgcn_s_waitcnt(0xC07F); asm volatile("" ::: "memory");
    const int c = lane & 7;
#pragma unroll
    for (int j = 0; j < 4; ++j) {
        const int n = (lane >> 3) + 8 * j; const float* s = scr + (8 * c) * 33 + n;
        u32x4 o; o.x = pk2(s[0 * 33], s[1 * 33]); o.y = pk2(s[2 * 33], s[3 * 33]); o.z = pk2(s[4 * 33], s[5 * 33]); o.w = pk2(s[6 * 33], s[7 * 33]);
        const int row = (WINMAP && nsrc0 >= 0) ? win_dst_col(nsrc0 + n) : ndst0 + n;
        *(u32x4*)(WT + (size_t)row * K + k0 + 8 * c) = o;
    }
    __builtin_amdgcn_s_waitcnt(0xC07F); asm volatile("" ::: "memory");
}
__device__ __forceinline__ void phase_prologue(const Args& a, float* ldsf, int wave, int lane) {
    float* scr = ldsf + wave * (64 * 33);
    const int gw = blockIdx.x * 8 + wave, NGW = gridDim.x * 8;
    constexpr int I_IN = 16 * (NZP / 32), I_SQ = 16 * 32, I_PL = 4 * 32, I_LAYER = I_IN + 2 * I_SQ + I_PL;
    for (int it = gw; it < L_ * I_LAYER; it += NGW) {
        const int l = it / I_LAYER; int r = it % I_LAYER;
        if (r < I_IN) {
            const int kb = r % 16, nb = r / 16, n0 = nb * 32;
            transpose_item<true>(a.in[I_WIN] + (size_t)l * 1024 * NZ, 1024, NZ, kb * 64, n0 < NZ ? n0 : -1, (bf16_t*)(a.ws + WS_WIN) + (size_t)l * NZP * 1024, n0, a.in[I_PREG] + l * 1024, scr, lane);
            continue;
        }
        r -= I_IN;
        if (r < I_SQ) { transpose_item(a.in[I_WOUT] + (size_t)l * 1024 * 1024, 1024, 1024, (r % 16) * 64, (r / 16) * 32, (bf16_t*)(a.ws + WS_WOUT) + (size_t)l * 1024 * 1024, (r / 16) * 32, nullptr, scr, lane); continue; }
        r -= I_SQ;
        if (r < I_SQ) { transpose_item(a.in[I_GW] + (size_t)l * 1024 * 1024, 1024, 1024, (r % 16) * 64, (r / 16) * 32, (bf16_t*)(a.ws + WS_WG) + (size_t)l * 1024 * 1024, (r / 16) * 32, nullptr, scr, lane); continue; }
        r -= I_SQ;
        transpose_item(a.in[I_PLEW] + (size_t)l * 256 * 1024, 256, 1024, (r % 4) * 64, (r / 4) * 32, (bf16_t*)(a.ws + WS_WP) + (size_t)l * 1024 * 256, (r / 4) * 32, nullptr, scr, lane);
    }
    {
        const int lr = lane & 31, lh = lane >> 5;
        for (int it = gw; it < 3 * 512; it += NGW) {
            const int kind = it >> 9, r = it & 511; float v[8]; bf16_t* dst;
            if (kind == 0) {
                const int l = r >> 7, nt = (r >> 4) & 7, ks = r & 15; const float* src = a.in[I_PWW] + (size_t)l * 256 * 256 + (size_t)(16 * ks + 8 * lh) * 256 + nt * 32 + lr;
#pragma unroll
                for (int j = 0; j < 8; ++j) v[j] = src[j * 256];
                dst = (bf16_t*)(a.ws + WS_WPW) + ((((size_t)l * 8 + nt) * 16 + ks) * 64 + lane) * 8;
            } else if (kind == 1) {
                const int mx = r >> 8, l = (r >> 6) & 3, ct = (r >> 2) & 15, ks = r & 3; const float* src = a.in[mx ? I_AUP : I_WUP] + (size_t)l * 64 * 512 + (size_t)(16 * ks + 8 * lh) * 512 + ct * 32 + lr;
#pragma unroll
                for (int j = 0; j < 8; ++j) v[j] = src[j * 512];
                dst = (bf16_t*)(a.ws + (mx ? WS_AUP : WS_WUP)) + ((((size_t)l * 16 + ct) * 4 + ks) * 64 + lane) * 8;
            } else {
                const int l = r >> 7, h = (r >> 5) & 3, itl = (r >> 3) & 3, ks = r & 7; const float* src = a.in[I_SGUW] + (((size_t)l * 4 + h) * 128 + itl * 32 + lr) * 128 + 16 * ks + 8 * lh;
                const f32x4 s0 = *(const f32x4*)(src), s1 = *(const f32x4*)(src + 4);
                v[0] = s0[0]; v[1] = s0[1]; v[2] = s0[2]; v[3] = s0[3]; v[4] = s1[0]; v[5] = s1[1]; v[6] = s1[2]; v[7] = s1[3];
                dst = (bf16_t*)(a.ws + WS_SGUW) + (((((size_t)l * 4 + h) * 4 + itl) * 8 + ks) * 64 + lane) * 8;
            }
            *(u32x4*)dst = (u32x4){pk2(v[0], v[1]), pk2(v[2], v[3]), pk2(v[4], v[5]), pk2(v[6], v[7])};
        }
    }
    const float* x = a.in[I_X]; bf16_t* XB = (bf16_t*)a.out; float* ssq = (float*)(a.ws + WS_SSQ1);
    for (int m0 = gw * 4; m0 < M_; m0 += NGW * 4) {
        f32x4 xv[4][4];
#pragma unroll
        for (int r = 0; r < 4; ++r)
#pragma unroll
            for (int h = 0; h < 2; ++h) { const size_t off = (size_t)(m0 + r) * 1024 + h * 512 + lane * 8; xv[r][2 * h] = *(const f32x4*)(x + off); xv[r][2 * h + 1] = *(const f32x4*)(x + off + 4); }
#pragma unroll
        for (int r = 0; r < 4; ++r) {
            float q = 0.f;
#pragma unroll
            for (int h = 0; h < 2; ++h) {
                const size_t off = (size_t)(m0 + r) * 1024 + h * 512 + lane * 8;
                const f32x4 x0 = xv[r][2 * h], x1 = xv[r][2 * h + 1];
                q += (x0[0] * x0[0] + x0[1] * x0[1]) + (x0[2] * x0[2] + x0[3] * x0[3]) + (x1[0] * x1[0] + x1[1] * x1[1]) + (x1[2] * x1[2] + x1[3] * x1[3]);
                u32x4 w; w.x = pk2(x0[0], x0[1]); w.y = pk2(x0[2], x0[3]); w.z = pk2(x1[0], x1[1]); w.w = pk2(x1[2], x1[3]);
                *(u32x4*)(XB + off) = w;
            }
            q = wave_sum(q);
            if (lane < 16) ssq[(size_t)(m0 + r) * 16 + lane] = lane == 0 ? q : 0.f;
        }
    }
}

template <int CTRL> __device__ __forceinline__ float dpp_f(float x) { return __builtin_bit_cast(float, __builtin_amdgcn_update_dpp(0, __builtin_bit_cast(int, x), CTRL, 0xf, 0xf, true)); }
__device__ __forceinline__ float allreduce16(float x) {
    x += dpp_f<0xB1>(x);
    x += dpp_f<0x4E>(x);
    x += dpp_f<0x141>(x);
    x += dpp_f<0x140>(x);
    return x;
}
__device__ __forceinline__ float wave_sum_d(float v) { v = allreduce16(v); v += __shfl_xor(v, 16); v += __shfl_xor(v, 32); return v; }
typedef float f32x16 __attribute__((ext_vector_type(16)));
using pg8::bf16x8;
#define MFMA32(a, b, c) __builtin_amdgcn_mfma_f32_32x32x16_bf16((a), (b), (c), 0, 0, 0)
constexpr int SG_PITCH = 272;
__device__ __forceinline__ void sgu_item(const Args& a, int l, int nb, unsigned char* shm, int tid_in, int wave, int lane_in) {
    int tid = tid_in, lane = lane_in; asm volatile("" : "+v"(tid), "+v"(lane));
    const bf16_t* Z = (const bf16_t*)(a.ws + WS_Z); bf16_t* CAT = (bf16_t*)(a.ws + WS_RA);
    {
        const f32x4 g = *(const f32x4*)(a.in[I_SLNG] + l * 256 + lane * 4), bb = *(const f32x4*)(a.in[I_SLNB] + l * 256 + lane * 4);
        u32x2 vld[16];
#pragma unroll
        for (int tt = 0; tt < 16; ++tt) vld[tt] = *(const u32x2*)(Z + ((size_t)nb * 128 + wave * 16 + tt) * NZ + ZC_V + lane * 4);
#pragma unroll
        for (int tt = 0; tt < 16; ++tt) {
            const int j = wave * 16 + tt;
            float v[4]; unpack4(vld[tt], v);
            const float mu = wave_sum_d((v[0] + v[1]) + (v[2] + v[3])) * (1.0f / 256.0f);
            const float d0 = v[0] - mu, d1 = v[1] - mu, d2 = v[2] - mu, d3 = v[3] - mu;
            const float rs = rsqrtf(wave_sum_d((d0 * d0 + d1 * d1) + (d2 * d2 + d3 * d3)) * (1.0f / 256.0f) + LN_EPS);
            unsigned short* dst = (unsigned short*)(shm + (size_t)(lane * 4) * SG_PITCH + j * 2);
            dst[0] = (unsigned short)f2bf(d0 * rs * g[0] + bb[0]); dst[SG_PITCH / 2] = (unsigned short)f2bf(d1 * rs * g[1] + bb[1]);
            dst[SG_PITCH] = (unsigned short)f2bf(d2 * rs * g[2] + bb[2]); dst[3 * SG_PITCH / 2] = (unsigned short)f2bf(d3 * rs * g[3] + bb[3]);
        }
    }
    __syncthreads();
    {
        const int h = wave >> 1, dt = wave & 1, lr = lane & 31, lh = lane >> 5;
        const unsigned char* arow = shm + (size_t)(h * 64 + dt * 32 + lr) * SG_PITCH + lh * 16;
        const bf16_t* wb = (const bf16_t*)(a.ws + WS_SGUW) + ((((size_t)l * 4 + h) * 4 * 8) * 64 + lane) * 8;
        f32x16 acc[4];
#pragma unroll
        for (int it = 0; it < 4; ++it)
#pragma unroll
            for (int r = 0; r < 16; ++r) acc[it][r] = 0.f;
#pragma unroll
        for (int ks = 0; ks < 8; ++ks) {
            const bf16x8 af = *(const bf16x8*)(arow + ks * 32);
#pragma unroll
            for (int it = (ks < 4 ? 0 : 2); it < 4; ++it) {
                const bf16x8 bf = *(const bf16x8*)(wb + (size_t)(it * 8 + ks) * 512);
                acc[it] = MFMA32(af, bf, acc[it]);
            }
        }
#pragma unroll
        for (int it = 0; it < 4; ++it) {
            const int i = it * 32 + lr; const size_t tok = (size_t)nb * 128 + i;
            const float bs = a.in[I_SGUB][((size_t)l * 4 + h) * 128 + i];
#pragma unroll
            for (int g = 0; g < 4; ++g) {
                const int c0 = h * 64 + dt * 32 + 8 * g + 4 * lh;
                float uu[4], gg[4]; unpack4(*(const u32x2*)(Z + tok * NZ + ZC_U + c0), uu); unpack4(*(const u32x2*)(Z + tok * NZ + ZC_GA + c0), gg);
                u32x2 o; o.x = pk2(uu[0] * (acc[it][4 * g] + bs) * siluf_(gg[0]), uu[1] * (acc[it][4 * g + 1] + bs) * siluf_(gg[1]));
                o.y = pk2(uu[2] * (acc[it][4 * g + 2] + bs) * siluf_(gg[2]), uu[3] * (acc[it][4 * g + 3] + bs) * siluf_(gg[3]));
                *(u32x2*)(CAT + tok * 1024 + c0) = o;
            }
        }
    }
    __syncthreads();
}

constexpr int CV_T = 64, CV_ROWS = CV_T + 30;
constexpr int CV_Y = 0;
constexpr int CV_C = CV_ROWS * 512;
constexpr int CV_APITCH = 528, CV_TPITCH = 144;
constexpr int CV_TW = CV_C + CV_T * 1024;
constexpr int CV_AD = CV_TW + CV_T * CV_TPITCH;
constexpr int CV_END = CV_AD + CV_T * CV_TPITCH;
__device__ __forceinline__ float tanh_fast(float x) { return 1.0f - 2.0f * __builtin_amdgcn_rcpf(__expf(2.0f * x) + 1.0f); }
template <int SKIP = 0>
__device__ __forceinline__ void conv_phase(const Args& a, int l, unsigned char* shm, int tid_in, int wave, int lane_in) {
    int tid = tid_in, lane = lane_in; asm volatile("" : "+v"(tid), "+v"(lane));
    const bf16_t* Z = (const bf16_t*)(a.ws + WS_Z); bf16_t* CAT = (bf16_t*)(a.ws + WS_RA);
    float* cbuf = (float*)(shm + CV_C);
    for (int item = blockIdx.x; item < M_ / CV_T; item += gridDim.x) {
        const int t0 = item * CV_T, pos0 = t0 & (S_ - 1);
        if (!(SKIP & 1))
        {
            int tid1 = tid; asm volatile("" : "+v"(tid1));
            const int c4 = (tid1 & 63) * 4, rg = tid1 >> 6;
            u32x2 vw[12], gw[12];
#pragma unroll
            for (int i = 0; i < 12; ++i) {
                const int rr = rg + 8 * i; vw[i] = (u32x2){0u, 0u}; gw[i] = (u32x2){0u, 0u};
                if (rr < CV_ROWS && pos0 - 30 + rr >= 0) { const size_t tok = (size_t)(t0 - 30 + rr); vw[i] = *(const u32x2*)(Z + tok * NZ + ZC_VAL + c4); gw[i] = *(const u32x2*)(Z + tok * NZ + ZC_GLU + c4); }
            }
#pragma unroll
            for (int i = 0; i < 12; ++i) {
                const int rr = rg + 8 * i;
                if (rr < CV_ROWS) {
                    float v[4], g[4]; unpack4(vw[i], v); unpack4(gw[i], g);
                    *(u32x2*)(shm + CV_Y + rr * 512 + c4 * 2) = (u32x2){pk2(v[0] * sigmoidf_(g[0]), v[1] * sigmoidf_(g[1])), pk2(v[2] * sigmoidf_(g[2]), v[3] * sigmoidf_(g[3]))};
                }
            }
        }
        if (!(SKIP & 2)) {
            int tid1 = tid; asm volatile("" : "+v"(tid1));
            const int t = tid1 >> 3, j0 = (tid1 & 7) * 16; const size_t tok = (size_t)(t0 + t);
            const bf16_t* zp = Z + tok * NZ + ZC_WD + j0;
            const u32x4 c0 = *(const u32x4*)(zp), c1 = *(const u32x4*)(zp + 8);
            u32x4 p0 = (u32x4){0u, 0u, 0u, 0u}, p1 = p0;
            if (pos0 + t > 0) { p0 = *(const u32x4*)(zp - NZ); p1 = *(const u32x4*)(zp - NZ + 8); }
            const float* mu = a.in[I_MU] + (size_t)l * 1664 + 1536 + j0;
            float zc[16], zq[16]; { float t8[8]; unpack8(c0, t8);
#pragma unroll
                for (int e = 0; e < 8; ++e) zc[e] = t8[e]; unpack8(c1, t8);
#pragma unroll
                for (int e = 0; e < 8; ++e) zc[8 + e] = t8[e]; unpack8(p0, t8);
#pragma unroll
                for (int e = 0; e < 8; ++e) zq[e] = t8[e]; unpack8(p1, t8);
#pragma unroll
                for (int e = 0; e < 8; ++e) zq[8 + e] = t8[e]; }
            float o[16];
#pragma unroll
            for (int e4 = 0; e4 < 4; ++e4) { const f32x4 m4 = *(const f32x4*)(mu + 4 * e4);
#pragma unroll
                for (int e = 0; e < 4; ++e) { const float sft = zc[4 * e4 + e] + m4[e] * (zq[4 * e4 + e] - zc[4 * e4 + e]); o[4 * e4 + e] = j0 < 64 ? tanh_fast(sft) : sft; } }
            unsigned char* dst = shm + (j0 < 64 ? CV_TW + t * CV_TPITCH + j0 * 2 : CV_AD + t * CV_TPITCH + (j0 - 64) * 2);
            *(u32x4*)(dst) = (u32x4){pk2(o[0], o[1]), pk2(o[2], o[3]), pk2(o[4], o[5]), pk2(o[6], o[7])};
            *(u32x4*)(dst + 16) = (u32x4){pk2(o[8], o[9]), pk2(o[10], o[11]), pk2(o[12], o[13]), pk2(o[14], o[15])};
        }
        __syncthreads();
        if (!(SKIP & 4)) {
            int tid2 = tid; asm volatile("" : "+v"(tid2));
            const int c = tid2 & 255, th = tid2 >> 8;
            float cw[31];
#pragma unroll
            for (int k = 0; k < 31; ++k) cw[k] = a.in[I_CW][((size_t)l * 31 + k) * 256 + c];
            const float cb = a.in[I_CB][l * 256 + c];
#pragma unroll 1
            for (int run = 0; run < 2; ++run) {
                const int tb = th * 32 + run * 16;
                float yr[46];
#pragma unroll
                for (int i = 0; i < 46; ++i) yr[i] = bf2f(*(const unsigned short*)(shm + CV_Y + (tb + i) * 512 + c * 2));
#pragma unroll
                for (int t = 0; t < 16; ++t) {
                    float acc = cb;
#pragma unroll
                    for (int k = 0; k < 31; ++k) acc += yr[t + k] * cw[k];
                    cbuf[(tb + t) * 256 + c] = acc;
                }
            }
        }
        __syncthreads();
        int ln4 = lane; asm volatile("" : "+v"(ln4));
        int lr = ln4 & 31, lh = ln4 >> 5;
        bf16x8 wpf[16];
        {
            const bf16_t* wp = (const bf16_t*)(a.ws + WS_WPW) + ((((size_t)l * 8 + wave) * 16) * 64 + ln4) * 8;
#pragma unroll
            for (int ks = 0; ks < 16; ++ks) wpf[ks] = *(const bf16x8*)(wp + ks * 512);
        }
        unsigned gbr[2][16];
#pragma unroll
        for (int tt = 0; tt < 2; ++tt)
#pragma unroll
            for (int r = 0; r < 16; ++r) gbr[tt][r] = Z[(size_t)(t0 + tt * 32 + (r & 3) + 8 * (r >> 2) + 4 * lh) * NZ + ZC_GB + wave * 32 + lr];
        if (!(SKIP & 8)) {
            const f32x4 g = *(const f32x4*)(a.in[I_CLNG] + l * 256 + lane * 4), b = *(const f32x4*)(a.in[I_CLNB] + l * 256 + lane * 4);
#pragma unroll
            for (int tt = 0; tt < 8; ++tt) {
                const int t = wave * 8 + tt;
                f32x4 v = *(const f32x4*)(cbuf + t * 256 + lane * 4);
                const float mu = wave_sum_d((v[0] + v[1]) + (v[2] + v[3])) * (1.0f / 256.0f);
                v = v - mu;
                const float rs = rsqrtf(wave_sum_d((v[0] * v[0] + v[1] * v[1]) + (v[2] * v[2] + v[3] * v[3])) * (1.0f / 256.0f) + LN_EPS);
                u32x2 o; o.x = pk2(siluf_(v[0] * rs * g[0] + b[0]), siluf_(v[1] * rs * g[1] + b[1])); o.y = pk2(siluf_(v[2] * rs * g[2] + b[2]), siluf_(v[3] * rs * g[3] + b[3]));
                *(u32x2*)(shm + CV_Y + t * CV_APITCH + lane * 8) = o;
            }
        }
        __syncthreads();
        f32x4 pbv[4][2];
        {
            int tid6 = tid; asm volatile("" : "+v"(tid6));
            const float* p = a.in[I_P] + ((size_t)l * M_ + t0) * 256;
#pragma unroll
            for (int h = 0; h < 4; ++h) { const int e0 = (h * 512 + tid6) * 8; pbv[h][0] = *(const f32x4*)(p + e0); pbv[h][1] = *(const f32x4*)(p + e0 + 4); }
        }
        if (!(SKIP & 16)) {
            f32x16 acc[2];
#pragma unroll
            for (int r = 0; r < 16; ++r) { acc[0][r] = 0.f; acc[1][r] = 0.f; }
            const unsigned char* bp = shm + CV_Y + lr * CV_APITCH + lh * 16;
#pragma unroll
            for (int ks = 0; ks < 16; ++ks) { acc[0] = MFMA32(*(const bf16x8*)(bp + ks * 32), wpf[ks], acc[0]); acc[1] = MFMA32(*(const bf16x8*)(bp + 32 * CV_APITCH + ks * 32), wpf[ks], acc[1]); }
            const int n = wave * 32 + lr; const float pb = a.in[I_PWB][l * 256 + n];
#pragma unroll
            for (int tt = 0; tt < 2; ++tt) {
#pragma unroll
                for (int r = 0; r < 16; ++r) CAT[(size_t)(t0 + tt * 32 + (r & 3) + 8 * (r >> 2) + 4 * lh) * 1024 + 256 + n] = (bf16_t)f2bf((acc[tt][r] + pb) * siluf_(bf2f(gbr[tt][r])));
            }
        }
        if (!(SKIP & 32)) {
            int ln5 = lane; asm volatile("" : "+v"(ln5)); lr = ln5 & 31; lh = ln5 >> 5;
            unsigned* AW = (unsigned*)(a.ws + WS_WQ);
#pragma unroll
            for (int cc = 0; cc < 2; ++cc) {
                const int ct = wave * 2 + cc;
                const bf16_t* wu = (const bf16_t*)(a.ws + WS_WUP) + ((((size_t)l * 16 + ct) * 4) * 64 + (lr + 32 * lh)) * 8;
                const bf16_t* au = (const bf16_t*)(a.ws + WS_AUP) + ((((size_t)l * 16 + ct) * 4) * 64 + (lr + 32 * lh)) * 8;
                bf16x8 wf[4], af[4];
#pragma unroll
                for (int ks = 0; ks < 4; ++ks) { wf[ks] = *(const bf16x8*)(wu + ks * 512); af[ks] = *(const bf16x8*)(au + ks * 512); }
#pragma unroll
                for (int tt = 0; tt < 2; ++tt) {
                    const unsigned char* tp = shm + CV_TW + (tt * 32 + lr) * CV_TPITCH + lh * 16; const unsigned char* ap = shm + CV_AD + (tt * 32 + lr) * CV_TPITCH + lh * 16;
                    f32x16 aw, aa;
#pragma unroll
                    for (int r = 0; r < 16; ++r) { aw[r] = 0.f; aa[r] = 0.f; }
#pragma unroll
                    for (int ks = 0; ks < 4; ++ks) { aw = MFMA32(*(const bf16x8*)(tp + ks * 32), wf[ks], aw); aa = MFMA32(*(const bf16x8*)(ap + ks * 32), af[ks], aa); }
                    const int c = ct * 32 + lr; const float w0 = a.in[I_W0][l * 512 + c], a0 = a.in[I_A0][l * 512 + c];
#pragma unroll
                    for (int r = 0; r < 16; ++r) {
                        const float w = __expf(-DECAY_SCALE * sigmoidf_(w0 + aw[r]));
                        const unsigned q = (unsigned)fminf(fmaxf(rintf((1.0f - w) * 131072.0f), 0.f), 65535.f);
                        AW[(size_t)(t0 + tt * 32 + (r & 3) + 8 * (r >> 2) + 4 * lh) * 512 + c] = q | (f2bf(sigmoidf_(a0 + aa[r])) << 16);
                    }
                }
            }
        }
        if (!(SKIP & 64)) {
            int tid6 = tid; asm volatile("" : "+v"(tid6));
            bf16_t* PB = (bf16_t*)(a.ws + WS_PB) + (size_t)t0 * 256;
#pragma unroll
            for (int h = 0; h < 4; ++h) {
                const int e0 = (h * 512 + tid6) * 8;
                const f32x4 x0 = pbv[h][0], x1 = pbv[h][1];
                u32x4 w; w.x = pk2(x0[0], x0[1]); w.y = pk2(x0[2], x0[3]); w.z = pk2(x1[0], x1[1]); w.w = pk2(x1[2], x1[3]);
                *(u32x4*)(PB + e0) = w;
            }
        }
        __syncthreads();
    }
}

constexpr int CS_C = 16, CS_NCH = S_ / CS_C, CS_NS = 8, CS_NP = 7;
constexpr int SM_AT4 = 0  , SM_RBK = 1024  , SM_RS = 2048, SM_BYTES = 2112;
constexpr int PA_AT = 0, PA_RT = 2304, PA_BN = 4608, PA_KN = 6912, PA_KR = 9216, PA_RK = 11520, PA_NF = 13824, PA_OUT = 14848, PA_SIZE = 16960;
constexpr int SL_AT = 0, SL_RT = 2304, SL_BK = 4608  , SL_SM = 9728, SL_VM = 11840, SL_WC = 12480, SL_SIZE = 12800;
constexpr int CS_FLAGS = CS_NS * SL_SIZE, CS_LDS = CS_FLAGS + 64;
__device__ __forceinline__ bf16x8 mk8(unsigned a, unsigned b, unsigned c, unsigned d) { return __builtin_bit_cast(bf16x8, (u32x4){a, b, c, d}); }
__device__ __forceinline__ unsigned short bf1(float x) { return (unsigned short)pg8::cvt_pk_bf16(x, x); }
#define MFMA16(a, b, c) __builtin_amdgcn_mfma_f32_16x16x32_bf16((a), (b), (c), 0, 0, 0)
__device__ __forceinline__ void scanprep_phase(const Args& a, int l, unsigned char* shm, int wave, int lane_in) {
    int lane = lane_in; asm volatile("" : "+v"(lane));
    const bf16_t* Z = (const bf16_t*)(a.ws + WS_Z);
    const unsigned* AW = (const unsigned*)(a.ws + WS_WQ);
    float* BON = (float*)(a.ws + WS_BON);
    unsigned char* sb = shm + wave * PA_SIZE;
    const int gw = blockIdx.x * 8 + wave, NGW = gridDim.x * 8;
    const int li = lane & 15, g = lane >> 4;
#pragma unroll 1
    for (int task = gw; task < 64 * CS_NCH; task += NGW) {
        const int bh = task / CS_NCH, c = task % CS_NCH, b = bh >> 3, h = bh & 7, hc = h * 64 + lane;
        const unsigned uhc = (unsigned)hc;
        const size_t tokc = (size_t)b * S_ + (size_t)c * CS_C;
        const float mu_k = a.in[I_MU][(size_t)l * 1664 + 512 + hc], mu_r = a.in[I_MU][(size_t)l * 1664 + hc];
        const float kkc = a.in[I_KK][l * 512 + hc], kac = a.in[I_KA][l * 512 + hc], rkc = a.in[I_RK][l * 512 + hc];
        unsigned rk[16], aw[16];
#pragma unroll
        for (int t = 0; t < 16; ++t) { rk[t] = ((const unsigned*)(Z + (tokc + t) * NZ + ZC_RK))[uhc]; aw[t] = (AW + (tokc + t) * 512)[uhc]; }
        unsigned prk = 0u;
        if (c > 0) prk = ((const unsigned*)(Z + (tokc - 1) * NZ + ZC_RK))[uhc];
        float pr = bf2f(prk & 0xffffu), pk = __uint_as_float(prk & 0xffff0000u);
        float W = 1.0f;
#pragma unroll
        for (int t = 0; t < 16; ++t) {
            const float fzr = bf2f(rk[t] & 0xffffu), fzk = __uint_as_float(rk[t] & 0xffff0000u), al = __uint_as_float(aw[t] & 0xffff0000u), w = 1.0f - (float)(aw[t] & 0xffffu) * (1.0f / 131072.0f);
            const float r = fzr + mu_r * (pr - fzr), kx = fzk + mu_k * (pk - fzk);
            pr = fzr; pk = fzk;
            const float kkr = kx * kkc, kp = kx * (1.0f + (al - 1.0f) * kac);
            const float Wp = W; W *= w; const float iW = __builtin_amdgcn_rcpf(W), rW = r * W;
            *(unsigned short*)(sb + PA_AT + t * 144 + 2 * lane) = bf1(-kkr * Wp);
            *(unsigned short*)(sb + PA_RT + t * 144 + 2 * lane) = bf1(rW);
            *(unsigned short*)(sb + PA_BN + t * 144 + 2 * lane) = bf1(kkr * al * iW);
            *(unsigned short*)(sb + PA_KN + t * 144 + 2 * lane) = bf1(kp * iW);
            *(unsigned short*)(sb + PA_KR + t * 144 + 2 * lane) = bf1(kkr);
            *(unsigned short*)(sb + PA_RK + t * 144 + 2 * lane) = bf1(rW * rkc);
        }
        __builtin_amdgcn_s_waitcnt(0xC07F); asm volatile("" ::: "memory");
        {
            bf16x8 fa[2], fr[2], fb[2], fk[2], fq[2], fo[2];
#pragma unroll
            for (int s2 = 0; s2 < 2; ++s2) {
                fa[s2] = *(const bf16x8*)(sb + PA_AT + li * 144 + 16 * g + 64 * s2); fr[s2] = *(const bf16x8*)(sb + PA_RT + li * 144 + 16 * g + 64 * s2);
                fb[s2] = *(const bf16x8*)(sb + PA_BN + li * 144 + 16 * g + 64 * s2); fk[s2] = *(const bf16x8*)(sb + PA_KN + li * 144 + 16 * g + 64 * s2);
                fq[s2] = *(const bf16x8*)(sb + PA_KR + li * 144 + 16 * g + 64 * s2); fo[s2] = *(const bf16x8*)(sb + PA_RK + li * 144 + 16 * g + 64 * s2);
            }
            const f32x4 z4 = {0.f, 0.f, 0.f, 0.f};
            f32x4 dss = MFMA16(fq[0], fq[0], z4); dss = MFMA16(fq[1], fq[1], dss);
            f32x4 dbo = MFMA16(fo[0], fk[0], z4); dbo = MFMA16(fo[1], fk[1], dbo);
            f32x4 dab = MFMA16(fa[0], fb[0], z4); dab = MFMA16(fa[1], fb[1], dab);
            f32x4 dak = MFMA16(fa[0], fk[0], z4); dak = MFMA16(fa[1], fk[1], dak);
            f32x4 drb = MFMA16(fr[0], fb[0], z4); drb = MFMA16(fr[1], fb[1], drb);
            f32x4 drk = MFMA16(fr[0], fk[0], z4); drk = MFMA16(fr[1], fk[1], drk);
            if (g == (li >> 2)) {
                const int rr = li & 3;
                const float ss = rr == 0 ? dss[0] : (rr == 1 ? dss[1] : (rr == 2 ? dss[2] : dss[3]));
                const float bo = rr == 0 ? dbo[0] : (rr == 1 ? dbo[1] : (rr == 2 ? dbo[2] : dbo[3]));
                const float rs = rsqrtf(fmaxf(ss, 1e-12f));
                *(float*)(sb + PA_OUT + SM_RS + 4 * li) = rs;
                BON[(tokc + li) * 8 + h] = bo;
            }
            __builtin_amdgcn_s_waitcnt(0xC07F); asm volatile("" ::: "memory");
            const float rsc = *(const float*)(sb + PA_OUT + SM_RS + 4 * li); const f32x4 rsr = *(const f32x4*)(sb + PA_OUT + SM_RS + 16 * g);
#pragma unroll
            for (int r = 0; r < 4; ++r) {
                const int t = 4 * g + r;
                *(float*)(sb + PA_NF + t * 64 + 4 * li) = li < t ? dab[r] * rsr[r] * rsc : 0.f;
                *(unsigned short*)(sb + PA_OUT + SM_AT4 + t * 64 + (li >> 2) * 16 + (li & 3) * 2) = bf1(li < t ? dak[r] * rsr[r] : 0.f);
                *(unsigned short*)(sb + PA_OUT + SM_RBK + t * 64 + (li >> 2) * 16 + (li & 3) * 2) = bf1(li <= t ? drb[r] * rsc : 0.f);
                *(unsigned short*)(sb + PA_OUT + SM_RBK + t * 64 + (li >> 2) * 16 + 8 + (li & 3) * 2) = bf1(li <= t ? drk[r] : 0.f);
            }
        }
        __builtin_amdgcn_s_waitcnt(0xC07F); asm volatile("" ::: "memory");
        {
            float T[16];
#pragma unroll
            for (int t = 0; t < 16; ++t) {
                float x = li == t ? 1.0f : 0.f;
#pragma unroll
                for (int j4 = 0; j4 < t; j4 += 4) {
                    const f32x4 n4 = *(const f32x4*)(sb + PA_NF + t * 64 + 4 * j4);
#pragma unroll
                    for (int e = 0; e < 4; ++e) if (j4 + e < t) x += n4[e] * T[j4 + e];
                }
                T[t] = x;
                if (g == 0) *(unsigned short*)(sb + PA_OUT + SM_AT4 + t * 64 + (li >> 2) * 16 + 8 + (li & 3) * 2) = bf1(x);
            }
        }
        __builtin_amdgcn_s_waitcnt(0xC07F); asm volatile("" ::: "memory");
        {
            unsigned char* dst = (unsigned char*)(Z + (tokc + h) * NZ);
            *(u32x4*)(dst + 16 * lane) = *(const u32x4*)(sb + PA_OUT + 16 * lane);
            *(u32x4*)(dst + 1024 + 16 * lane) = *(const u32x4*)(sb + PA_OUT + 1024 + 16 * lane);
            if (lane < 4) *(u32x4*)(dst + 2048 + 16 * lane) = *(const u32x4*)(sb + PA_OUT + 2048 + 16 * lane);
        }
        __builtin_amdgcn_s_waitcnt(0xC07F); asm volatile("" ::: "memory");
    }
}
template <int MODE  >
__device__ __forceinline__ void cscan_phase(const Args& a, int l, unsigned char* shm, int tid, int wave, int lane) {
    const bf16_t* Z = (const bf16_t*)(a.ws + WS_Z);
    const unsigned* AW = (const unsigned*)(a.ws + WS_WQ);
    float* Y = (float*)(a.ws + WS_RB);
    volatile PG8_LAS unsigned* flags = (volatile PG8_LAS unsigned*)((PG8_LAS unsigned char*)shm + CS_FLAGS);
    const int G = gridDim.x, bx = blockIdx.x, vcu = (G % 8 == 0) ? (bx % 8) * (G / 8) + bx / 8 : bx;
    for (int task = vcu; task < 256; task += G) {
        const int bh = task >> 2, q = task & 3, b = bh >> 3, h = bh & 7;
        const size_t tok0 = (size_t)b * S_;
        if (tid < 16) flags[tid] = 0u;
        __syncthreads();
        const int li = lane & 15, g = lane >> 4;
        if (wave == 0) {
            __builtin_amdgcn_s_setprio(3);
            f32x4 S[4];
#pragma unroll
            for (int i = 0; i < 4; ++i) S[i] = (f32x4){0.f, 0.f, 0.f, 0.f};
            float* Yp = Y + (tok0 + 4 * g) * 512 + h * 64 + 16 * q + li;
            bf16x8 c_at[2], c_rt[2], c_bk[4], c_a4, c_rbk; u32x2 c_vm; f32x4 c_wc[4];
            bf16x8 n_at[2], n_rt[2], n_bk[4], n_a4, n_rbk; u32x2 n_vm; f32x4 n_wc[4];
#define CS_LOAD(P, cc) do { const unsigned char* sb_ = shm + ((cc) & 7) * SL_SIZE; \
                _Pragma("unroll") for (int s2 = 0; s2 < 2; ++s2) { P##at[s2] = *(const bf16x8*)(sb_ + SL_AT + li * 144 + 64 * s2 + 16 * g); P##rt[s2] = *(const bf16x8*)(sb_ + SL_RT + li * 144 + 64 * s2 + 16 * g); } \
                _Pragma("unroll") for (int i = 0; i < 4; ++i) { P##bk[i] = *(const bf16x8*)(sb_ + SL_BK + (16 * i + li) * 80 + 16 * g); P##wc[i] = *(const f32x4*)(sb_ + SL_WC + (16 * i + 4 * g) * 4); } \
                P##a4 = *(const bf16x8*)(sb_ + SL_SM + SM_AT4 + li * 64 + 16 * g); P##rbk = *(const bf16x8*)(sb_ + SL_SM + SM_RBK + li * 64 + 16 * g); P##vm = *(const u32x2*)(sb_ + SL_VM + li * 40 + 8 * g); } while (0)
#define CS_COMPUTE(P, cc) do { \
                const f32x4 z4_ = {0.f, 0.f, 0.f, 0.f}; \
                const f32x4 rhs0_ = MFMA16(P##a4, mk8(P##vm.x, P##vm.y, 0u, 0u), z4_); \
                const bf16x8 sb0_ = mk8(pg8::cvt_pk_bf16(S[0][0], S[0][1]), pg8::cvt_pk_bf16(S[0][2], S[0][3]), pg8::cvt_pk_bf16(S[1][0], S[1][1]), pg8::cvt_pk_bf16(S[1][2], S[1][3])); \
                const bf16x8 sb1_ = mk8(pg8::cvt_pk_bf16(S[2][0], S[2][1]), pg8::cvt_pk_bf16(S[2][2], S[2][3]), pg8::cvt_pk_bf16(S[3][0], S[3][1]), pg8::cvt_pk_bf16(S[3][2], S[3][3])); \
                f32x4 rhs_ = MFMA16(P##at[0], sb0_, rhs0_); rhs_ = MFMA16(P##at[1], sb1_, rhs_); \
                f32x4 y_ = MFMA16(P##rt[0], sb0_, z4_); y_ = MFMA16(P##rt[1], sb1_, y_); \
                const f32x4 sa_ = MFMA16(P##a4, mk8(0u, 0u, pg8::cvt_pk_bf16(rhs_[0], rhs_[1]), pg8::cvt_pk_bf16(rhs_[2], rhs_[3])), z4_); \
                const bf16x8 sv_ = mk8(pg8::cvt_pk_bf16(sa_[0], sa_[1]), pg8::cvt_pk_bf16(sa_[2], sa_[3]), P##vm.x, P##vm.y); \
                _Pragma("unroll") for (int i = 0; i < 4; ++i) { S[i] = MFMA16(P##bk[i], sv_, S[i]); S[i] = S[i] * P##wc[i]; } \
                y_ = MFMA16(P##rbk, sv_, y_); \
                { float* yq_ = Yp + (size_t)(cc) * (CS_C * 512); yq_[0] = y_[0]; yq_[512] = y_[1]; yq_[1024] = y_[2]; yq_[1536] = y_[3]; } } while (0)
#define CS_WAIT(fl, cc) do { while ((fl) != (unsigned)((cc) + 1)) { __builtin_amdgcn_s_sleep(1); (fl) = flags[(cc) & 7]; } asm volatile("" ::: "memory"); } while (0)
#define CS_SIGNAL(n) do { __builtin_amdgcn_s_waitcnt(0xC07F); asm volatile("" ::: "memory"); flags[8] = (unsigned)(n); asm volatile("" ::: "memory"); } while (0)
            unsigned fl = flags[0];
            CS_WAIT(fl, 0);
            if (MODE != 2) CS_LOAD(c_, 0);
            fl = flags[1];
            CS_SIGNAL(1);
#pragma unroll 1
            for (int c = 0; c < CS_NCH - 2; c += 2) {
                CS_WAIT(fl, c + 1);
                if (MODE != 2) CS_LOAD(n_, c + 1);
                fl = flags[(c + 2) & 7];
                if (MODE != 2) CS_COMPUTE(c_, c);
                CS_SIGNAL(c + 2);
                CS_WAIT(fl, c + 2);
                if (MODE != 2) CS_LOAD(c_, c + 2);
                fl = flags[(c + 3) & 7];
                if (MODE != 2) CS_COMPUTE(n_, c + 1);
                CS_SIGNAL(c + 3);
            }
            {
                CS_WAIT(fl, CS_NCH - 1);
                if (MODE != 2) CS_LOAD(n_, CS_NCH - 1);
                if (MODE != 2) CS_COMPUTE(c_, CS_NCH - 2);
                CS_SIGNAL(CS_NCH);
                if (MODE != 2) CS_COMPUTE(n_, CS_NCH - 1);
            }
#undef CS_COMPUTE
#undef CS_WAIT
#undef CS_SIGNAL
            __builtin_amdgcn_s_setprio(0);
#undef CS_LOAD
        } else {
            const int hc = h * 64 + lane;
            const unsigned uhc = (unsigned)hc;
            const int kpos = (lane & 32) | (((lane >> 2) & 3) << 3) | (((lane >> 4) & 1) << 2) | (lane & 3);
            const float mu_r = a.in[I_MU][(size_t)l * 1664 + hc], mu_k = a.in[I_MU][(size_t)l * 1664 + 512 + hc], mu_v = a.in[I_MU][(size_t)l * 1664 + 1024 + hc];
            const float kkc = a.in[I_KK][l * 512 + hc], kac = a.in[I_KA][l * 512 + hc];
            u32x2 zq[16]; unsigned aw[16]; u32x4 bl0, bl1; f32x4 rs4[4]; u32x2 cpq;

#define PLOADH(hh, cc) do { const size_t tokc_ = tok0 + (size_t)(cc) * CS_C; \
                _Pragma("unroll") for (int t = 8 * (hh); t < 8 * (hh) + 8; ++t) { zq[t].x = ((const unsigned*)(Z + (tokc_ + t) * NZ + ZC_RK))[uhc]; aw[t] = (AW + (tokc_ + t) * 512)[uhc]; } \
                _Pragma("unroll") for (int t = 8 * (hh); t < 8 * (hh) + 8; ++t) zq[t].y = ((const unsigned*)(Z + (tokc_ + t) * NZ + ZC_VG))[uhc]; } while (0)
#define PLOADB(cc) do { const size_t tokc_ = tok0 + (size_t)(cc) * CS_C; const unsigned char* blk_ = (const unsigned char*)(Z + (tokc_ + h) * NZ); \
                bl0 = *(const u32x4*)(blk_ + 16 * lane); bl1 = *(const u32x4*)(blk_ + 1024 + 16 * lane); \
                _Pragma("unroll") for (int i = 0; i < 4; ++i) rs4[i] = *(const f32x4*)(blk_ + SM_RS + 16 * i); \
                cpq = (u32x2){0u, 0u}; \
                if ((cc) > 0) { cpq.x = ((const unsigned*)(Z + (tokc_ - 1) * NZ + ZC_RK))[uhc]; cpq.y = ((const unsigned*)(Z + (tokc_ - 1) * NZ + ZC_VG))[uhc]; } } while (0)
#define PTOK(t) do { \
                    const float fzr = bf2f(zq[t].x & 0xffffu), fzk = __uint_as_float(zq[t].x & 0xffff0000u), fzv = bf2f(zq[t].y & 0xffffu), al = __uint_as_float(aw[t] & 0xffff0000u), w = 1.0f - (float)(aw[t] & 0xffffu) * (1.0f / 131072.0f); \
                    const float r = fzr + mu_r * (pr - fzr), kx = fzk + mu_k * (pk - fzk), v = fzv + mu_v * (pv - fzv); \
                    pr = fzr; pk = fzk; pv = fzv; \
                    const float kk = kx * kkc * rs4[(t) >> 2][(t) & 3]; \
                    const float kp = kx * (1.0f + (al - 1.0f) * kac); \
                    const float Wp = W; W *= w; const float iW = __builtin_amdgcn_rcpf(W); \
                    const float fb = kk * al * iW, fk = kp * iW; \
                    *(unsigned short*)(sb + SL_AT + (t) * 144 + 2 * kpos) = bf1(-kk * Wp); \
                    *(unsigned short*)(sb + SL_RT + (t) * 144 + 2 * kpos) = bf1(r * W); \
                    if ((t) & 1) { btp[(t) >> 1] = pg8::cvt_pk_bf16(eb, fb); ktp[(t) >> 1] = pg8::cvt_pk_bf16(ek, fk); vp[(t) >> 1] = pg8::cvt_pk_bf16(ev, v); } \
                    else { eb = fb; ek = fk; ev = v; } } while (0)
            int c = wave - 1;
            if (MODE != 1) { PLOADB(c); PLOADH(0, c); PLOADH(1, c); }
#pragma unroll 1
            for (; c < CS_NCH; c += CS_NP) {
                unsigned char* sb = shm + (c & 7) * SL_SIZE;
                if (c >= CS_NS) { while ((int)flags[8] < c - (CS_NS - 1)) __builtin_amdgcn_s_sleep(2); }
                asm volatile("" ::: "memory");
                if (MODE != 1) {
                    const bool more = c + CS_NP < CS_NCH;
                    *(u32x4*)(sb + SL_SM + 16 * lane) = bl0; *(u32x4*)(sb + SL_SM + 1024 + 16 * lane) = bl1;
                    float pr = bf2f(cpq.x & 0xffffu), pk = __uint_as_float(cpq.x & 0xffff0000u), pv = bf2f(cpq.y & 0xffffu);
                    float W = 1.0f, eb = 0.f, ek = 0.f, ev = 0.f;
                    unsigned btp[8], ktp[8], vp[8];
#pragma unroll
                    for (int t = 0; t < 8; ++t) PTOK(t);
                    asm volatile("" ::: "memory");
                    if (more) PLOADH(0, c + CS_NP);
#pragma unroll
                    for (int t = 8; t < 16; ++t) PTOK(t);
                    asm volatile("" ::: "memory");
                    if (more) { PLOADH(1, c + CS_NP); PLOADB(c + CS_NP); }
                    {
                        unsigned char* pb = sb + SL_BK + lane * 80;
#pragma unroll
                        for (int i = 0; i < 4; ++i) *(u32x4*)(pb + 16 * i) = (u32x4){btp[2 * i], btp[2 * i + 1], ktp[2 * i], ktp[2 * i + 1]};
                        if ((lane >> 4) == q) { unsigned char* pvm = sb + SL_VM + li * 40;
#pragma unroll
                            for (int i = 0; i < 4; ++i) *(u32x2*)(pvm + 8 * i) = (u32x2){vp[2 * i], vp[2 * i + 1]}; }
                        *(float*)(sb + SL_WC + 4 * lane) = W;
                    }
                }
                __builtin_amdgcn_s_waitcnt(0xC07F); asm volatile("" ::: "memory");
                flags[c & 7] = (unsigned)(c + 1);
                asm volatile("" ::: "memory");
            }
#undef PLOADH
#undef PLOADB
#undef PTOK
        }
        __syncthreads();
    }
}

__device__ __forceinline__ void phase_branchc(const Args& a, int l, int wave, int lane) {
    const int gw = blockIdx.x * 8 + wave, NGW = gridDim.x * 8;
    const bf16_t* Z = (const bf16_t*)(a.ws + WS_Z); bf16_t* CAT = (bf16_t*)(a.ws + WS_RA); const float* Y = (const float*)(a.ws + WS_RB); const float* BON = (const float*)(a.ws + WS_BON);
    const int hc = lane * 8, head = lane >> 3;
    const f32x4 g0 = *(const f32x4*)(a.in[I_LXG] + l * 512 + hc), g1 = *(const f32x4*)(a.in[I_LXG] + l * 512 + hc + 4), b0 = *(const f32x4*)(a.in[I_LXB] + l * 512 + hc), b1 = *(const f32x4*)(a.in[I_LXB] + l * 512 + hc + 4);
    const f32x4 m0 = *(const f32x4*)(a.in[I_MU] + (size_t)l * 1664 + 1024 + hc), m1 = *(const f32x4*)(a.in[I_MU] + (size_t)l * 1664 + 1024 + hc + 4);
    constexpr int NT = 4;
    for (int mp = NT * gw; mp < M_; mp += NT * NGW) {
        f32x4 yv[NT][2]; u32x4 cw[NT][2], pw[2]; float bo[NT];
#pragma unroll
        for (int u = 0; u < NT; ++u) {
            yv[u][0] = *(const f32x4*)(Y + (size_t)(mp + u) * 512 + hc); yv[u][1] = *(const f32x4*)(Y + (size_t)(mp + u) * 512 + hc + 4);
            const u32x4* cp = (const u32x4*)(Z + (size_t)(mp + u) * NZ + ZC_VG + 2 * hc);
#pragma unroll
            for (int i = 0; i < 2; ++i) cw[u][i] = cp[i];
            bo[u] = BON[(size_t)(mp + u) * 8 + head];
        }
        {
            const bool hp = (mp & (S_ - 1)) > 0; const u32x4* pp = (const u32x4*)(Z + (size_t)(mp - 1) * NZ + ZC_VG + 2 * hc);
#pragma unroll
            for (int i = 0; i < 2; ++i) { pw[i] = (u32x4){0u, 0u, 0u, 0u}; if (hp) pw[i] = pp[i]; }
        }
#pragma unroll
        for (int u = 0; u < NT; ++u) {
            float y[8] = {yv[u][0][0], yv[u][0][1], yv[u][0][2], yv[u][0][3], yv[u][1][0], yv[u][1][1], yv[u][1][2], yv[u][1][3]};
            float sm = ((y[0] + y[1]) + (y[2] + y[3])) + ((y[4] + y[5]) + (y[6] + y[7]));
            sm += __shfl_xor(sm, 1); sm += __shfl_xor(sm, 2); sm += __shfl_xor(sm, 4);
            const float mean = sm * (1.0f / 64.0f); float q = 0.f;
#pragma unroll
            for (int e = 0; e < 8; ++e) { y[e] -= mean; q += y[e] * y[e]; }
            q += __shfl_xor(q, 1); q += __shfl_xor(q, 2); q += __shfl_xor(q, 4);
            const float rs = rsqrtf(q * (1.0f / 64.0f) + GN_EPS);
            float o[8];
#pragma unroll
            for (int i = 0; i < 2; ++i) {
                const u32x4 c4 = cw[u][i], p4 = u == 0 ? pw[i] : cw[u > 0 ? u - 1 : 0][i];
#pragma unroll
                for (int hh = 0; hh < 4; ++hh) {
                    const int e = 4 * i + hh; const unsigned cd = c4[hh], pd = p4[hh];
                    const float zv = bf2f(cd & 0xffffu), gc = __uint_as_float(cd & 0xffff0000u), pvv = bf2f(pd & 0xffffu);
                    const float mu = e < 4 ? m0[e & 3] : m1[e & 3], g = e < 4 ? g0[e & 3] : g1[e & 3], bb = e < 4 ? b0[e & 3] : b1[e & 3];
                    const float v = zv + mu * (pvv - zv);
                    o[e] = (y[e] * rs * g + bb + bo[u] * v) * siluf_(gc);
                }
            }
            u32x4 w; w.x = pk2(o[0], o[1]); w.y = pk2(o[2], o[3]); w.z = pk2(o[4], o[5]); w.w = pk2(o[6], o[7]);
            *(u32x4*)(CAT + (size_t)(mp + u) * 1024 + 512 + hc) = w;
        }
    }
}

__device__ __forceinline__ void phase_xnew(const Args& a, int l, int wave, int lane) {
    const int gw = blockIdx.x * 8 + wave, NGW = gridDim.x * 8;
    const float* xin = l == 0 ? a.in[I_X] : a.out; float* xout = a.out;
    const bf16_t* MIX = (const bf16_t*)(a.ws + WS_RB); bf16_t* XNB = (bf16_t*)(a.ws + WS_RA); const float* ssq = (const float*)(a.ws + WS_SSQ2);
    const float* g = a.in[I_POSTG] + l * 1024;
    for (int m = gw; m < M_; m += NGW) {
        const f32x4* sp = (const f32x4*)(ssq + (size_t)m * 16);
        const f32x4 s0 = sp[0], s1 = sp[1], s2 = sp[2], s3 = sp[3];
        const float t = ((s0[0] + s0[1]) + (s0[2] + s0[3])) + ((s1[0] + s1[1]) + (s1[2] + s1[3])) + ((s2[0] + s2[1]) + (s2[2] + s2[3])) + ((s3[0] + s3[1]) + (s3[2] + s3[3]));
        const float rstd = rsqrtf(t * (1.0f / 1024.0f) + RMS_EPS);
#pragma unroll
        for (int h = 0; h < 2; ++h) {
            const int col = h * 512 + lane * 8; const size_t off = (size_t)m * 1024 + col;
            const u32x4 mw = *(const u32x4*)(MIX + off); float mx[8]; unpack8(mw, mx);
            const f32x4 x0 = *(const f32x4*)(xin + off), x1 = *(const f32x4*)(xin + off + 4), g0 = *(const f32x4*)(g + col), g1 = *(const f32x4*)(g + col + 4);
            f32x4 o0, o1;
#pragma unroll
            for (int j = 0; j < 4; ++j) { o0[j] = x0[j] + mx[j] * rstd * g0[j]; o1[j] = x1[j] + mx[4 + j] * rstd * g1[j]; }
            *(f32x4*)(xout + off) = o0; *(f32x4*)(xout + off + 4) = o1;
            u32x4 w; w.x = pk2(o0[0], o0[1]); w.y = pk2(o0[2], o0[3]); w.z = pk2(o1[0], o1[1]); w.w = pk2(o1[2], o1[3]);
            *(u32x4*)(XNB + off) = w;
        }
    }
}

#define XB_TMO      128
#define XB_XCNT(j)  (256  + 64 * (j))
#define XB_XSUB(j)  (1280 + 64 * (j))
#define XB_XGEN(j)  (2304 + 64 * (j))
#define XB_TOP      3328
#define XB_TOPGEN   3392
#define XCD_BAR_WORDS 3456
#define XB_SPIN_CAP (1u << 18)

__device__ __forceinline__ unsigned xb_ld(unsigned* p)              { return __hip_atomic_load(p, __ATOMIC_RELAXED, __HIP_MEMORY_SCOPE_AGENT); }
__device__ __forceinline__ unsigned xb_add(unsigned* p, unsigned v) { return __hip_atomic_fetch_add(p, v, __ATOMIC_RELAXED, __HIP_MEMORY_SCOPE_AGENT); }
__device__ __forceinline__ unsigned xb_xcc_id() { return (unsigned)__builtin_amdgcn_s_getreg((3 << 11) | 20) & 0xFu; }
#define XB_SPIN(cond, bar) do { unsigned _sp = 0; while (cond) { __builtin_amdgcn_s_sleep(1); \
    if ((++_sp & 255u) == 0u) { if (xb_ld(&(bar)[XB_TMO])) break; if (_sp > XB_SPIN_CAP) { atomicAdd(&(bar)[XB_TMO], 1u); break; } } } } while (0)

struct XcdBarrier {
    unsigned* bar; unsigned x;
    volatile unsigned* st;
};

__device__ __forceinline__ XcdBarrier xcd_barrier_post(unsigned* bar, volatile unsigned* st) {
    XcdBarrier b; b.bar = bar; b.x = xb_xcc_id(); b.st = st;
    if (threadIdx.x == 0) (void)xb_add(&bar[XB_XCNT(b.x)], 1u);
    return b;
}
__device__ __forceinline__ void xcd_barrier_complete(unsigned* bar, unsigned x, unsigned& nloc, unsigned& nx) {
    const unsigned G = gridDim.x * gridDim.y * gridDim.z;
    unsigned sum, cnt, mine, sp = 0u;
    for (;;) {
        sum = 0u; cnt = 0u; mine = 0u;
#pragma unroll
        for (unsigned j = 0; j < 16; ++j) { const unsigned c = xb_ld(&bar[XB_XCNT(j)]); sum += c; cnt += (c > 0u) ? 1u : 0u; mine = (j == x) ? c : mine; }
        if (sum == G) break;
        __builtin_amdgcn_s_sleep(1);
        if ((++sp & 255u) == 0u) { if (xb_ld(&bar[XB_TMO])) break; if (sp > XB_SPIN_CAP) { atomicAdd(&bar[XB_TMO], 1u); break; } }
    }
    nloc = mine > 0u ? mine : 1u; nx = cnt > 0u ? cnt : 1u;
}

__device__ __forceinline__ void xcd_barrier(const XcdBarrier& b) {
    asm volatile("s_waitcnt vmcnt(0)" ::: "memory");
    __syncthreads();
    if (threadIdx.x == 0) {
        unsigned* bar = b.bar;
        __builtin_amdgcn_s_waitcnt(0);
        unsigned nloc = b.st[0], nx = b.st[1];
        if (nloc == 0u) { xcd_barrier_complete(bar, b.x, nloc, nx); b.st[0] = nloc; b.st[1] = nx; }
        const unsigned old = xb_add(&bar[XB_XSUB(b.x)], 1u);
        const unsigned gen = old / nloc;
        if (old + 1u == (gen + 1u) * nloc) {
            __builtin_amdgcn_fence(__ATOMIC_RELEASE, "agent");
            asm volatile("s_waitcnt vmcnt(0)" ::: "memory");
            const unsigned og = xb_add(&bar[XB_TOP], 1u);
            const unsigned tg = og / nx;
            if (og + 1u == (tg + 1u) * nx) xb_add(&bar[XB_TOPGEN], 1u);
            else XB_SPIN(xb_ld(&bar[XB_TOPGEN]) == tg, bar);
            __builtin_amdgcn_fence(__ATOMIC_ACQUIRE, "agent");
            xb_add(&bar[XB_XGEN(b.x)], 1u);
            asm volatile("s_waitcnt vmcnt(0)" ::: "memory");
        } else {
            XB_SPIN(xb_ld(&bar[XB_XGEN(b.x)]) == gen, bar);
            __builtin_amdgcn_fence(__ATOMIC_ACQUIRE, "agent");
            asm volatile("s_waitcnt vmcnt(0)" ::: "memory");
        }
    }
    __syncthreads();
}

#ifndef MK_ONE_LAUNCH
#define MK_ONE_LAUNCH 1
#endif
constexpr int cmax_(int a, int b) { return a > b ? a : b; }
constexpr int LDS_MAIN = cmax_(cmax_(CS_LDS, CV_END), cmax_((int)pg8::STAGE_BYTES, 8 * PA_SIZE));
static_assert(LDS_MAIN + 64 <= 163840, "LDS budget");
constexpr int NSP = 7, N_PHASES = 1 + NSP * L_, KALL = (1 << (NSP + 1)) - 1;
template <int KMASK>
__global__ void __launch_bounds__(512, 2) fwd_kernel(Args a) {
    extern __shared__ __attribute__((aligned(16))) unsigned char shm[];
    float* ldsf = (float*)shm;
#if MK_ONE_LAUNCH
    cg::grid_group grid = cg::this_grid();
    volatile unsigned* bst = (volatile unsigned*)(shm + LDS_MAIN);
    if (threadIdx.x < 2) bst[threadIdx.x] = 0u;
    __syncthreads();
    const XcdBarrier xbar = xcd_barrier_post((unsigned*)(a.ws + WS_CTL), bst);
    bool first_bar = true;
#define GRID_BAR() do { if (first_bar) { grid.sync(); first_bar = false; } else xcd_barrier(xbar); } while (0)
#else
#define GRID_BAR() do { } while (0)
#endif
#ifndef DUP_SP
#define DUP_SP -1
#endif
#ifdef PROBE_SP
    unsigned long long probe_acc = 0, probe_t0 = __builtin_amdgcn_s_memrealtime();
#endif
    for (int ph = a.ph_lo; ph < a.ph_hi; ++ph) {
      const int nrep = (DUP_SP >= 0 && ph > 0 && (ph - 1) % NSP == DUP_SP) ? 2 : 1;
      for (int rep = 0; rep < nrep; ++rep) {
        if (rep) GRID_BAR();
        int tid_ = threadIdx.x; asm volatile("" : "+v"(tid_));
        const int tid = tid_, wave = __builtin_amdgcn_readfirstlane(tid >> 6), lane = tid & 63;
        if (ph == 0) { if constexpr ((KMASK >> NSP) & 1) phase_prologue(a, ldsf, wave, lane); }
        else {
            const int l = (ph - 1) / NSP, sp = (ph - 1) % NSP;
            if (sp == 0) {
                if constexpr ((KMASK >> 0) & 1) {
                pg8::Gemm g{(const bf16_t*)a.out, (const bf16_t*)(a.ws + WS_WIN) + (size_t)l * NZP * 1024, M_, NZP, 1024};
                pg8::StaticOrder S; S.init(M_, NZP, (int)gridDim.x, (int)blockIdx.x);
                EpiZ E{(bf16_t*)(a.ws + WS_Z), (const float*)(a.ws + WS_SSQ1)};
                pg8::gemm_phase<EpiZ, pg8::StaticOrder, false>((PG8_LAS unsigned char*)shm, g, S, E, nullptr);
                }
            } else if (sp == 1) {
                if constexpr ((KMASK >> 1) & 1) {
                for (int it = blockIdx.x; it < 256; it += gridDim.x) sgu_item(a, l, it, shm, tid, wave, lane);
#ifdef CONV_SKIP
                conv_phase<CONV_SKIP>(a, l, shm, tid, wave, lane); GRID_BAR();
#endif
                conv_phase<0>(a, l, shm, tid, wave, lane);
                }
            } else if (sp == 2) {
                if constexpr ((KMASK >> 2) & 1) scanprep_phase(a, l, shm, wave, lane);
            } else if (sp == 3) {
                if constexpr ((KMASK >> 3) & 1) {
#ifdef CSCAN_PROBE
                    cscan_phase<CSCAN_PROBE>(a, l, shm, tid, wave, lane); GRID_BAR();
#endif
                    cscan_phase<0>(a, l, shm, tid, wave, lane);
                }
            } else if (sp == 4) {
                if constexpr ((KMASK >> 4) & 1) phase_branchc(a, l, wave, lane);
            } else if (sp == 5) {
                if constexpr ((KMASK >> 5) & 1) {
#pragma unroll 1
                for (int rd = 0; rd < 2; ++rd) {
                    pg8::Gemm g{(const bf16_t*)(a.ws + WS_RA), (const bf16_t*)(a.ws + WS_WOUT) + (size_t)l * 1024 * 1024, M_, 1024, 1024};
                    RoundOrder S; S.base.init(M_, 1024, (int)gridDim.x, (int)blockIdx.x); S.round = rd;
                    EpiXnew E{(const bf16_t*)a.out, (bf16_t*)(a.ws + WS_RB), a.in[I_POSTG] + l * 1024, (float*)(a.ws + WS_XCH), (unsigned*)(a.ws + WS_CNT) + (size_t)l * 128 * 64};
                    pg8::gemm_phase<EpiXnew, RoundOrder, false>((PG8_LAS unsigned char*)shm, g, S, E, nullptr);
                }
                {
                    pg8::Gemm g{(const bf16_t*)(a.ws + WS_PB), (const bf16_t*)(a.ws + WS_WP) + (size_t)l * 1024 * 256, M_, 1024, 256};
                    pg8::StaticOrder S; S.init(M_, 1024, (int)gridDim.x, (int)blockIdx.x);
                    EpiPlain E{(bf16_t*)(a.ws + WS_PP)};
                    pg8::gemm_phase<EpiPlain, pg8::StaticOrder, false>((PG8_LAS unsigned char*)shm, g, S, E, nullptr);
                }
                }
            } else {
                if constexpr ((KMASK >> 6) & 1) {
                pg8::Gemm g{(const bf16_t*)(a.ws + WS_RB), (const bf16_t*)(a.ws + WS_WG) + (size_t)l * 1024 * 1024, M_, 1024, 1024};
                pg8::StaticOrder S; S.init(M_, 1024, (int)gridDim.x, (int)blockIdx.x);
                EpiOut E{(const bf16_t*)(a.ws + WS_RB), (const bf16_t*)(a.ws + WS_PP), (bf16_t*)a.out, l == L_ - 1 ? a.out : nullptr, (float*)(a.ws + WS_SSQ1), a.in[I_GB] + l * 1024};
                pg8::gemm_phase<EpiOut, pg8::StaticOrder, false>((PG8_LAS unsigned char*)shm, g, S, E, nullptr);
                }
            }
        }
      }
        if (ph + 1 < a.ph_hi) GRID_BAR();
#ifdef PROBE_SP
        { const unsigned long long tnow = __builtin_amdgcn_s_memrealtime(); if ((ph == 0 && PROBE_SP < 0) || (ph > 0 && (ph - 1) % NSP == PROBE_SP)) probe_acc += tnow - probe_t0; probe_t0 = tnow; }
#endif
    }
#ifdef PROBE_SP
    { const unsigned long long t0 = __builtin_amdgcn_s_memrealtime(); while (__builtin_amdgcn_s_memrealtime() - t0 < probe_acc) __builtin_amdgcn_s_sleep(8); }
#endif
}

template <int KMASK> static bool prep_kernel(int lds_bytes) {
    return hipFuncSetAttribute((const void*)fwd_kernel<KMASK>, hipFuncAttributeMaxDynamicSharedMemorySize, lds_bytes) == hipSuccess;
}
template <int K> static void launch_kind(int kind, int grid, int lds, hipStream_t st, const Args& a) {
    if constexpr (K <= NSP) { if (kind == K) hipLaunchKernelGGL(fwd_kernel<(1 << K)>, dim3(grid), dim3(512), lds, st, a); else launch_kind<K + 1>(kind, grid, lds, st, a); }
}
template <int K> static bool prep_all(int lds) { if constexpr (K <= NSP) return prep_kernel<(1 << K)>(lds) && prep_all<K + 1>(lds); else return true; }

extern "C" void kernel_launch(void* const* d_in, const int* in_sizes, int n_in, void* d_out, int out_size, void* d_ws, size_t ws_size, hipStream_t stream) {
    static int grid = 0;
    constexpr int LDS_BYTES = LDS_MAIN + 64;
    if (grid == 0) {
        if (n_in != N_IN || out_size != M_ * D_ || ws_size < WS_END) { fprintf(stderr, "kernel_launch: unexpected shapes (n_in %d, out %d, ws %zu < %zu)\n", n_in, out_size, ws_size, (size_t)WS_END); grid = -1; return; }
        int dev = 0, cus = 0;
        (void)hipGetDevice(&dev); (void)hipDeviceGetAttribute(&cus, hipDeviceAttributeMultiprocessorCount, dev);
#if MK_ONE_LAUNCH
        bool ok = prep_kernel<KALL>(LDS_BYTES);
        int per_cu = 0;
        (void)hipOccupancyMaxActiveBlocksPerMultiprocessor(&per_cu, (const void*)fwd_kernel<KALL>, 512, LDS_BYTES);
        (void)hipGetLastError();
        if (per_cu < 1) { fprintf(stderr, "kernel_launch: occupancy query says %d blocks per CU\n", per_cu); ok = false; }
#else
        bool ok = prep_all<0>(LDS_BYTES);
#endif
        if (!ok) { fprintf(stderr, "kernel_launch: kernel set-up failed\n"); grid = -1; return; }
        grid = cus;
    }
    if (grid < 0) return;
    Args a{};
    for (int i = 0; i < N_IN; ++i) a.in[i] = (const float*)d_in[i];
    a.out = (float*)d_out; a.ws = (unsigned char*)d_ws;
#if MK_ONE_LAUNCH
    (void)hipMemsetAsync(d_ws, 0, XCD_BAR_WORDS * 4, stream);
    (void)hipMemsetAsync((unsigned char*)d_ws + WS_CNT, 0, (size_t)L_ * 128 * 256, stream);
    a.ph_lo = 0; a.ph_hi = N_PHASES;
    void* args[] = {&a};
    hipError_t e = hipLaunchCooperativeKernel((const void*)fwd_kernel<KALL>, dim3(grid), dim3(512), args, LDS_BYTES, stream);
    if (e != hipSuccess) fprintf(stderr, "cooperative launch failed: %s (grid %d)\n", hipGetErrorString(e), grid);
#else
    for (int ph = 0; ph < N_PHASES; ++ph) {
        a.ph_lo = ph; a.ph_hi = ph + 1;
        launch_kind<0>(ph == 0 ? NSP : (ph - 1) % NSP, grid, LDS_BYTES, stream, a);
    }
#endif
}
```

```cpp
#include <hip/hip_runtime.h>
#include <hip/hip_cooperative_groups.h>
#include <cstdio>
namespace cg = cooperative_groups;
namespace pg8 {
#define PG8_LAS __attribute__((address_space(3)))
typedef unsigned short bf16_t;
typedef short bf16x8 __attribute__((ext_vector_type(8)));
typedef float f32x4 __attribute__((ext_vector_type(4)));
typedef unsigned u32x4 __attribute__((ext_vector_type(4)));
constexpr int BM = 256, BK = 64, HALF = 128, HTB = HALF * BK * 2  , STAGE_BYTES = 8 * HTB, NXCD = 8, WGM = 8;

__host__ __device__ __forceinline__ int lds_byte(int r, int c) { const int st = (r >> 4) * 2 + (c >> 5), rr = r & 15, cc = c & 31, ob = rr * 64 + cc * 2; return st * 1024 + (ob ^ (((ob >> 9) & 1) << 5)); }
__host__ __device__ __forceinline__ void stage_rc(int b, int& R, int& C) { const int st = b / 1024, sb = b % 1024, swz = sb ^ (((sb >> 9) & 1) << 5); R = (st >> 1) * 16 + swz / 64; C = (st & 1) * 32 + (swz % 64) / 2; }
__host__ __device__ __forceinline__ int perm32(int rho) { const int n = rho >> 4, i = rho & 15; return 8 * (i >> 2) + 4 * n + (i & 3); }

struct Unit { int pm, pn; };
struct Gemm { const bf16_t* A; const bf16_t* Bt; int M, N, K; };

struct StaticOrder {
    int nM, nN, nwg, G, c;
    __host__ __device__ void init(int M, int N, int G_, int c_) { nM = M / BM; nN = N / BM; nwg = nM * nN; G = G_; c = c_; }
    __host__ __device__ bool next(int i, Unit& u) const {
        const long L = (long)i * G + c; if (L >= nwg) return false;
        int wgid = (int)L; { const int q = nwg / NXCD, r = nwg % NXCD, xcd = wgid % NXCD, off = wgid / NXCD; wgid = (xcd < r ? xcd * (q + 1) : r * (q + 1) + (xcd - r) * q) + off; }
        const int nig = WGM * nN, gid = wgid / nig, fm = gid * WGM, gsz = (nM - fm) < WGM ? (nM - fm) : WGM;
        u.pm = fm + ((wgid % nig) % gsz); u.pn = (wgid % nig) / gsz; return true;
    }
    __device__ __forceinline__ void a_ready(const Unit&) const {}
    __device__ __forceinline__ void done(const Unit&) const {}
};
typedef __bf16 bf16x2_t __attribute__((ext_vector_type(2)));
__device__ __forceinline__ unsigned cvt_pk_bf16(float lo, float hi) { typedef float f32x2_t __attribute__((ext_vector_type(2))); return __builtin_bit_cast(unsigned, __builtin_convertvector((f32x2_t){lo, hi}, bf16x2_t)); }
typedef float f32x2 __attribute__((ext_vector_type(2)));
template <class Epi, class Sched, bool STAMP = false>
__device__ __forceinline__ void gemm_phase(PG8_LAS unsigned char* lds, const Gemm g, const Sched& S, const Epi& E, unsigned long long* stamps) {
    int tid_ = threadIdx.x; asm volatile("" : "+v"(tid_));
    const int tid = tid_, wid = __builtin_amdgcn_readfirstlane(tid >> 6), lane = tid & 63, wr = wid >> 2, wc = wid & 3, fr = lane & 15, fq = lane >> 4;
    const int K = g.K; int nt_ = K / BK; asm volatile("" : "+s"(nt_)); const int nt = nt_;
    int ts_lo = 0, ts_hi = 0, nts = 0; const unsigned long long rt_entry = STAMP ? (unsigned long long)wall_clock64() : 0ull;
#define PG8_STAMP() do { if (STAMP && wid == 0 && nts < 64) { const unsigned long long _c = (unsigned long long)clock64(); \
        ts_lo = (lane == nts) ? (int)(unsigned)_c : ts_lo; ts_hi = (lane == nts) ? (int)(unsigned)(_c >> 32) : ts_hi; ++nts; } } while (0)
    PG8_STAMP();
    unsigned voffA[2], voffB[2];
#pragma unroll
    for (int i = 0; i < 2; ++i) { int R, C; stage_rc(tid * 16 + i * 8192, R, C); const int Rb = Epi::PERM ? ((R & ~31) + perm32(R & 31)) : R;
        voffA[i] = (unsigned)(R * K + C) * 2u; voffB[i] = (unsigned)(Rb * K + C) * 2u; }
    const size_t kstep = (size_t)(BK * 2);
    const size_t hstep = (size_t)HALF * K * 2;
    const size_t tstep = 2 * hstep;
    const unsigned ldsw = (unsigned)wid * 1024u;
    const int aoff = lds_byte(wr * 64 + fr, fq * 8), boff = lds_byte(wc * 32 + fr, fq * 8);
#define PG8_SA(b, h) (((b) * 2 + (h)) * HTB)
#define PG8_SB(b, h) ((4 + (b) * 2 + (h)) * HTB)
#define PG8_STAGE(bufoff, gbase, voff) do { _Pragma("unroll") for (int _i = 0; _i < 2; ++_i) \
        __builtin_amdgcn_global_load_lds((const unsigned*)((const char*)(gbase) + (voff)[_i]), (PG8_LAS unsigned*)(lds + (bufoff) + ldsw + _i * 8192), 16, 0, 0); } while (0)
#define PG8_LDA(dst, b, h) do { _Pragma("unroll") for (int m = 0; m < 4; ++m) _Pragma("unroll") for (int k = 0; k < 2; ++k) dst[m][k] = *(const PG8_LAS bf16x8*)(lds + PG8_SA(b, h) + aoff + m * 2048 + k * 1024); } while (0)
#define PG8_LDB(dst, b, h) do { _Pragma("unroll") for (int n = 0; n < 2; ++n) _Pragma("unroll") for (int k = 0; k < 2; ++k) dst[n][k] = *(const PG8_LAS bf16x8*)(lds + PG8_SB(b, h) + boff + n * 2048 + k * 1024); } while (0)
#define PG8_MMA(ai, bj, At, Bt) do { __builtin_amdgcn_s_setprio(1); _Pragma("unroll") for (int m = 0; m < 4; ++m) _Pragma("unroll") for (int n = 0; n < 2; ++n) _Pragma("unroll") for (int k = 0; k < 2; ++k) \
        acc[ai][bj][m][n] = __builtin_amdgcn_mfma_f32_16x16x32_bf16(Bt[n][k], At[m][k], acc[ai][bj][m][n], 0, 0, 0); __builtin_amdgcn_s_setprio(0); } while (0)
#define PG8_WAIT_V(n) asm volatile("s_waitcnt vmcnt(" #n ")" ::: "memory")
#define PG8_WAIT_L(n) asm volatile("s_waitcnt lgkmcnt(" #n ")" ::: "memory")
#define PG8_BAR __builtin_amdgcn_s_barrier()
#define PG8_SCHED __builtin_amdgcn_sched_barrier(0)
    Unit cur, nxt; int ui = 0;
    if (!S.next(0, cur)) return;
    f32x4 acc[2][2][4][2];
#pragma unroll
    for (int a = 0; a < 2; ++a)
#pragma unroll
        for (int b = 0; b < 2; ++b)
#pragma unroll
            for (int m = 0; m < 4; ++m)
#pragma unroll
                for (int n = 0; n < 2; ++n) acc[a][b][m][n] = (f32x4){0.f, 0.f, 0.f, 0.f};
    bf16x8 At[4][2], B0[2][2], B1[2][2];
    const char* cA = (const char*)g.A + (size_t)cur.pm * tstep; const char* cB = (const char*)g.Bt + (size_t)cur.pn * tstep;
    S.a_ready(cur);
    PG8_STAGE(PG8_SB(0, 0), cB, voffB); PG8_STAGE(PG8_SA(0, 0), cA, voffA); PG8_STAGE(PG8_SB(0, 1), cB + hstep, voffB); PG8_STAGE(PG8_SA(0, 1), cA + hstep, voffA);
    if (wr == 1) PG8_BAR;
    PG8_WAIT_V(4); PG8_BAR;
    PG8_STAGE(PG8_SB(1, 0), cB + kstep, voffB); PG8_STAGE(PG8_SA(1, 0), cA + kstep, voffA); PG8_STAGE(PG8_SB(1, 1), cB + hstep + kstep, voffB);
    PG8_WAIT_V(6); PG8_BAR;
    PG8_STAMP();
    for (;;) {
        const bool has_next = S.next(ui + 1, nxt);
        const char* nA = has_next ? (const char*)g.A + (size_t)nxt.pm * tstep : cA; const char* nB = has_next ? (const char*)g.Bt + (size_t)nxt.pn * tstep : cB;
        for (int t = 0; t < nt; t += 2) {
            const bool last = (t == nt - 2);
            const char* a1 = cA + (size_t)(t + 1) * kstep;
            const char* a2 = last ? nA : cA + (size_t)(t + 2) * kstep; const char* b2 = last ? nB : cB + (size_t)(t + 2) * kstep;
            const char* a3 = a2 + kstep; const char* b3 = b2 + kstep;
            if (last && has_next) S.a_ready(nxt);
            PG8_LDB(B0, 0, 0); PG8_SCHED; PG8_LDA(At, 0, 0); PG8_STAGE(PG8_SA(1, 1), a1 + hstep, voffA);
            PG8_WAIT_L(8); PG8_BAR; PG8_WAIT_L(0); PG8_MMA(0, 0, At, B0); PG8_BAR; PG8_SCHED;
            PG8_LDB(B1, 0, 1); PG8_STAGE(PG8_SB(0, 0), b2, voffB);
            PG8_BAR; PG8_WAIT_L(0); PG8_MMA(0, 1, At, B1); PG8_BAR;
            PG8_LDA(At, 0, 1); PG8_STAGE(PG8_SA(0, 0), a2, voffA);
            PG8_BAR; PG8_WAIT_L(0); PG8_MMA(1, 0, At, B0); PG8_BAR; PG8_SCHED;
            PG8_STAGE(PG8_SB(0, 1), b2 + hstep, voffB);
            PG8_WAIT_V(6); PG8_BAR; PG8_MMA(1, 1, At, B1); PG8_BAR;
            PG8_LDB(B0, 1, 0); PG8_SCHED; PG8_LDA(At, 1, 0); PG8_STAGE(PG8_SA(0, 1), a2 + hstep, voffA);
            PG8_WAIT_L(8); PG8_BAR; PG8_WAIT_L(0); PG8_MMA(0, 0, At, B0); PG8_BAR; PG8_SCHED;
            PG8_LDB(B1, 1, 1); PG8_STAGE(PG8_SB(1, 0), b3, voffB);
            PG8_BAR; PG8_WAIT_L(0); PG8_MMA(0, 1, At, B1); PG8_BAR;
            PG8_LDA(At, 1, 1); PG8_STAGE(PG8_SA(1, 0), a3, voffA);
            PG8_BAR; PG8_WAIT_L(0); PG8_MMA(1, 0, At, B0); PG8_BAR; PG8_SCHED;
            PG8_STAGE(PG8_SB(1, 1), b3 + hstep, voffB);
            PG8_WAIT_V(6); PG8_BAR; PG8_MMA(1, 1, At, B1); PG8_BAR;
        }
        PG8_STAMP();
        if constexpr (!Epi::AFTER_DRAIN) { int t2_ = threadIdx.x; asm volatile("" : "+v"(t2_)); const int l2_ = t2_ & 63;
            E(acc, cur, wr, wc, l2_ & 15, l2_ >> 4); S.done(cur); }
        PG8_STAMP();
        if (!has_next) break;
#pragma unroll
        for (int a = 0; a < 2; ++a)
#pragma unroll
            for (int b = 0; b < 2; ++b)
#pragma unroll
                for (int m = 0; m < 4; ++m)
#pragma unroll
                    for (int n = 0; n < 2; ++n) acc[a][b][m][n] = (f32x4){0.f, 0.f, 0.f, 0.f};
        cur = nxt; cA = nA; cB = nB; ++ui;
    }
    PG8_WAIT_V(0);
    if (wr == 0) PG8_BAR;
    PG8_BAR;
    if constexpr (Epi::AFTER_DRAIN) { E.fused(acc, cur, wr, wc, fr, fq, lds, wid, lane); S.done(cur); }
    PG8_STAMP();
    if (STAMP && wid == 0) { stamps[lane] = lane < nts ? (((unsigned long long)(unsigned)ts_hi << 32) | (unsigned)ts_lo) : 0ull;
        if (lane == 62) stamps[62] = rt_entry; if (lane == 63) stamps[63] = (unsigned long long)wall_clock64(); }
#undef PG8_STAMP
#undef PG8_SA
#undef PG8_SB
#undef PG8_STAGE
#undef PG8_LDA
#undef PG8_LDB
#undef PG8_MMA
#undef PG8_WAIT_V
#undef PG8_WAIT_L
#undef PG8_BAR
#undef PG8_SCHED
}
}

using pg8::bf16_t; using pg8::f32x4; using pg8::u32x4; using pg8::Unit;
typedef unsigned u32x2 __attribute__((ext_vector_type(2)));

constexpr int M_ = 32768, D_ = 1024, S_ = 4096, L_ = 4;
constexpr int NZ = 3712, NZP = 3840;
constexpr int ZC_U = 0, ZC_V = 256, ZC_GA = 512, ZC_VAL = 768, ZC_GLU = 1024, ZC_GB = 1280, ZC_RK = 1536  , ZC_VG = 2560  , ZC_WD = 3584, ZC_AD = 3648;
constexpr float RMS_EPS = 1e-6f, LN_EPS = 1e-5f, GN_EPS = 64e-5f, DECAY_SCALE = 0.6065306597126334f;

enum { I_X = 0, I_P, I_PREG, I_WIN, I_SLNG, I_SLNB, I_SGUW, I_SGUB, I_CW, I_CB, I_CLNG, I_CLNB, I_PWW, I_PWB, I_MU, I_W0, I_WUP, I_A0, I_AUP, I_KK, I_KA, I_RK, I_LXG, I_LXB, I_WOUT, I_POSTG, I_PLEW, I_GW, I_GB, N_IN };

constexpr size_t WS_CTL = 0;
constexpr size_t WS_WIN = 65536;
constexpr size_t WS_WOUT = WS_WIN + (size_t)L_ * NZP * 1024 * 2;
constexpr size_t WS_WG = WS_WOUT + (size_t)L_ * 1024 * 1024 * 2;
constexpr size_t WS_WP = WS_WG + (size_t)L_ * 1024 * 1024 * 2;
constexpr size_t WS_SSQ1 = WS_WP + (size_t)L_ * 1024 * 256 * 2;
constexpr size_t WS_SSQ2 = WS_SSQ1 + (size_t)M_ * 16 * 4;
constexpr size_t WS_Z = WS_SSQ2 + (size_t)M_ * 16 * 4;
constexpr size_t WS_RA = WS_Z + (size_t)M_ * NZ * 2;
constexpr size_t WS_RB = WS_RA + (size_t)M_ * 1024 * 2;
constexpr size_t WS_WQ = WS_RB + (size_t)M_ * 1024 * 2;
constexpr size_t WS_AQ = WS_WQ + (size_t)M_ * 512 * 2;
constexpr size_t WS_PB = WS_AQ + (size_t)M_ * 512 * 2;
constexpr size_t WS_BON = WS_PB + (size_t)M_ * 256 * 2;
constexpr size_t WS_SGUW = WS_BON + (size_t)M_ * 8 * 4;
constexpr size_t WS_WPW = WS_SGUW + (size_t)L_ * 4 * 128 * 128 * 2;
constexpr size_t WS_WUP = WS_WPW + (size_t)L_ * 256 * 256 * 2;
constexpr size_t WS_AUP = WS_WUP + (size_t)L_ * 512 * 64 * 2;
constexpr size_t WS_XCH = WS_AUP + (size_t)L_ * 512 * 64 * 2;
constexpr size_t WS_CNT = WS_XCH + (size_t)128 * 256 * 4 * 4;
constexpr size_t WS_END = WS_CNT + (size_t)L_ * 128 * 256;
constexpr size_t WS_PP = WS_Z;

struct Args { const float* in[N_IN]; float* out; unsigned char* ws; int ph_lo, ph_hi; };
static_assert(sizeof(Args) == 8 * N_IN + 8 + 8 + 8, "no padding");

__device__ __forceinline__ float bf2f(unsigned h) { return __uint_as_float(h << 16); }
__device__ __forceinline__ unsigned f2bf(float f) { return pg8::cvt_pk_bf16(f, f) & 0xffffu; }
__device__ __forceinline__ unsigned pk2(float lo, float hi) { return pg8::cvt_pk_bf16(lo, hi); }
__device__ __forceinline__ float shx(float v, int m, int lane) { return __builtin_bit_cast(float, __builtin_amdgcn_ds_bpermute((lane ^ m) << 2, __builtin_bit_cast(int, v))); }
__device__ __forceinline__ float wave_sum(float v, int lane) {
#pragma unroll
    for (int o = 1; o < 64; o <<= 1) v += shx(v, o, lane);
    return v;
}
__device__ __forceinline__ float sigmoidf_(float x) { return __builtin_amdgcn_rcpf(1.0f + __expf(-x)); }
__device__ __forceinline__ float siluf_(float x) { return x * __builtin_amdgcn_rcpf(1.0f + __expf(-x)); }
__device__ __forceinline__ void unpack8(const u32x4 w, float (&o)[8]) {
    o[0] = bf2f(w.x & 0xffffu); o[1] = __uint_as_float(w.x & 0xffff0000u); o[2] = bf2f(w.y & 0xffffu); o[3] = __uint_as_float(w.y & 0xffff0000u);
    o[4] = bf2f(w.z & 0xffffu); o[5] = __uint_as_float(w.z & 0xffff0000u); o[6] = bf2f(w.w & 0xffffu); o[7] = __uint_as_float(w.w & 0xffff0000u);
}
__device__ __forceinline__ void unpack4(const u32x2 w, float (&o)[4]) {
    o[0] = bf2f(w.x & 0xffffu); o[1] = __uint_as_float(w.x & 0xffff0000u); o[2] = bf2f(w.y & 0xffffu); o[3] = __uint_as_float(w.y & 0xffff0000u);
}

struct EpiZ {
    static constexpr bool PERM = true, AFTER_DRAIN = false;
    bf16_t* Z; const float* ssq;
    __device__ __forceinline__ void operator()(const f32x4 (&acc)[2][2][4][2], const Unit& u, int wr, int wc, int fr, int fq) const {
        const int row0 = u.pm * 256 + wr * 64 + fr, col0 = u.pn * 256 + wc * 32 + 8 * fq;
        f32x4 sq[2][4];
#pragma unroll
        for (int ai = 0; ai < 2; ++ai)
#pragma unroll
            for (int m = 0; m < 4; ++m) sq[ai][m] = *(const f32x4*)(ssq + (size_t)(row0 + ai * 128 + m * 16) * 16 + 4 * fq);
        float rstd8[2][4];
#pragma unroll
        for (int ai = 0; ai < 2; ++ai)
#pragma unroll
            for (int m = 0; m < 4; ++m) {
                float t = (sq[ai][m][0] + sq[ai][m][1]) + (sq[ai][m][2] + sq[ai][m][3]);
                t += shx(t, 16, fq * 16 + fr); t += shx(t, 32, fq * 16 + fr);
                rstd8[ai][m] = rsqrtf(t * (1.0f / 1024.0f) + RMS_EPS);
            }
#pragma unroll
        for (int ai = 0; ai < 2; ++ai)
#pragma unroll
            for (int m = 0; m < 4; ++m) {
                const int row = row0 + ai * 128 + m * 16;
                const float rstd = rstd8[ai][m];
#pragma unroll
                for (int bj = 0; bj < 2; ++bj) {
                    const int col = col0 + bj * 128;
                    if (col < NZ) {
                        const f32x4 v0 = acc[ai][bj][m][0] * rstd, v1 = acc[ai][bj][m][1] * rstd;
                        u32x4 w; w.x = pg8::cvt_pk_bf16(v0[0], v0[1]); w.y = pg8::cvt_pk_bf16(v0[2], v0[3]); w.z = pg8::cvt_pk_bf16(v1[0], v1[1]); w.w = pg8::cvt_pk_bf16(v1[2], v1[3]);
                        __builtin_nontemporal_store(w, (u32x4*)(Z + (size_t)row * NZ + col));
                    }
                }
            }
    }
};
struct EpiMix {
    static constexpr bool PERM = true, AFTER_DRAIN = false;
    bf16_t* O; float* ssq;
    __device__ __forceinline__ void operator()(const f32x4 (&acc)[2][2][4][2], const Unit& u, int wr, int wc, int fr, int fq) const {
        const int row0 = u.pm * 256 + wr * 64 + fr, col0 = u.pn * 256 + wc * 32 + 8 * fq;
#pragma unroll
        for (int ai = 0; ai < 2; ++ai)
#pragma unroll
            for (int m = 0; m < 4; ++m) {
                const int row = row0 + ai * 128 + m * 16; float q = 0.f;
#pragma unroll
                for (int bj = 0; bj < 2; ++bj) {
                    const f32x4 v0 = acc[ai][bj][m][0], v1 = acc[ai][bj][m][1];
                    q += (v0[0] * v0[0] + v0[1] * v0[1]) + (v0[2] * v0[2] + v0[3] * v0[3]) + (v1[0] * v1[0] + v1[1] * v1[1]) + (v1[2] * v1[2] + v1[3] * v1[3]);
                    u32x4 w; w.x = pg8::cvt_pk_bf16(v0[0], v0[1]); w.y = pg8::cvt_pk_bf16(v0[2], v0[3]); w.z = pg8::cvt_pk_bf16(v1[0], v1[1]); w.w = pg8::cvt_pk_bf16(v1[2], v1[3]);
                    *(u32x4*)(O + (size_t)row * 1024 + col0 + bj * 128) = w;
                }
                q += shx(q, 16, fq * 16 + fr); q += shx(q, 32, fq * 16 + fr);
                if (fq == 0) ssq[(size_t)row * 16 + u.pn * 4 + wc] = q;
            }
    }
};
struct EpiPlain {
    static constexpr bool PERM = true, AFTER_DRAIN = false;
    bf16_t* O;
    __device__ __forceinline__ void operator()(const f32x4 (&acc)[2][2][4][2], const Unit& u, int wr, int wc, int fr, int fq) const {
        const int row0 = u.pm * 256 + wr * 64 + fr, col0 = u.pn * 256 + wc * 32 + 8 * fq;
#pragma unroll
        for (int ai = 0; ai < 2; ++ai)
#pragma unroll
            for (int m = 0; m < 4; ++m) {
                const int row = row0 + ai * 128 + m * 16;
#pragma unroll
                for (int bj = 0; bj < 2; ++bj) {
                    const f32x4 v0 = acc[ai][bj][m][0], v1 = acc[ai][bj][m][1];
                    u32x4 w; w.x = pg8::cvt_pk_bf16(v0[0], v0[1]); w.y = pg8::cvt_pk_bf16(v0[2], v0[3]); w.z = pg8::cvt_pk_bf16(v1[0], v1[1]); w.w = pg8::cvt_pk_bf16(v1[2], v1[3]);
                    *(u32x4*)(O + (size_t)row * 1024 + col0 + bj * 128) = w;
                }
            }
    }
};
struct EpiGate {
    static constexpr bool PERM = true, AFTER_DRAIN = false;
    unsigned char* G8; const float* bias;
    __device__ __forceinline__ void operator()(const f32x4 (&acc)[2][2][4][2], const Unit& u, int wr, int wc, int fr, int fq) const {
        const int row0 = u.pm * 256 + wr * 64 + fr, col0 = u.pn * 256 + wc * 32 + 8 * fq;
        f32x4 bv[2][2];
#pragma unroll
        for (int bj = 0; bj < 2; ++bj)
#pragma unroll
            for (int n = 0; n < 2; ++n) bv[bj][n] = *(const f32x4*)(bias + col0 + bj * 128 + 4 * n);
#pragma unroll
        for (int ai = 0; ai < 2; ++ai)
#pragma unroll
            for (int m = 0; m < 4; ++m)
#pragma unroll
                for (int bj = 0; bj < 2; ++bj) {
                    const f32x4 g0 = acc[ai][bj][m][0] + bv[bj][0], g1 = acc[ai][bj][m][1] + bv[bj][1];
                    unsigned q[8];
#pragma unroll
                    for (int j = 0; j < 4; ++j) { q[j] = (unsigned)rintf(sigmoidf_(g0[j]) * 255.0f); q[4 + j] = (unsigned)rintf(sigmoidf_(g1[j]) * 255.0f); }
                    const u32x2 w = {q[0] | (q[1] << 8) | (q[2] << 16) | (q[3] << 24), q[4] | (q[5] << 8) | (q[6] << 16) | (q[7] << 24)};
                    *(u32x2*)(G8 + (size_t)(row0 + ai * 128 + m * 16) * 1024 + col0 + bj * 128) = w;
                }
    }
};
template <bool F32OUT> struct EpiOut {
    static constexpr bool PERM = true, AFTER_DRAIN = false;
    const bf16_t* XN; const unsigned char* G8; bf16_t* XB; float* XF; float* ssq;
    __device__ __forceinline__ void operator()(const f32x4 (&acc)[2][2][4][2], const Unit& u, int wr, int wc, int fr, int fq) const {
        const int row0 = u.pm * 256 + wr * 64 + fr, col0 = u.pn * 256 + wc * 32 + 8 * fq;
        const unsigned ob0 = ((unsigned)row0 * 1024u + (unsigned)col0) * 2u;
        u32x4 xw[2][2]; u32x2 gw[2][2];
#define EPO_LD(r, s, bj) do { const unsigned o_ = ob0 + (unsigned)((((r) >> 2) * 128 + ((r) & 3) * 16) * 2048 + (bj) * 256); \
            xw[s][bj] = *(const u32x4*)((const char*)XN + o_); gw[s][bj] = *(const u32x2*)((const unsigned char*)G8 + (o_ >> 1)); } while (0)
#pragma unroll
        for (int r = 0; r < 2; ++r) { EPO_LD(r, r, 0); EPO_LD(r, r, 1); }
#pragma unroll
        for (int r = 0; r < 8; ++r) {
            const int ai = r >> 2, m = r & 3, row = row0 + ai * 128 + m * 16; float q = 0.f;
#pragma unroll
            for (int bj = 0; bj < 2; ++bj) {
                float xr[8]; unpack8(xw[r & 1][bj], xr);
                const unsigned ga = gw[r & 1][bj].x, gb = gw[r & 1][bj].y;
                f32x4 o0, o1;
#pragma unroll
                for (int j = 0; j < 4; ++j) { o0[j] = xr[j] + acc[ai][bj][m][0][j] * ((float)((ga >> (8 * j)) & 255u) * (1.0f / 255.0f)); o1[j] = xr[4 + j] + acc[ai][bj][m][1][j] * ((float)((gb >> (8 * j)) & 255u) * (1.0f / 255.0f)); }
                if (r + 2 < 8) EPO_LD(r + 2, r & 1, bj);
                const unsigned ob = ob0 + (unsigned)((ai * 128 + m * 16) * 2048 + bj * 256);
                if constexpr (F32OUT) { *(f32x4*)((char*)XF + 2u * ob) = o0; *(f32x4*)((char*)XF + 2u * ob + 16) = o1; }
                else {
                    u32x4 w; w.x = pg8::cvt_pk_bf16(o0[0], o0[1]); w.y = pg8::cvt_pk_bf16(o0[2], o0[3]); w.z = pg8::cvt_pk_bf16(o1[0], o1[1]); w.w = pg8::cvt_pk_bf16(o1[2], o1[3]);
                    *(u32x4*)((char*)XB + ob) = w;
                    q += (o0[0] * o0[0] + o0[1] * o0[1]) + (o0[2] * o0[2] + o0[3] * o0[3]) + (o1[0] * o1[0] + o1[1] * o1[1]) + (o1[2] * o1[2] + o1[3] * o1[3]);
                }
            }
            if constexpr (!F32OUT) { q += shx(q, 16, fq * 16 + fr); q += shx(q, 32, fq * 16 + fr); if (fq == 0) ssq[(size_t)row * 16 + u.pn * 4 + wc] = q; }
        }
#undef EPO_LD
    }
};


struct EpiXnew {
    static constexpr bool PERM = true, AFTER_DRAIN = true;
    const bf16_t* xin; bf16_t* XNB; const float* g; float* xbuf; unsigned* cnt;
    __device__ __forceinline__ void fused(f32x4 (&acc)[2][2][4][2], const Unit& u, int wr, int wc, int fr, int fq, PG8_LAS unsigned char* lds, int wid, int lane) const {
        PG8_LAS float* P = (PG8_LAS float*)lds;
        PG8_LAS float* Sr = (PG8_LAS float*)(lds + 4096);
        u32x4 xres[2][4][2];
        {
            const int col0_ = u.pn * 256 + wc * 32 + 8 * fq;
#pragma unroll
            for (int ai = 0; ai < 2; ++ai)
#pragma unroll
                for (int m = 0; m < 4; ++m)
#pragma unroll
                    for (int bj = 0; bj < 2; ++bj) xres[ai][m][bj] = *(const u32x4*)((const char*)xin + ((unsigned)(u.pm * 256 + wr * 64 + fr) * 1024u + (unsigned)col0_) * 2u + (unsigned)((ai * 128 + m * 16) * 2048 + bj * 256));
        }
#pragma unroll
        for (int ai = 0; ai < 2; ++ai)
#pragma unroll
            for (int m = 0; m < 4; ++m) {
                float q = 0.f;
#pragma unroll
                for (int bj = 0; bj < 2; ++bj)
#pragma unroll
                    for (int n = 0; n < 2; ++n) { const f32x4 v = acc[ai][bj][m][n]; q += (v[0] * v[0] + v[1] * v[1]) + (v[2] * v[2] + v[3] * v[3]); }
                q += shx(q, 16, fq * 16 + fr); q += shx(q, 32, fq * 16 + fr);
                if (fq == 0) P[(ai * 128 + wr * 64 + m * 16 + fr) * 4 + wc] = q;
            }
        asm volatile("s_waitcnt lgkmcnt(0)" ::: "memory"); __builtin_amdgcn_s_barrier(); asm volatile("" ::: "memory");
        const int row = wid * 32 + (lane & 31);
        if (lane < 32) {
            const float t = (P[row * 4 + 0] + P[row * 4 + 1]) + (P[row * 4 + 2] + P[row * 4 + 3]);
            __hip_atomic_store(xbuf + ((size_t)(u.pm * 256 + row) * 4 + u.pn), t, __ATOMIC_RELAXED, __HIP_MEMORY_SCOPE_AGENT);
        }
        asm volatile("s_waitcnt vmcnt(0)" ::: "memory");
        if (lane == 0) __hip_atomic_fetch_add(cnt + 64 * u.pm, 1u, __ATOMIC_RELAXED, __HIP_MEMORY_SCOPE_AGENT);
        if (wid == 0) {
            unsigned spins = 0;
            while ((unsigned)__builtin_amdgcn_readfirstlane(__hip_atomic_load(cnt + 64 * u.pm, __ATOMIC_RELAXED, __HIP_MEMORY_SCOPE_AGENT)) < 32u) { __builtin_amdgcn_s_sleep(2); if (++spins > (1u << 22)) break; }
            __builtin_amdgcn_fence(__ATOMIC_ACQUIRE, "agent");
        }
        asm volatile("s_waitcnt vmcnt(0) lgkmcnt(0)" ::: "memory"); __builtin_amdgcn_s_barrier(); asm volatile("" ::: "memory");
        if (lane < 32) {
            const float* slot = xbuf + (size_t)(u.pm * 256 + row) * 4; float t = 0.f;
#pragma unroll
            for (int k = 0; k < 4; ++k) t += __hip_atomic_load(slot + k, __ATOMIC_RELAXED, __HIP_MEMORY_SCOPE_AGENT);
            Sr[row] = rsqrtf(t * (1.0f / 1024.0f) + RMS_EPS);
        }
        asm volatile("s_waitcnt lgkmcnt(0)" ::: "memory"); __builtin_amdgcn_s_barrier(); asm volatile("" ::: "memory");
        float rs[2][4];
#pragma unroll
        for (int ai = 0; ai < 2; ++ai)
#pragma unroll
            for (int m = 0; m < 4; ++m) rs[ai][m] = Sr[ai * 128 + wr * 64 + m * 16 + fr];
        asm volatile("s_waitcnt lgkmcnt(0)" ::: "memory"); __builtin_amdgcn_s_barrier(); asm volatile("" ::: "memory");
        const int col0 = u.pn * 256 + wc * 32 + 8 * fq;
        f32x4 gv[2][2];
#pragma unroll
        for (int bj = 0; bj < 2; ++bj)
#pragma unroll
            for (int n = 0; n < 2; ++n) gv[bj][n] = *(const f32x4*)(g + col0 + bj * 128 + 4 * n);
#pragma unroll
        for (int ai = 0; ai < 2; ++ai)
#pragma unroll
            for (int m = 0; m < 4; ++m) {
                const int r = ai * 128 + wr * 64 + m * 16 + fr; const float rstd = rs[ai][m];
#pragma unroll
                for (int bj = 0; bj < 2; ++bj) {
                    const unsigned ob = ((unsigned)(u.pm * 256 + wr * 64 + fr) * 1024u + (unsigned)col0) * 2u + (unsigned)((ai * 128 + m * 16) * 2048 + bj * 256);
                    float xr[8]; unpack8(xres[ai][m][bj], xr);
                    const f32x4 o0 = (f32x4){xr[0], xr[1], xr[2], xr[3]} + acc[ai][bj][m][0] * rstd * gv[bj][0], o1 = (f32x4){xr[4], xr[5], xr[6], xr[7]} + acc[ai][bj][m][1] * rstd * gv[bj][1];
                    u32x4 w; w.x = pg8::cvt_pk_bf16(o0[0], o0[1]); w.y = pg8::cvt_pk_bf16(o0[2], o0[3]); w.z = pg8::cvt_pk_bf16(o1[0], o1[1]); w.w = pg8::cvt_pk_bf16(o1[2], o1[3]);
                    *(u32x4*)((char*)XNB + ob) = w;
                }
                asm volatile("" ::: "memory");
            }
    }
};
struct RoundOrder {
    pg8::StaticOrder base; int round;
    __device__ bool next(int i, Unit& u) const { return i == 0 ? base.next(round, u) : false; }
    __device__ __forceinline__ void a_ready(const Unit&) const {}
    __device__ __forceinline__ void done(const Unit&) const {}
};

__device__ __forceinline__ int win_dst_col(int o) {
    if (o < 1536) return o;
    if (o < 2560) return ZC_RK + 2 * ((o - 1536) & 511) + ((o - 1536) >> 9);
    if (o < 3072) return ZC_VG + 2 * (o - 2560);
    if (o < 3200) return o + 512;
    return ZC_VG + 2 * (o - 3200) + 1;
}
template <bool WINMAP = false>
__device__ __forceinline__ void transpose_item(const float* W, int K, int N, int k0, int nsrc0, bf16_t* WT, int ndst0, const float* g, float* scr, int lane) {
    float vv[32];
#pragma unroll
    for (int i = 0; i < 32; ++i) { const int kk = 2 * i + (lane >> 5); vv[i] = 0.f; if (nsrc0 >= 0) vv[i] = W[(size_t)(k0 + kk) * N + nsrc0 + (lane & 31)]; }
#pragma unroll
    for (int i = 0; i < 32; ++i) { const int kk = 2 * i + (lane >> 5); float v = vv[i]; if (g) v *= g[k0 + kk]; scr[kk * 33 + (lane & 31)] = v; }
    __builtin_amdgcn_s_waitcnt(0xC07F); asm volatile("" ::: "memory");
    const int c = lane & 7;
#pragma unroll
    for (int j = 0; j < 4; ++j) {
        const int n = (lane >> 3) + 8 * j; const float* s = scr + (8 * c) * 33 + n;
        u32x4 o; o.x = pk2(s[0 * 33], s[1 * 33]); o.y = pk2(s[2 * 33], s[3 * 33]); o.z = pk2(s[4 * 33], s[5 * 33]); o.w = pk2(s[6 * 33], s[7 * 33]);
        const int row = (WINMAP && nsrc0 >= 0) ? win_dst_col(nsrc0 + n) : ndst0 + n;
        *(u32x4*)(WT + (size_t)row * K + k0 + 8 * c) = o;
    }
    __builtin_amdgcn_s_waitcnt(0xC07F); asm volatile("" ::: "memory");
}
__device__ __forceinline__ void convert_weights(const Args& a, float* scr, int lane, int l, int worker, int nworkers) {
    constexpr int I_IN = 16 * (NZP / 32), I_SQ = 16 * 32, I_PL = 4 * 32, I_LAYER = I_IN + 2 * I_SQ + I_PL;
#pragma unroll 1
    for (int it = worker; it < I_LAYER; it += nworkers) {
        int r = it;
        if (r < I_IN) {
            const int kb = r % 16, nb = r / 16, n0 = nb * 32;
            transpose_item<true>(a.in[I_WIN] + (size_t)l * 1024 * NZ, 1024, NZ, kb * 64, n0 < NZ ? n0 : -1, (bf16_t*)(a.ws + WS_WIN) + (size_t)l * NZP * 1024, n0, a.in[I_PREG] + l * 1024, scr, lane);
            continue;
        }
        r -= I_IN;
        if (r < I_SQ) { transpose_item(a.in[I_WOUT] + (size_t)l * 1024 * 1024, 1024, 1024, (r % 16) * 64, (r / 16) * 32, (bf16_t*)(a.ws + WS_WOUT) + (size_t)l * 1024 * 1024, (r / 16) * 32, nullptr, scr, lane); continue; }
        r -= I_SQ;
        if (r < I_SQ) { transpose_item(a.in[I_GW] + (size_t)l * 1024 * 1024, 1024, 1024, (r % 16) * 64, (r / 16) * 32, (bf16_t*)(a.ws + WS_WG) + (size_t)l * 1024 * 1024, (r / 16) * 32, nullptr, scr, lane); continue; }
        r -= I_SQ;
        transpose_item(a.in[I_PLEW] + (size_t)l * 256 * 1024, 256, 1024, (r % 4) * 64, (r / 4) * 32, (bf16_t*)(a.ws + WS_WP) + (size_t)l * 1024 * 256, (r / 4) * 32, nullptr, scr, lane);
    }
}
__device__ __forceinline__ void phase_prologue(const Args& a, float* ldsf, int wave, int lane) {
    float* scr = ldsf + wave * (64 * 33);
    const int gw = blockIdx.x * 8 + wave, NGW = gridDim.x * 8;
    convert_weights(a, scr, lane, 0, gw, NGW);
    {
        const int lr = lane & 31, lh = lane >> 5;
        for (int it = gw; it < 3 * 512; it += NGW) {
            const int kind = it >> 9, r = it & 511; float v[8]; bf16_t* dst;
            if (kind == 0) {
                const int l = r >> 7, nt = (r >> 4) & 7, ks = r & 15; const float* src = a.in[I_PWW] + (size_t)l * 256 * 256 + (size_t)(16 * ks + 8 * lh) * 256 + nt * 32 + lr;
#pragma unroll
                for (int j = 0; j < 8; ++j) v[j] = src[j * 256];
                dst = (bf16_t*)(a.ws + WS_WPW) + ((((size_t)l * 8 + nt) * 16 + ks) * 64 + lane) * 8;
            } else if (kind == 1) {
                const int mx = r >> 8, l = (r >> 6) & 3, ct = (r >> 2) & 15, ks = r & 3; const float* src = a.in[mx ? I_AUP : I_WUP] + (size_t)l * 64 * 512 + (size_t)(16 * ks + 8 * lh) * 512 + ct * 32 + lr;
#pragma unroll
                for (int j = 0; j < 8; ++j) v[j] = src[j * 512];
                dst = (bf16_t*)(a.ws + (mx ? WS_AUP : WS_WUP)) + ((((size_t)l * 16 + ct) * 4 + ks) * 64 + lane) * 8;
            } else {
                const int l = r >> 7, h = (r >> 5) & 3, itl = (r >> 3) & 3, ks = r & 7; const float* src = a.in[I_SGUW] + (((size_t)l * 4 + h) * 128 + itl * 32 + lr) * 128 + 16 * ks + 8 * lh;
                const f32x4 s0 = *(const f32x4*)(src), s1 = *(const f32x4*)(src + 4);
                v[0] = s0[0]; v[1] = s0[1]; v[2] = s0[2]; v[3] = s0[3]; v[4] = s1[0]; v[5] = s1[1]; v[6] = s1[2]; v[7] = s1[3];
                dst = (bf16_t*)(a.ws + WS_SGUW) + (((((size_t)l * 4 + h) * 4 + itl) * 8 + ks) * 64 + lane) * 8;
            }
            *(u32x4*)dst = (u32x4){pk2(v[0], v[1]), pk2(v[2], v[3]), pk2(v[4], v[5]), pk2(v[6], v[7])};
        }
    }
    const float* x = a.in[I_X]; bf16_t* XB = (bf16_t*)a.out; float* ssq = (float*)(a.ws + WS_SSQ1);
    for (int m0 = gw * 4; m0 < M_; m0 += NGW * 4) {
        f32x4 xv[4][4];
#pragma unroll
        for (int r = 0; r < 4; ++r)
#pragma unroll
            for (int h = 0; h < 2; ++h) { const size_t off = (size_t)(m0 + r) * 1024 + h * 512 + lane * 8; xv[r][2 * h] = *(const f32x4*)(x + off); xv[r][2 * h + 1] = *(const f32x4*)(x + off + 4); }
#pragma unroll
        for (int r = 0; r < 4; ++r) {
            float q = 0.f;
#pragma unroll
            for (int h = 0; h < 2; ++h) {
                const size_t off = (size_t)(m0 + r) * 1024 + h * 512 + lane * 8;
                const f32x4 x0 = xv[r][2 * h], x1 = xv[r][2 * h + 1];
                q += (x0[0] * x0[0] + x0[1] * x0[1]) + (x0[2] * x0[2] + x0[3] * x0[3]) + (x1[0] * x1[0] + x1[1] * x1[1]) + (x1[2] * x1[2] + x1[3] * x1[3]);
                u32x4 w; w.x = pk2(x0[0], x0[1]); w.y = pk2(x0[2], x0[3]); w.z = pk2(x1[0], x1[1]); w.w = pk2(x1[2], x1[3]);
                *(u32x4*)(XB + off) = w;
            }
            q = wave_sum(q, lane);
            if (lane < 16) ssq[(size_t)(m0 + r) * 16 + lane] = lane == 0 ? q : 0.f;
        }
    }
}

template <int CTRL> __device__ __forceinline__ float dpp_f(float x) { return __builtin_bit_cast(float, __builtin_amdgcn_update_dpp(0, __builtin_bit_cast(int, x), CTRL, 0xf, 0xf, true)); }
__device__ __forceinline__ float allreduce16(float x) {
    x += dpp_f<0xB1>(x);
    x += dpp_f<0x4E>(x);
    x += dpp_f<0x141>(x);
    x += dpp_f<0x140>(x);
    return x;
}
__device__ __forceinline__ float wave_sum_d(float v, int lane) { v = allreduce16(v); v += shx(v, 16, lane); v += shx(v, 32, lane); return v; }
typedef float f32x16 __attribute__((ext_vector_type(16)));
using pg8::bf16x8;
#define MFMA32(a, b, c) __builtin_amdgcn_mfma_f32_32x32x16_bf16((a), (b), (c), 0, 0, 0)
constexpr int SG_PITCH = 272;
__device__ __forceinline__ void sgu_item(const Args& a, int l, int nb, unsigned char* shm, int tid_in, int wave, int lane_in) {
    int tid = tid_in, lane = lane_in; asm volatile("" : "+v"(tid), "+v"(lane));
    const bf16_t* Z = (const bf16_t*)(a.ws + WS_Z); bf16_t* CAT = (bf16_t*)(a.ws + WS_RA);
    {
        const f32x4 g = *(const f32x4*)(a.in[I_SLNG] + l * 256 + lane * 4), bb = *(const f32x4*)(a.in[I_SLNB] + l * 256 + lane * 4);
        u32x2 vld[16];
#pragma unroll
        for (int tt = 0; tt < 16; ++tt) vld[tt] = *(const u32x2*)(Z + ((size_t)nb * 128 + wave * 16 + tt) * NZ + ZC_V + lane * 4);
#pragma unroll
        for (int tt = 0; tt < 16; ++tt) {
            const int j = wave * 16 + tt;
            float v[4]; unpack4(vld[tt], v);
            const float mu = wave_sum_d((v[0] + v[1]) + (v[2] + v[3]), lane) * (1.0f / 256.0f);
            const float d0 = v[0] - mu, d1 = v[1] - mu, d2 = v[2] - mu, d3 = v[3] - mu;
            const float rs = rsqrtf(wave_sum_d((d0 * d0 + d1 * d1) + (d2 * d2 + d3 * d3), lane) * (1.0f / 256.0f) + LN_EPS);
            unsigned short* dst = (unsigned short*)(shm + (size_t)(lane * 4) * SG_PITCH + j * 2);
            dst[0] = (unsigned short)f2bf(d0 * rs * g[0] + bb[0]); dst[SG_PITCH / 2] = (unsigned short)f2bf(d1 * rs * g[1] + bb[1]);
            dst[SG_PITCH] = (unsigned short)f2bf(d2 * rs * g[2] + bb[2]); dst[3 * SG_PITCH / 2] = (unsigned short)f2bf(d3 * rs * g[3] + bb[3]);
        }
    }
    __syncthreads();
    {
        const int h = wave >> 1, dt = wave & 1, lr = lane & 31, lh = lane >> 5;
        const unsigned char* arow = shm + (size_t)(h * 64 + dt * 32 + lr) * SG_PITCH + lh * 16;
        const bf16_t* wb = (const bf16_t*)(a.ws + WS_SGUW) + ((((size_t)l * 4 + h) * 4 * 8) * 64 + lane) * 8;
        f32x16 acc[4];
#pragma unroll
        for (int it = 0; it < 4; ++it)
#pragma unroll
            for (int r = 0; r < 16; ++r) acc[it][r] = 0.f;
#pragma unroll
        for (int ks = 0; ks < 8; ++ks) {
            const bf16x8 af = *(const bf16x8*)(arow + ks * 32);
#pragma unroll
            for (int it = (ks < 4 ? 0 : 2); it < 4; ++it) {
                const bf16x8 bf = *(const bf16x8*)(wb + (size_t)(it * 8 + ks) * 512);
                acc[it] = MFMA32(af, bf, acc[it]);
            }
        }
#pragma unroll
        for (int it = 0; it < 4; ++it) {
            const int i = it * 32 + lr; const size_t tok = (size_t)nb * 128 + i;
            const float bs = a.in[I_SGUB][((size_t)l * 4 + h) * 128 + i];
#pragma unroll
            for (int g = 0; g < 4; ++g) {
                const int c0 = h * 64 + dt * 32 + 8 * g + 4 * lh;
                float uu[4], gg[4]; unpack4(*(const u32x2*)(Z + tok * NZ + ZC_U + c0), uu); unpack4(*(const u32x2*)(Z + tok * NZ + ZC_GA + c0), gg);
                u32x2 o; o.x = pk2(uu[0] * (acc[it][4 * g] + bs) * siluf_(gg[0]), uu[1] * (acc[it][4 * g + 1] + bs) * siluf_(gg[1]));
                o.y = pk2(uu[2] * (acc[it][4 * g + 2] + bs) * siluf_(gg[2]), uu[3] * (acc[it][4 * g + 3] + bs) * siluf_(gg[3]));
                *(u32x2*)(CAT + tok * 1024 + c0) = o;
            }
        }
    }
    __syncthreads();
}

constexpr int CV_T = 64, CV_ROWS = CV_T + 30;
constexpr int CV_Y = 0;
constexpr int CV_C = CV_ROWS * 512;
constexpr int CV_APITCH = 528, CV_TPITCH = 144;
constexpr int CV_TW = CV_C + CV_T * 1024;
constexpr int CV_AD = CV_TW + CV_T * CV_TPITCH;
constexpr int CV_END = CV_AD + CV_T * CV_TPITCH;
__device__ __forceinline__ float tanh_fast(float x) { return 1.0f - 2.0f * __builtin_amdgcn_rcpf(__expf(2.0f * x) + 1.0f); }
template <int SKIP = 0>
__device__ __forceinline__ void conv_phase(const Args& a, int l, unsigned char* shm, int tid_in, int wave, int lane_in) {
    int tid = tid_in, lane = lane_in; asm volatile("" : "+v"(tid), "+v"(lane));
    const bf16_t* Z = (const bf16_t*)(a.ws + WS_Z); bf16_t* CAT = (bf16_t*)(a.ws + WS_RA);
    float* cbuf = (float*)(shm + CV_C);
    for (int item = blockIdx.x; item < M_ / CV_T; item += gridDim.x) {
        const int t0 = item * CV_T, pos0 = t0 & (S_ - 1);
        float cw[31]; float cb;
        {
            int tid2 = tid; asm volatile("" : "+v"(tid2));
            const int c = tid2 & 255;
#pragma unroll
            for (int k = 0; k < 31; ++k) cw[k] = a.in[I_CW][((size_t)l * 31 + k) * 256 + c];
            cb = a.in[I_CB][l * 256 + c];
        }
        if (!(SKIP & 1))
        {
            int tid1 = tid; asm volatile("" : "+v"(tid1));
            const int c4 = (tid1 & 63) * 4, rg = tid1 >> 6;
            u32x2 vw[12], gw[12];
#pragma unroll
            for (int i = 0; i < 12; ++i) {
                const int rr = rg + 8 * i; vw[i] = (u32x2){0u, 0u}; gw[i] = (u32x2){0u, 0u};
                if (rr < CV_ROWS && pos0 - 30 + rr >= 0) { const size_t tok = (size_t)(t0 - 30 + rr); vw[i] = *(const u32x2*)(Z + tok * NZ + ZC_VAL + c4); gw[i] = *(const u32x2*)(Z + tok * NZ + ZC_GLU + c4); }
            }
#pragma unroll
            for (int i = 0; i < 12; ++i) {
                const int rr = rg + 8 * i;
                if (rr < CV_ROWS) {
                    float v[4], g[4]; unpack4(vw[i], v); unpack4(gw[i], g);
                    *(u32x2*)(shm + CV_Y + rr * 512 + c4 * 2) = (u32x2){pk2(v[0] * sigmoidf_(g[0]), v[1] * sigmoidf_(g[1])), pk2(v[2] * sigmoidf_(g[2]), v[3] * sigmoidf_(g[3]))};
                }
            }
        }
        if (!(SKIP & 2)) {
            int tid1 = tid; asm volatile("" : "+v"(tid1));
            const int t = tid1 >> 3, j0 = (tid1 & 7) * 16; const size_t tok = (size_t)(t0 + t);
            const bf16_t* zp = Z + tok * NZ + ZC_WD + j0;
            const u32x4 c0 = *(const u32x4*)(zp), c1 = *(const u32x4*)(zp + 8);
            u32x4 p0 = (u32x4){0u, 0u, 0u, 0u}, p1 = p0;
            if (pos0 + t > 0) { p0 = *(const u32x4*)(zp - NZ); p1 = *(const u32x4*)(zp - NZ + 8); }
            const float* mu = a.in[I_MU] + (size_t)l * 1664 + 1536 + j0;
            float zc[16], zq[16]; { float t8[8]; unpack8(c0, t8);
#pragma unroll
                for (int e = 0; e < 8; ++e) zc[e] = t8[e]; unpack8(c1, t8);
#pragma unroll
                for (int e = 0; e < 8; ++e) zc[8 + e] = t8[e]; unpack8(p0, t8);
#pragma unroll
                for (int e = 0; e < 8; ++e) zq[e] = t8[e]; unpack8(p1, t8);
#pragma unroll
                for (int e = 0; e < 8; ++e) zq[8 + e] = t8[e]; }
            float o[16];
#pragma unroll
            for (int e4 = 0; e4 < 4; ++e4) { const f32x4 m4 = *(const f32x4*)(mu + 4 * e4);
#pragma unroll
                for (int e = 0; e < 4; ++e) { const float sft = zc[4 * e4 + e] + m4[e] * (zq[4 * e4 + e] - zc[4 * e4 + e]); o[4 * e4 + e] = j0 < 64 ? tanh_fast(sft) : sft; } }
            unsigned char* dst = shm + (j0 < 64 ? CV_TW + t * CV_TPITCH + j0 * 2 : CV_AD + t * CV_TPITCH + (j0 - 64) * 2);
            *(u32x4*)(dst) = (u32x4){pk2(o[0], o[1]), pk2(o[2], o[3]), pk2(o[4], o[5]), pk2(o[6], o[7])};
            *(u32x4*)(dst + 16) = (u32x4){pk2(o[8], o[9]), pk2(o[10], o[11]), pk2(o[12], o[13]), pk2(o[14], o[15])};
        }
        __syncthreads();
        if (!(SKIP & 4)) {
            int tid2 = tid; asm volatile("" : "+v"(tid2));
            const int c = tid2 & 255, th = tid2 >> 8;
#pragma unroll 1
            for (int run = 0; run < 2; ++run) {
                const int tb = th * 32 + run * 16;
                float yr[46];
#pragma unroll
                for (int i = 0; i < 46; ++i) yr[i] = bf2f(*(const unsigned short*)(shm + CV_Y + (tb + i) * 512 + c * 2));
#pragma unroll
                for (int t = 0; t < 16; ++t) {
                    float acc = cb;
#pragma unroll
                    for (int k = 0; k < 31; ++k) acc += yr[t + k] * cw[k];
                    cbuf[(tb + t) * 256 + c] = acc;
                }
            }
        }
        __syncthreads();
        int ln4 = lane; asm volatile("" : "+v"(ln4));
        int lr = ln4 & 31, lh = ln4 >> 5;
        bf16x8 wpf[16];
        {
            const bf16_t* wp = (const bf16_t*)(a.ws + WS_WPW) + ((((size_t)l * 8 + wave) * 16) * 64 + ln4) * 8;
#pragma unroll
            for (int ks = 0; ks < 16; ++ks) wpf[ks] = *(const bf16x8*)(wp + ks * 512);
        }
        unsigned gbr[2][16];
#pragma unroll
        for (int tt = 0; tt < 2; ++tt)
#pragma unroll
            for (int r = 0; r < 16; ++r) gbr[tt][r] = Z[(size_t)(t0 + tt * 32 + (r & 3) + 8 * (r >> 2) + 4 * lh) * NZ + ZC_GB + wave * 32 + lr];
        f32x4 pbv[4][2];
        {
            int tid6 = tid; asm volatile("" : "+v"(tid6));
            const float* p = a.in[I_P] + ((size_t)l * M_ + t0) * 256;
#pragma unroll
            for (int h = 0; h < 4; ++h) { const int e0 = (h * 512 + tid6) * 8; pbv[h][0] = *(const f32x4*)(p + e0); pbv[h][1] = *(const f32x4*)(p + e0 + 4); }
        }
        if (!(SKIP & 8)) {
            const f32x4 g = *(const f32x4*)(a.in[I_CLNG] + l * 256 + ln4 * 4), b = *(const f32x4*)(a.in[I_CLNB] + l * 256 + ln4 * 4);
#pragma unroll
            for (int tt = 0; tt < 8; ++tt) {
                const int t = wave * 8 + tt;
                f32x4 v = *(const f32x4*)(cbuf + t * 256 + lane * 4);
                const float mu = wave_sum_d((v[0] + v[1]) + (v[2] + v[3]), lane) * (1.0f / 256.0f);
                v = v - mu;
                const float rs = rsqrtf(wave_sum_d((v[0] * v[0] + v[1] * v[1]) + (v[2] * v[2] + v[3] * v[3]), lane) * (1.0f / 256.0f) + LN_EPS);
                u32x2 o; o.x = pk2(siluf_(v[0] * rs * g[0] + b[0]), siluf_(v[1] * rs * g[1] + b[1])); o.y = pk2(siluf_(v[2] * rs * g[2] + b[2]), siluf_(v[3] * rs * g[3] + b[3]));
                *(u32x2*)(shm + CV_Y + t * CV_APITCH + lane * 8) = o;
            }
        }
        __syncthreads();
        bf16x8 lwf[4], laf[4]; float lw0, la0;
        const bf16_t* lwu = (const bf16_t*)(a.ws + WS_WUP) + ((((size_t)l * 16 + wave * 2) * 4) * 64 + ln4) * 8;
        const bf16_t* lau = (const bf16_t*)(a.ws + WS_AUP) + ((((size_t)l * 16 + wave * 2) * 4) * 64 + ln4) * 8;
        if (!(SKIP & 16)) {
            f32x16 acc[2];
#pragma unroll
            for (int r = 0; r < 16; ++r) { acc[0][r] = 0.f; acc[1][r] = 0.f; }
            const unsigned char* bp = shm + CV_Y + lr * CV_APITCH + lh * 16;
#pragma unroll
            for (int ks = 0; ks < 16; ++ks) { acc[0] = MFMA32(*(const bf16x8*)(bp + ks * 32), wpf[ks], acc[0]); acc[1] = MFMA32(*(const bf16x8*)(bp + 32 * CV_APITCH + ks * 32), wpf[ks], acc[1]); }
            {
                int tid6 = tid; asm volatile("" : "+v"(tid6));
                bf16_t* PB = (bf16_t*)(a.ws + WS_PB) + (size_t)t0 * 256;
#pragma unroll
                for (int h = 0; h < 4; ++h) {
                    const int e0 = (h * 512 + tid6) * 8;
                    const f32x4 x0 = pbv[h][0], x1 = pbv[h][1];
                    u32x4 w; w.x = pk2(x0[0], x0[1]); w.y = pk2(x0[2], x0[3]); w.z = pk2(x1[0], x1[1]); w.w = pk2(x1[2], x1[3]);
                    *(u32x4*)(PB + e0) = w;
                }
            }
#pragma unroll
            for (int ks = 0; ks < 4; ++ks) { lwf[ks] = *(const bf16x8*)(lwu + ks * 512); laf[ks] = *(const bf16x8*)(lau + ks * 512); }
            lw0 = a.in[I_W0][l * 512 + wave * 64 + lr]; la0 = a.in[I_A0][l * 512 + wave * 64 + lr];
            const int n = wave * 32 + lr; const float pb = a.in[I_PWB][l * 256 + n];
#pragma unroll
            for (int tt = 0; tt < 2; ++tt) {
#pragma unroll
                for (int r = 0; r < 16; ++r) CAT[(size_t)(t0 + tt * 32 + (r & 3) + 8 * (r >> 2) + 4 * lh) * 1024 + 256 + n] = (bf16_t)f2bf((acc[tt][r] + pb) * siluf_(bf2f(gbr[tt][r])));
            }
        }
        if (!(SKIP & 32)) {
            int ln5 = lane; asm volatile("" : "+v"(ln5)); lr = ln5 & 31; lh = ln5 >> 5;
            unsigned* AW = (unsigned*)(a.ws + WS_WQ);
#pragma unroll
            for (int cc = 0; cc < 2; ++cc) {
                const int ct = wave * 2 + cc;
                bf16x8 wf[4], af[4];
#pragma unroll
                for (int ks = 0; ks < 4; ++ks) { wf[ks] = lwf[ks]; af[ks] = laf[ks]; }
                const float w0 = lw0, a0 = la0;
                if (cc == 0) {
#pragma unroll
                    for (int ks = 0; ks < 4; ++ks) { lwf[ks] = *(const bf16x8*)(lwu + 2048 + ks * 512); laf[ks] = *(const bf16x8*)(lau + 2048 + ks * 512); }
                    lw0 = a.in[I_W0][l * 512 + wave * 64 + 32 + lr]; la0 = a.in[I_A0][l * 512 + wave * 64 + 32 + lr];
                }
#pragma unroll
                for (int tt = 0; tt < 2; ++tt) {
                    const unsigned char* tp = shm + CV_TW + (tt * 32 + lr) * CV_TPITCH + lh * 16; const unsigned char* ap = shm + CV_AD + (tt * 32 + lr) * CV_TPITCH + lh * 16;
                    f32x16 aw, aa;
#pragma unroll
                    for (int r = 0; r < 16; ++r) { aw[r] = 0.f; aa[r] = 0.f; }
#pragma unroll
                    for (int ks = 0; ks < 4; ++ks) { aw = MFMA32(*(const bf16x8*)(tp + ks * 32), wf[ks], aw); aa = MFMA32(*(const bf16x8*)(ap + ks * 32), af[ks], aa); }
                    const int c = ct * 32 + lr;
#pragma unroll
                    for (int rg = 0; rg < 4; ++rg) {
                        u32x4 o4;
#pragma unroll
                        for (int e = 0; e < 4; ++e) {
                            const int r = 4 * rg + e;
                            const float w = __expf(-DECAY_SCALE * sigmoidf_(w0 + aw[r]));
                            const unsigned q = (unsigned)fminf(fmaxf(rintf((1.0f - w) * 131072.0f), 0.f), 65535.f);
                            o4[e] = q | (f2bf(sigmoidf_(a0 + aa[r])) << 16);
                        }
                        ((u32x4*)AW)[(size_t)((t0 + tt * 32 + 8 * rg + 4 * lh) >> 2) * 512 + c] = o4;
                    }
                }
            }
        }
        __syncthreads();
    }
}

constexpr int CS_C = 16, CS_NCH = S_ / CS_C, CS_NS = 8, CS_NP = 7;
constexpr int SM_AT4 = 0  , SM_RBK = 1024  , SM_RS = 2048, SM_BYTES = 2112;
constexpr int PA_AT = 0, PA_RT = 2304, PA_BN = 4608, PA_KN = 6912, PA_KR = 9216, PA_RK = 11520, PA_NF = 13824, PA_OUT = 14848, PA_SIZE = 16960;
constexpr int SL_AT = 0, SL_RT = 2304, SL_BK = 4608  , SL_SM = 9728, SL_VM = 11840, SL_WC = 12480, SL_SIZE = 12800;
constexpr int CS_FLAGS = CS_NS * SL_SIZE, CS_LDS = CS_FLAGS + 64;
__device__ __forceinline__ bf16x8 mk8(unsigned a, unsigned b, unsigned c, unsigned d) { return __builtin_bit_cast(bf16x8, (u32x4){a, b, c, d}); }
__device__ __forceinline__ unsigned short bf1(float x) { return (unsigned short)pg8::cvt_pk_bf16(x, x); }
#define MFMA16(a, b, c) __builtin_amdgcn_mfma_f32_16x16x32_bf16((a), (b), (c), 0, 0, 0)
__device__ __forceinline__ void scanprep_phase(const Args& a, int l, unsigned char* shm, int wave, int lane_in) {
    int lane = lane_in; asm volatile("" : "+v"(lane));
    const bf16_t* Z = (const bf16_t*)(a.ws + WS_Z);
    const unsigned* AW = (const unsigned*)(a.ws + WS_WQ);
    float* BON = (float*)(a.ws + WS_BON);
    unsigned char* sb = shm + wave * PA_SIZE;
    const int gw = blockIdx.x * 8 + wave, NGW = gridDim.x * 8;
    const int li = lane & 15, g = lane >> 4;
#pragma unroll 1
    for (int task = gw; task < 64 * CS_NCH; task += NGW) {
        const int bh = task / CS_NCH, c = task % CS_NCH, b = bh >> 3, h = bh & 7, hc = h * 64 + lane;
        const unsigned uhc = (unsigned)hc;
        const size_t tokc = (size_t)b * S_ + (size_t)c * CS_C;
        const float mu_k = a.in[I_MU][(size_t)l * 1664 + 512 + hc], mu_r = a.in[I_MU][(size_t)l * 1664 + hc];
        const float kkc = a.in[I_KK][l * 512 + hc], kac = a.in[I_KA][l * 512 + hc], rkc = a.in[I_RK][l * 512 + hc];
        unsigned rk[16]; u32x4 aw4[4];
#pragma unroll
        for (int t = 0; t < 16; ++t) rk[t] = ((const unsigned*)(Z + (tokc + t) * NZ + ZC_RK))[uhc];
#pragma unroll
        for (int j = 0; j < 4; ++j) aw4[j] = ((const u32x4*)AW)[((tokc >> 2) + j) * 512 + uhc];
        unsigned prk = 0u;
        if (c > 0) prk = ((const unsigned*)(Z + (tokc - 1) * NZ + ZC_RK))[uhc];
        float pr = bf2f(prk & 0xffffu), pk = __uint_as_float(prk & 0xffff0000u);
        float W = 1.0f;
#pragma unroll
        for (int t = 0; t < 16; ++t) {
            const float fzr = bf2f(rk[t] & 0xffffu), fzk = __uint_as_float(rk[t] & 0xffff0000u), al = __uint_as_float(aw4[t >> 2][t & 3] & 0xffff0000u), w = 1.0f - (float)(aw4[t >> 2][t & 3] & 0xffffu) * (1.0f / 131072.0f);
            const float r = fzr + mu_r * (pr - fzr), kx = fzk + mu_k * (pk - fzk);
            pr = fzr; pk = fzk;
            const float kkr = kx * kkc, kp = kx * (1.0f + (al - 1.0f) * kac);
            const float Wp = W; W *= w; const float iW = __builtin_amdgcn_rcpf(W), rW = r * W;
            *(unsigned short*)(sb + PA_AT + t * 144 + 2 * lane) = bf1(-kkr * Wp);
            *(unsigned short*)(sb + PA_RT + t * 144 + 2 * lane) = bf1(rW);
            *(unsigned short*)(sb + PA_BN + t * 144 + 2 * lane) = bf1(kkr * al * iW);
            *(unsigned short*)(sb + PA_KN + t * 144 + 2 * lane) = bf1(kp * iW);
            *(unsigned short*)(sb + PA_KR + t * 144 + 2 * lane) = bf1(kkr);
            *(unsigned short*)(sb + PA_RK + t * 144 + 2 * lane) = bf1(rW * rkc);
        }
        __builtin_amdgcn_s_waitcnt(0xC07F); asm volatile("" ::: "memory");
        {
            bf16x8 fa[2], fr[2], fb[2], fk[2], fq[2], fo[2];
#pragma unroll
            for (int s2 = 0; s2 < 2; ++s2) {
                fa[s2] = *(const bf16x8*)(sb + PA_AT + li * 144 + 16 * g + 64 * s2); fr[s2] = *(const bf16x8*)(sb + PA_RT + li * 144 + 16 * g + 64 * s2);
                fb[s2] = *(const bf16x8*)(sb + PA_BN + li * 144 + 16 * g + 64 * s2); fk[s2] = *(const bf16x8*)(sb + PA_KN + li * 144 + 16 * g + 64 * s2);
                fq[s2] = *(const bf16x8*)(sb + PA_KR + li * 144 + 16 * g + 64 * s2); fo[s2] = *(const bf16x8*)(sb + PA_RK + li * 144 + 16 * g + 64 * s2);
            }
            const f32x4 z4 = {0.f, 0.f, 0.f, 0.f};
            f32x4 dss = MFMA16(fq[0], fq[0], z4); dss = MFMA16(fq[1], fq[1], dss);
            f32x4 dbo = MFMA16(fo[0], fk[0], z4); dbo = MFMA16(fo[1], fk[1], dbo);
            f32x4 dab = MFMA16(fa[0], fb[0], z4); dab = MFMA16(fa[1], fb[1], dab);
            f32x4 dak = MFMA16(fa[0], fk[0], z4); dak = MFMA16(fa[1], fk[1], dak);
            f32x4 drb = MFMA16(fr[0], fb[0], z4); drb = MFMA16(fr[1], fb[1], drb);
            f32x4 drk = MFMA16(fr[0], fk[0], z4); drk = MFMA16(fr[1], fk[1], drk);
            if (g == (li >> 2)) {
                const int rr = li & 3;
                const float ss = rr == 0 ? dss[0] : (rr == 1 ? dss[1] : (rr == 2 ? dss[2] : dss[3]));
                const float bo = rr == 0 ? dbo[0] : (rr == 1 ? dbo[1] : (rr == 2 ? dbo[2] : dbo[3]));
                const float rs = rsqrtf(fmaxf(ss, 1e-12f));
                *(float*)(sb + PA_OUT + SM_RS + 4 * li) = rs;
                BON[(tokc + li) * 8 + h] = bo;
            }
            __builtin_amdgcn_s_waitcnt(0xC07F); asm volatile("" ::: "memory");
            const float rsc = *(const float*)(sb + PA_OUT + SM_RS + 4 * li); const f32x4 rsr = *(const f32x4*)(sb + PA_OUT + SM_RS + 16 * g);
#pragma unroll
            for (int r = 0; r < 4; ++r) {
                const int t = 4 * g + r;
                *(float*)(sb + PA_NF + t * 64 + 4 * li) = li < t ? dab[r] * rsr[r] * rsc : 0.f;
                *(unsigned short*)(sb + PA_OUT + SM_AT4 + t * 64 + (li >> 2) * 16 + (li & 3) * 2) = bf1(li < t ? dak[r] * rsr[r] : 0.f);
                *(unsigned short*)(sb + PA_OUT + SM_RBK + t * 64 + (li >> 2) * 16 + (li & 3) * 2) = bf1(li <= t ? drb[r] * rsc : 0.f);
                *(unsigned short*)(sb + PA_OUT + SM_RBK + t * 64 + (li >> 2) * 16 + 8 + (li & 3) * 2) = bf1(li <= t ? drk[r] : 0.f);
            }
        }
        __builtin_amdgcn_s_waitcnt(0xC07F); asm volatile("" ::: "memory");
        {
            float T[16];
#pragma unroll
            for (int t = 0; t < 16; ++t) {
                float x = li == t ? 1.0f : 0.f;
#pragma unroll
                for (int j4 = 0; j4 < t; j4 += 4) {
                    const f32x4 n4 = *(const f32x4*)(sb + PA_NF + t * 64 + 4 * j4);
#pragma unroll
                    for (int e = 0; e < 4; ++e) if (j4 + e < t) x += n4[e] * T[j4 + e];
                }
                T[t] = x;
                if (g == 0) *(unsigned short*)(sb + PA_OUT + SM_AT4 + t * 64 + (li >> 2) * 16 + 8 + (li & 3) * 2) = bf1(x);
            }
        }
        __builtin_amdgcn_s_waitcnt(0xC07F); asm volatile("" ::: "memory");
        {
            unsigned char* dst = (unsigned char*)(Z + (tokc + h) * NZ);
            *(u32x4*)(dst + 16 * lane) = *(const u32x4*)(sb + PA_OUT + 16 * lane);
            *(u32x4*)(dst + 1024 + 16 * lane) = *(const u32x4*)(sb + PA_OUT + 1024 + 16 * lane);
            if (lane < 4) *(u32x4*)(dst + 2048 + 16 * lane) = *(const u32x4*)(sb + PA_OUT + 2048 + 16 * lane);
        }
        __builtin_amdgcn_s_waitcnt(0xC07F); asm volatile("" ::: "memory");
    }
}
template <int MODE  >
__device__ __forceinline__ void cscan_phase(const Args& a, int l, unsigned char* shm, int tid, int wave, int lane) {
    const bf16_t* Z = (const bf16_t*)(a.ws + WS_Z);
    const unsigned* AW = (const unsigned*)(a.ws + WS_WQ);
    bf16_t* Y = (bf16_t*)(a.ws + WS_RB);
    volatile PG8_LAS unsigned* flags = (volatile PG8_LAS unsigned*)((PG8_LAS unsigned char*)shm + CS_FLAGS);
    const int G = gridDim.x, bx = blockIdx.x, vcu = (G % 8 == 0) ? (bx % 8) * (G / 8) + bx / 8 : bx;
    for (int task = vcu; task < 256; task += G) {
        const int bh = task >> 2, q = task & 3, b = bh >> 3, h = bh & 7;
        const size_t tok0 = (size_t)b * S_;
        if (tid < 16) flags[tid] = 0u;
        __syncthreads();
        const int li = lane & 15, g = lane >> 4;
        if (wave == 0) {
            __builtin_amdgcn_s_setprio(3);
            f32x4 S[4];
#pragma unroll
            for (int i = 0; i < 4; ++i) S[i] = (f32x4){0.f, 0.f, 0.f, 0.f};
            bf16_t* Yp = Y + (tok0 + 4 * g) * 512 + h * 64 + 16 * q + li;
            bf16x8 c_at[2], c_rt[2], c_bk[4], c_a4, c_rbk; u32x2 c_vm; f32x4 c_wc[4];
            bf16x8 n_at[2], n_rt[2], n_bk[4], n_a4, n_rbk; u32x2 n_vm; f32x4 n_wc[4];
#define CS_LOAD(P, cc) do { const unsigned char* sb_ = shm + ((cc) & 7) * SL_SIZE; \
                _Pragma("unroll") for (int s2 = 0; s2 < 2; ++s2) { P##at[s2] = *(const bf16x8*)(sb_ + SL_AT + li * 144 + 64 * s2 + 16 * g); P##rt[s2] = *(const bf16x8*)(sb_ + SL_RT + li * 144 + 64 * s2 + 16 * g); } \
                _Pragma("unroll") for (int i = 0; i < 4; ++i) { P##bk[i] = *(const bf16x8*)(sb_ + SL_BK + (16 * i + li) * 80 + 16 * g); P##wc[i] = *(const f32x4*)(sb_ + SL_WC + (16 * i + 4 * g) * 4); } \
                P##a4 = *(const bf16x8*)(sb_ + SL_SM + SM_AT4 + li * 64 + 16 * g); P##rbk = *(const bf16x8*)(sb_ + SL_SM + SM_RBK + li * 64 + 16 * g); P##vm = *(const u32x2*)(sb_ + SL_VM + li * 40 + 8 * g); } while (0)
#define CS_COMPUTE(P, cc) do { \
                const f32x4 z4_ = {0.f, 0.f, 0.f, 0.f}; \
                const f32x4 rhs0_ = MFMA16(P##a4, mk8(P##vm.x, P##vm.y, 0u, 0u), z4_); \
                const bf16x8 sb0_ = mk8(pg8::cvt_pk_bf16(S[0][0], S[0][1]), pg8::cvt_pk_bf16(S[0][2], S[0][3]), pg8::cvt_pk_bf16(S[1][0], S[1][1]), pg8::cvt_pk_bf16(S[1][2], S[1][3])); \
                const bf16x8 sb1_ = mk8(pg8::cvt_pk_bf16(S[2][0], S[2][1]), pg8::cvt_pk_bf16(S[2][2], S[2][3]), pg8::cvt_pk_bf16(S[3][0], S[3][1]), pg8::cvt_pk_bf16(S[3][2], S[3][3])); \
                f32x4 rhs_ = MFMA16(P##at[0], sb0_, rhs0_); rhs_ = MFMA16(P##at[1], sb1_, rhs_); \
                f32x4 y_ = MFMA16(P##rt[0], sb0_, z4_); y_ = MFMA16(P##rt[1], sb1_, y_); \
                const f32x4 sa_ = MFMA16(P##a4, mk8(0u, 0u, pg8::cvt_pk_bf16(rhs_[0], rhs_[1]), pg8::cvt_pk_bf16(rhs_[2], rhs_[3])), z4_); \
                const bf16x8 sv_ = mk8(pg8::cvt_pk_bf16(sa_[0], sa_[1]), pg8::cvt_pk_bf16(sa_[2], sa_[3]), P##vm.x, P##vm.y); \
                _Pragma("unroll") for (int i = 0; i < 4; ++i) { S[i] = MFMA16(P##bk[i], sv_, S[i]); S[i] = S[i] * P##wc[i]; } \
                y_ = MFMA16(P##rbk, sv_, y_); \
                { bf16_t* yq_ = Yp + (size_t)(cc) * (CS_C * 512); const unsigned y01_ = pg8::cvt_pk_bf16(y_[0], y_[1]), y23_ = pg8::cvt_pk_bf16(y_[2], y_[3]); yq_[0] = (bf16_t)y01_; yq_[512] = (bf16_t)(y01_ >> 16); yq_[1024] = (bf16_t)y23_; yq_[1536] = (bf16_t)(y23_ >> 16); } } while (0)
#define CS_WAIT(fl, cc) do { while ((fl) != (unsigned)((cc) + 1)) { __builtin_amdgcn_s_sleep(1); (fl) = flags[(cc) & 7]; } asm volatile("" ::: "memory"); } while (0)
#define CS_SIGNAL(n) do { __builtin_amdgcn_s_waitcnt(0xC07F); asm volatile("" ::: "memory"); flags[8] = (unsigned)(n); asm volatile("" ::: "memory"); } while (0)
            unsigned fl = flags[0];
            CS_WAIT(fl, 0);
            if (MODE != 2) CS_LOAD(c_, 0);
            fl = flags[1];
            CS_SIGNAL(1);
#pragma unroll 1
            for (int c = 0; c < CS_NCH - 2; c += 2) {
                CS_WAIT(fl, c + 1);
                if (MODE != 2) CS_LOAD(n_, c + 1);
                fl = flags[(c + 2) & 7];
                if (MODE != 2) CS_COMPUTE(c_, c);
                CS_SIGNAL(c + 2);
                CS_WAIT(fl, c + 2);
                if (MODE != 2) CS_LOAD(c_, c + 2);
                fl = flags[(c + 3) & 7];
                if (MODE != 2) CS_COMPUTE(n_, c + 1);
                CS_SIGNAL(c + 3);
            }
            {
                CS_WAIT(fl, CS_NCH - 1);
                if (MODE != 2) CS_LOAD(n_, CS_NCH - 1);
                if (MODE != 2) CS_COMPUTE(c_, CS_NCH - 2);
                CS_SIGNAL(CS_NCH);
                if (MODE != 2) CS_COMPUTE(n_, CS_NCH - 1);
            }
#undef CS_COMPUTE
#undef CS_WAIT
#undef CS_SIGNAL
            __builtin_amdgcn_s_setprio(0);
#undef CS_LOAD
        } else {
            const int hc = h * 64 + lane;
            const unsigned uhc = (unsigned)hc;
            const int kpos = (lane & 32) | (((lane >> 2) & 3) << 3) | (((lane >> 4) & 1) << 2) | (lane & 3);
            float mu_r = a.in[I_MU][(size_t)l * 1664 + hc], mu_k = a.in[I_MU][(size_t)l * 1664 + 512 + hc];
            float kkc = a.in[I_KK][l * 512 + hc], kac = a.in[I_KA][l * 512 + hc];
            const int vt = lane >> 2, vcg = lane & 3;
            f32x4 mu_v4 = *(const f32x4*)(a.in[I_MU] + (size_t)l * 1664 + 1024 + h * 64 + 16 * q + 4 * vcg);
            const unsigned long long zb_ = (unsigned long long)Z, wb_ = (unsigned long long)AW;
            const u32x4 zrs = {(unsigned)__builtin_amdgcn_readfirstlane((int)(unsigned)zb_), (unsigned)__builtin_amdgcn_readfirstlane((int)(unsigned)(zb_ >> 32)) & 0xffffu, 0x7fffffffu, 0x00020000u};
            const u32x4 wrs = {(unsigned)__builtin_amdgcn_readfirstlane((int)(unsigned)wb_), (unsigned)__builtin_amdgcn_readfirstlane((int)(unsigned)(wb_ >> 32)) & 0xffffu, 0x7fffffffu, 0x00020000u};
            const int vo_rk = (int)uhc * 4 + ZC_RK * 2, vo_aw = (int)uhc * 16, vo_bl = 16 * lane, vo_rs = SM_RS + 4 * (lane & 15), vo_v = vt * (NZ * 2) + (ZC_VG + 2 * (h * 64 + 16 * q + 4 * vcg)) * 2;
            const int vo_vz = (vt > 0 ? vt - 1 : 0) * (NZ * 2) + (ZC_VG + 2 * (h * 64 + 16 * q + 4 * vcg)) * 2;
#define PDECL(P) unsigned P##rk[16]; u32x4 P##aw4[4]; u32x4 P##bl0, P##bl1, P##vc, P##vp; unsigned P##rsv, P##cpq
#define PZERO(P) do { _Pragma("unroll") for (int t = 0; t < 16; ++t) P##rk[t] = 0u; _Pragma("unroll") for (int j = 0; j < 4; ++j) P##aw4[j] = (u32x4){0u, 0u, 0u, 0u}; \
                P##bl0 = P##bl1 = P##vc = P##vp = (u32x4){0u, 0u, 0u, 0u}; P##rsv = 0u; P##cpq = 0u; } while (0)
            PDECL(A_); PDECL(B_); PZERO(A_); PZERO(B_);
#define ALD32(dst, vo, rs, so) asm volatile("buffer_load_dword %0, %1, %2, %3 offen" : "+v"(dst) : "v"(vo), "s"(rs), "s"(so))
#define ALD128(dst, vo, rs, so) asm volatile("buffer_load_dwordx4 %0, %1, %2, %3 offen" : "+v"(dst) : "v"(vo), "s"(rs), "s"(so))
#define PLD_B(P, tk) do { const int bo_ = ((tk) + h) * (NZ * 2); ALD128(P##bl0, vo_bl, zrs, bo_); ALD128(P##bl1, vo_bl, zrs, bo_ + 1024); \
                const bool z0_ = (tk) == 0;            \
                const int pso_ = z0_ ? 0 : ((tk) - 1) * (NZ * 2); const int pvo_ = z0_ ? vo_vz : vo_v; \
                ALD32(P##cpq, vo_rk, zrs, pso_); ALD128(P##vc, vo_v, zrs, (tk) * (NZ * 2)); ALD128(P##vp, pvo_, zrs, pso_); } while (0)
#define PLD_H(P, hh, tk) do { _Pragma("unroll") for (int t = 8 * (hh); t < 8 * (hh) + 8; ++t) ALD32(P##rk[t], vo_rk, zrs, ((tk) + t) * (NZ * 2)); \
                _Pragma("unroll") for (int j = 2 * (hh); j < 2 * (hh) + 2; ++j) ALD128(P##aw4[j], vo_aw, wrs, (((tk) >> 2) + j) * 8192); } while (0)
#define PLD_R(P, tk) ALD32(P##rsv, vo_rs, zrs, ((tk) + h) * (NZ * 2))
#define PWAIT(P) do { asm volatile("s_waitcnt vmcnt(26)" : "+v"(P##bl0), "+v"(P##bl1), "+v"(P##vc), "+v"(P##vp), "+v"(P##cpq), "+v"(P##rsv), "+v"(P##aw4[0]), "+v"(P##aw4[1]), "+v"(P##aw4[2]), "+v"(P##aw4[3]), \
                    "+v"(P##rk[0]), "+v"(P##rk[1]), "+v"(P##rk[2]), "+v"(P##rk[3]), "+v"(P##rk[4]), "+v"(P##rk[5]), "+v"(P##rk[6]), "+v"(P##rk[7]), \
                    "+v"(P##rk[8]), "+v"(P##rk[9]), "+v"(P##rk[10]), "+v"(P##rk[11]), "+v"(P##rk[12]), "+v"(P##rk[13]), "+v"(P##rk[14]), "+v"(P##rk[15])); } while (0)
#define PTOK(P, t) do { \
                    const unsigned zr_ = P##rk[t], aw_ = P##aw4[(t) >> 2][(t) & 3]; \
                    const float fzr = bf2f(zr_ & 0xffffu), fzk = __uint_as_float(zr_ & 0xffff0000u), al = __uint_as_float(aw_ & 0xffff0000u), w = 1.0f - (float)(aw_ & 0xffffu) * (1.0f / 131072.0f); \
                    const float r = fzr + mu_r * (pr - fzr), kx = fzk + mu_k * (pk - fzk); \
                    pr = fzr; pk = fzk; \
                    const float kk = kx * kkc * __uint_as_float(__builtin_amdgcn_readlane(P##rsv, (t))); \
                    const float kp = kx * (1.0f + (al - 1.0f) * kac); \
                    const float Wp = W; W *= w; const float iW = __builtin_amdgcn_rcpf(W); \
                    const float fb = kk * al * iW, fk = kp * iW; \
                    *(unsigned short*)(sb + SL_AT + (t) * 144 + 2 * kpos) = bf1(-kk * Wp); \
                    *(unsigned short*)(sb + SL_RT + (t) * 144 + 2 * kpos) = bf1(r * W); \
                    if ((t) & 1) { btp[(t) >> 1] = pg8::cvt_pk_bf16(eb, fb); ktp[(t) >> 1] = pg8::cvt_pk_bf16(ek, fk); } \
                    else { eb = fb; ek = fk; } } while (0)
#define PITER(P, c) do { \
                unsigned char* sb = shm + ((c) & 7) * SL_SIZE; \
                if ((c) >= CS_NS) { while ((int)flags[8] < (c) - (CS_NS - 1)) __builtin_amdgcn_s_sleep(2); } \
                asm volatile("" ::: "memory"); \
                { \
                    const int cn_ = (c) + 2 * CS_NP < CS_NCH ? (c) + 2 * CS_NP : (c);            \
                    const int tkn_ = (int)tok0 + cn_ * CS_C; \
                    PWAIT(P); \
                    if ((c) == 0) { P##cpq = 0u; if (vt == 0) P##vp = (u32x4){0u, 0u, 0u, 0u}; }            \
                    *(u32x4*)(sb + SL_SM + 16 * lane) = P##bl0; *(u32x4*)(sb + SL_SM + 1024 + 16 * lane) = P##bl1; \
                    float pr = bf2f(P##cpq & 0xffffu), pk = __uint_as_float(P##cpq & 0xffff0000u); \
                    {     \
                        _Pragma("unroll") for (int i = 0; i < 4; ++i) { const float zv = bf2f(P##vc[i] & 0xffffu), pv = bf2f(P##vp[i] & 0xffffu); \
                            *(unsigned short*)(sb + SL_VM + (4 * vcg + i) * 40 + 2 * vt) = bf1(zv + mu_v4[i] * (pv - zv)); } \
                    } \
                    PLD_B(P, tkn_); \
                    float W = 1.0f, eb = 0.f, ek = 0.f; \
                    unsigned btp[8], ktp[8]; \
                    _Pragma("unroll") for (int t = 0; t < 8; ++t) PTOK(P, t); \
                    PLD_H(P, 0, tkn_); \
                    _Pragma("unroll") for (int t = 8; t < 16; ++t) PTOK(P, t); \
                    PLD_H(P, 1, tkn_); PLD_R(P, tkn_); \
                    {     \
                        unsigned char* pb = sb + SL_BK + lane * 80; \
                        _Pragma("unroll") for (int i = 0; i < 4; ++i) *(u32x4*)(pb + 16 * i) = (u32x4){btp[2 * i], btp[2 * i + 1], ktp[2 * i], ktp[2 * i + 1]}; \
                        *(float*)(sb + SL_WC + 4 * lane) = W; \
                    } \
                } \
                __builtin_amdgcn_s_waitcnt(0xC07F); asm volatile("" ::: "memory"); \
                flags[(c) & 7] = (unsigned)((c) + 1); \
                asm volatile("" ::: "memory"); } while (0)
            int c = wave - 1;
            {
                float m0_ = mu_v4[0], m1_ = mu_v4[1], m2_ = mu_v4[2], m3_ = mu_v4[3], a_ = mu_r, b_ = mu_k, c_ = kkc, d_ = kac;
                asm volatile("" : "+v"(m0_), "+v"(m1_), "+v"(m2_), "+v"(m3_), "+v"(a_), "+v"(b_), "+v"(c_), "+v"(d_));
                mu_v4 = (f32x4){m0_, m1_, m2_, m3_}; mu_r = a_; mu_k = b_; kkc = c_; kac = d_;
            }
            {
                const int tk0_ = (int)tok0 + c * CS_C, tk1_ = tk0_ + CS_NP * CS_C;
                PLD_B(A_, tk0_); PLD_H(A_, 0, tk0_); PLD_H(A_, 1, tk0_); PLD_R(A_, tk0_);
                PLD_B(B_, tk1_); PLD_H(B_, 0, tk1_); PLD_H(B_, 1, tk1_); PLD_R(B_, tk1_);
            }
#pragma unroll 1
            for (;;) {
                PITER(A_, c); c += CS_NP; if (c >= CS_NCH) break;
                PITER(B_, c); c += CS_NP; if (c >= CS_NCH) break;
            }
            asm volatile("s_waitcnt vmcnt(0)" ::: "memory");
#undef ALD32
#undef ALD128
#undef PWAIT
#undef PZERO
#undef PITER
#undef PDECL
#undef PLD_B
#undef PLD_H
#undef PLD_R
#undef PTOK
        }
        __syncthreads();
    }
}

__device__ __forceinline__ void phase_branchc(const Args& a, int l, int wave, int lane) {
    const int gw = blockIdx.x * 8 + wave, NGW = gridDim.x * 8;
    const bf16_t* Z = (const bf16_t*)(a.ws + WS_Z); bf16_t* CAT = (bf16_t*)(a.ws + WS_RA); const bf16_t* Y = (const bf16_t*)(a.ws + WS_RB); const float* BON = (const float*)(a.ws + WS_BON);
    const int hc = lane * 8, head = lane >> 3;
    const f32x4 g0 = *(const f32x4*)(a.in[I_LXG] + l * 512 + hc), g1 = *(const f32x4*)(a.in[I_LXG] + l * 512 + hc + 4), b0 = *(const f32x4*)(a.in[I_LXB] + l * 512 + hc), b1 = *(const f32x4*)(a.in[I_LXB] + l * 512 + hc + 4);
    const f32x4 m0 = *(const f32x4*)(a.in[I_MU] + (size_t)l * 1664 + 1024 + hc), m1 = *(const f32x4*)(a.in[I_MU] + (size_t)l * 1664 + 1024 + hc + 4);
    constexpr int NT = 4;
    for (int mp = NT * gw; mp < M_; mp += NT * NGW) {
        u32x4 yv[NT]; u32x4 cw[NT][2], pw[2]; float bo[NT];
#pragma unroll
        for (int u = 0; u < NT; ++u) {
            yv[u] = *(const u32x4*)(Y + (size_t)(mp + u) * 512 + hc);
            const u32x4* cp = (const u32x4*)(Z + (size_t)(mp + u) * NZ + ZC_VG + 2 * hc);
#pragma unroll
            for (int i = 0; i < 2; ++i) cw[u][i] = cp[i];
            bo[u] = BON[(size_t)(mp + u) * 8 + head];
        }
        {
            const bool hp = (mp & (S_ - 1)) > 0; const u32x4* pp = (const u32x4*)(Z + (size_t)(mp - 1) * NZ + ZC_VG + 2 * hc);
#pragma unroll
            for (int i = 0; i < 2; ++i) { pw[i] = (u32x4){0u, 0u, 0u, 0u}; if (hp) pw[i] = pp[i]; }
        }
#pragma unroll
        for (int u = 0; u < NT; ++u) {
            float y[8]; unpack8(yv[u], y);
            float sm = ((y[0] + y[1]) + (y[2] + y[3])) + ((y[4] + y[5]) + (y[6] + y[7]));
            sm += shx(sm, 1, lane); sm += shx(sm, 2, lane); sm += shx(sm, 4, lane);
            const float mean = sm * (1.0f / 64.0f); float q = 0.f;
#pragma unroll
            for (int e = 0; e < 8; ++e) { y[e] -= mean; q += y[e] * y[e]; }
            q += shx(q, 1, lane); q += shx(q, 2, lane); q += shx(q, 4, lane);
            const float rs = rsqrtf(q * (1.0f / 64.0f) + GN_EPS);
            float o[8];
#pragma unroll
            for (int i = 0; i < 2; ++i) {
                const u32x4 c4 = cw[u][i], p4 = u == 0 ? pw[i] : cw[u > 0 ? u - 1 : 0][i];
#pragma unroll
                for (int hh = 0; hh < 4; ++hh) {
                    const int e = 4 * i + hh; const unsigned cd = c4[hh], pd = p4[hh];
                    const float zv = bf2f(cd & 0xffffu), gc = __uint_as_float(cd & 0xffff0000u), pvv = bf2f(pd & 0xffffu);
                    const float mu = e < 4 ? m0[e & 3] : m1[e & 3], g = e < 4 ? g0[e & 3] : g1[e & 3], bb = e < 4 ? b0[e & 3] : b1[e & 3];
                    const float v = zv + mu * (pvv - zv);
                    o[e] = (y[e] * rs * g + bb + bo[u] * v) * siluf_(gc);
                }
            }
            u32x4 w; w.x = pk2(o[0], o[1]); w.y = pk2(o[2], o[3]); w.z = pk2(o[4], o[5]); w.w = pk2(o[6], o[7]);
            *(u32x4*)(CAT + (size_t)(mp + u) * 1024 + 512 + hc) = w;
        }
    }
}

__device__ __forceinline__ void phase_xnew(const Args& a, int l, int wave, int lane) {
    const int gw = blockIdx.x * 8 + wave, NGW = gridDim.x * 8;
    const float* xin = l == 0 ? a.in[I_X] : a.out; float* xout = a.out;
    const bf16_t* MIX = (const bf16_t*)(a.ws + WS_RB); bf16_t* XNB = (bf16_t*)(a.ws + WS_RA); const float* ssq = (const float*)(a.ws + WS_SSQ2);
    const float* g = a.in[I_POSTG] + l * 1024;
    for (int m = gw; m < M_; m += NGW) {
        const f32x4* sp = (const f32x4*)(ssq + (size_t)m * 16);
        const f32x4 s0 = sp[0], s1 = sp[1], s2 = sp[2], s3 = sp[3];
        const float t = ((s0[0] + s0[1]) + (s0[2] + s0[3])) + ((s1[0] + s1[1]) + (s1[2] + s1[3])) + ((s2[0] + s2[1]) + (s2[2] + s2[3])) + ((s3[0] + s3[1]) + (s3[2] + s3[3]));
        const float rstd = rsqrtf(t * (1.0f / 1024.0f) + RMS_EPS);
#pragma unroll
        for (int h = 0; h < 2; ++h) {
            const int col = h * 512 + lane * 8; const size_t off = (size_t)m * 1024 + col;
            const u32x4 mw = *(const u32x4*)(MIX + off); float mx[8]; unpack8(mw, mx);
            const f32x4 x0 = *(const f32x4*)(xin + off), x1 = *(const f32x4*)(xin + off + 4), g0 = *(const f32x4*)(g + col), g1 = *(const f32x4*)(g + col + 4);
            f32x4 o0, o1;
#pragma unroll
            for (int j = 0; j < 4; ++j) { o0[j] = x0[j] + mx[j] * rstd * g0[j]; o1[j] = x1[j] + mx[4 + j] * rstd * g1[j]; }
            *(f32x4*)(xout + off) = o0; *(f32x4*)(xout + off + 4) = o1;
            u32x4 w; w.x = pk2(o0[0], o0[1]); w.y = pk2(o0[2], o0[3]); w.z = pk2(o1[0], o1[1]); w.w = pk2(o1[2], o1[3]);
            *(u32x4*)(XNB + off) = w;
        }
    }
}

#define XB_TMO      128
#define XB_XCNT(j)  (256  + 64 * (j))
#define XB_XSUB(j)  (1280 + 64 * (j))
#define XB_XGEN(j)  (2304 + 64 * (j))
#define XB_TOP      3328
#define XB_TOPGEN   3392
#define XCD_BAR_WORDS 3456
#define XB_SPIN_CAP (1u << 18)

__device__ __forceinline__ unsigned xb_ld(unsigned* p)              { return __hip_atomic_load(p, __ATOMIC_RELAXED, __HIP_MEMORY_SCOPE_AGENT); }
__device__ __forceinline__ unsigned xb_add(unsigned* p, unsigned v) { return __hip_atomic_fetch_add(p, v, __ATOMIC_RELAXED, __HIP_MEMORY_SCOPE_AGENT); }
__device__ __forceinline__ unsigned xb_xcc_id() { return (unsigned)__builtin_amdgcn_s_getreg((3 << 11) | 20) & 0xFu; }
#define XB_SPIN(cond, bar) do { unsigned _sp = 0; while (cond) { __builtin_amdgcn_s_sleep(1); \
    if ((++_sp & 255u) == 0u) { if (xb_ld(&(bar)[XB_TMO])) break; if (_sp > XB_SPIN_CAP) { atomicAdd(&(bar)[XB_TMO], 1u); break; } } } } while (0)

struct XcdBarrier {
    unsigned* bar; unsigned x;
    volatile unsigned* st;
};

__device__ __forceinline__ XcdBarrier xcd_barrier_post(unsigned* bar, volatile unsigned* st) {
    XcdBarrier b; b.bar = bar; b.x = xb_xcc_id(); b.st = st;
    if (threadIdx.x == 0) (void)xb_add(&bar[XB_XCNT(b.x)], 1u);
    return b;
}
__device__ __forceinline__ void xcd_barrier_complete(unsigned* bar, unsigned x, unsigned& nloc, unsigned& nx) {
    const unsigned G = gridDim.x * gridDim.y * gridDim.z;
    unsigned sum, cnt, mine, sp = 0u;
    for (;;) {
        sum = 0u; cnt = 0u; mine = 0u;
#pragma unroll
        for (unsigned j = 0; j < 16; ++j) { const unsigned c = xb_ld(&bar[XB_XCNT(j)]); sum += c; cnt += (c > 0u) ? 1u : 0u; mine = (j == x) ? c : mine; }
        if (sum == G) break;
        __builtin_amdgcn_s_sleep(1);
        if ((++sp & 255u) == 0u) { if (xb_ld(&bar[XB_TMO])) break; if (sp > XB_SPIN_CAP) { atomicAdd(&bar[XB_TMO], 1u); break; } }
    }
    nloc = mine > 0u ? mine : 1u; nx = cnt > 0u ? cnt : 1u;
}

__device__ __forceinline__ void xcd_barrier(const XcdBarrier& b) {
    asm volatile("s_waitcnt vmcnt(0)" ::: "memory");
    __syncthreads();
    if (threadIdx.x == 0) {
        unsigned* bar = b.bar;
        __builtin_amdgcn_s_waitcnt(0);
        unsigned nloc = b.st[0], nx = b.st[1];
        if (nloc == 0u) { xcd_barrier_complete(bar, b.x, nloc, nx); b.st[0] = nloc; b.st[1] = nx; }
        const unsigned old = xb_add(&bar[XB_XSUB(b.x)], 1u);
        const unsigned gen = old / nloc;
        if (old + 1u == (gen + 1u) * nloc) {
            __builtin_amdgcn_fence(__ATOMIC_RELEASE, "agent");
            asm volatile("s_waitcnt vmcnt(0)" ::: "memory");
            const unsigned og = xb_add(&bar[XB_TOP], 1u);
            const unsigned tg = og / nx;
            if (og + 1u == (tg + 1u) * nx) xb_add(&bar[XB_TOPGEN], 1u);
            else XB_SPIN(xb_ld(&bar[XB_TOPGEN]) == tg, bar);
            __builtin_amdgcn_fence(__ATOMIC_ACQUIRE, "agent");
            xb_add(&bar[XB_XGEN(b.x)], 1u);
            asm volatile("s_waitcnt vmcnt(0)" ::: "memory");
        } else {
            XB_SPIN(xb_ld(&bar[XB_XGEN(b.x)]) == gen, bar);
            __builtin_amdgcn_fence(__ATOMIC_ACQUIRE, "agent");
            asm volatile("s_waitcnt vmcnt(0)" ::: "memory");
        }
    }
    __syncthreads();
}

#ifndef MK_ONE_LAUNCH
#define MK_ONE_LAUNCH 1
#endif
constexpr int cmax_(int a, int b) { return a > b ? a : b; }
constexpr int LDS_MAIN = cmax_(cmax_(CS_LDS, CV_END), cmax_((int)pg8::STAGE_BYTES, 8 * PA_SIZE));
static_assert(LDS_MAIN + 64 <= 163840, "LDS budget");
constexpr int NSP = 7, N_PHASES = 1 + NSP * L_, KALL = (1 << (NSP + 1)) - 1;
template <int KMASK>
__global__ void __launch_bounds__(512, 2) fwd_kernel(Args a_k) {
    const Args& a = a_k;
    extern __shared__ __attribute__((aligned(16))) unsigned char shm[];
    float* ldsf = (float*)shm;
#if MK_ONE_LAUNCH
    cg::grid_group grid = cg::this_grid();
    volatile unsigned* bst = (volatile unsigned*)(shm + LDS_MAIN);
    if (threadIdx.x < 2) bst[threadIdx.x] = 0u;
    __syncthreads();
    const XcdBarrier xbar = xcd_barrier_post((unsigned*)(a.ws + WS_CTL), bst);
    bool first_bar = true;
#define GRID_BAR() do { if (first_bar) { grid.sync(); first_bar = false; } else xcd_barrier(xbar); } while (0)
#else
#define GRID_BAR() do { } while (0)
#endif
#ifndef DUP_SP
#define DUP_SP -1
#endif
#ifdef PROBE_SP
    unsigned long long probe_acc = 0, probe_t0 = __builtin_amdgcn_s_memrealtime();
#endif
    for (int ph = a.ph_lo; ph < a.ph_hi; ++ph) {
      const int nrep = (DUP_SP >= 0 && ph > 0 && (ph - 1) % NSP == DUP_SP) ? 2 : 1;
      for (int rep = 0; rep < nrep; ++rep) {
        if (rep) GRID_BAR();
        int tid_ = threadIdx.x; asm volatile("" : "+v"(tid_));
        const int tid = tid_, wave = __builtin_amdgcn_readfirstlane(tid >> 6), lane = tid & 63;
        unsigned long long kp_ = (unsigned long long)__builtin_amdgcn_kernarg_segment_ptr(); asm volatile("" : "+s"(kp_));
#if defined(__HIP_DEVICE_COMPILE__)
        const Args a_l = *(const __attribute__((address_space(4))) Args*)kp_;
#else
        const Args a_l = a_k; (void)kp_;
#endif
        const Args& a = a_l;
        if (ph == 0) { if constexpr ((KMASK >> NSP) & 1) phase_prologue(a, ldsf, wave, lane); }
        else {
            const int l = (ph - 1) / NSP, sp = (ph - 1) % NSP;
            if (sp == 0) {
                if constexpr ((KMASK >> 0) & 1) {
                pg8::Gemm g{(const bf16_t*)a.out, (const bf16_t*)(a.ws + WS_WIN) + (size_t)l * NZP * 1024, M_, NZP, 1024};
                pg8::StaticOrder S; S.init(M_, NZP, (int)gridDim.x, (int)blockIdx.x);
                EpiZ E{(bf16_t*)(a.ws + WS_Z), (const float*)(a.ws + WS_SSQ1)};
                pg8::gemm_phase<EpiZ, pg8::StaticOrder, false>((PG8_LAS unsigned char*)shm, g, S, E, nullptr);
                if (l + 1 < L_ && (int)blockIdx.x >= (int)gridDim.x / 2) convert_weights(a, ldsf + wave * (64 * 33), lane, l + 1, ((int)blockIdx.x - (int)gridDim.x / 2) * 8 + wave, ((int)gridDim.x - (int)gridDim.x / 2) * 8);
                }
            } else if (sp == 1) {
                if constexpr ((KMASK >> 1) & 1) {
                for (int it = blockIdx.x; it < 256; it += gridDim.x) sgu_item(a, l, it, shm, tid, wave, lane);
#ifdef CONV_SKIP
                conv_phase<CONV_SKIP>(a, l, shm, tid, wave, lane); GRID_BAR();
#endif
                conv_phase<0>(a, l, shm, tid, wave, lane);
                }
            } else if (sp == 2) {
                if constexpr ((KMASK >> 2) & 1) scanprep_phase(a, l, shm, wave, lane);
            } else if (sp == 3) {
                if constexpr ((KMASK >> 3) & 1) {
#ifdef CSCAN_PROBE
                    cscan_phase<CSCAN_PROBE>(a, l, shm, tid, wave, lane); GRID_BAR();
#endif
                    cscan_phase<0>(a, l, shm, tid, wave, lane);
                }
            } else if (sp == 4) {
                if constexpr ((KMASK >> 4) & 1) phase_branchc(a, l, wave, lane);
            } else if (sp == 5) {
                if constexpr ((KMASK >> 5) & 1) {
#pragma unroll 1
                for (int rd = 0; rd < 2; ++rd) {
                    pg8::Gemm g{(const bf16_t*)(a.ws + WS_RA), (const bf16_t*)(a.ws + WS_WOUT) + (size_t)l * 1024 * 1024, M_, 1024, 1024};
                    RoundOrder S; S.base.init(M_, 1024, (int)gridDim.x, (int)blockIdx.x); S.round = rd;
                    EpiXnew E{(const bf16_t*)a.out, (bf16_t*)(a.ws + WS_RB), a.in[I_POSTG] + l * 1024, (float*)(a.ws + WS_XCH), (unsigned*)(a.ws + WS_CNT) + (size_t)l * 128 * 64};
                    pg8::gemm_phase<EpiXnew, RoundOrder, false>((PG8_LAS unsigned char*)shm, g, S, E, nullptr);
                }
                }
            } else {
                if constexpr ((KMASK >> 6) & 1) {
                int gdx_ = (int)gridDim.x, bix_ = (int)blockIdx.x; asm volatile("" : "+s"(gdx_), "+s"(bix_));
                {
                    pg8::Gemm g{(const bf16_t*)(a.ws + WS_RB), (const bf16_t*)(a.ws + WS_WG) + (size_t)l * 1024 * 1024, M_, 1024, 1024};
                    pg8::StaticOrder S; S.init(M_, 1024, gdx_, bix_);
                    EpiGate E{(unsigned char*)(a.ws + WS_PP), a.in[I_GB] + l * 1024};
                    pg8::gemm_phase<EpiGate, pg8::StaticOrder, false>((PG8_LAS unsigned char*)shm, g, S, E, nullptr);
                }
                {
                    pg8::Gemm g{(const bf16_t*)(a.ws + WS_PB), (const bf16_t*)(a.ws + WS_WP) + (size_t)l * 1024 * 256, M_, 1024, 256};
                    pg8::StaticOrder S; S.init(M_, 1024, gdx_, bix_);
                    if (l == L_ - 1) { EpiOut<true> E{(const bf16_t*)(a.ws + WS_RB), (const unsigned char*)(a.ws + WS_PP), (bf16_t*)a.out, a.out, (float*)(a.ws + WS_SSQ1)};
                        pg8::gemm_phase<EpiOut<true>, pg8::StaticOrder, false>((PG8_LAS unsigned char*)shm, g, S, E, nullptr); }
                    else { EpiOut<false> E{(const bf16_t*)(a.ws + WS_RB), (const unsigned char*)(a.ws + WS_PP), (bf16_t*)a.out, nullptr, (float*)(a.ws + WS_SSQ1)};
                        pg8::gemm_phase<EpiOut<false>, pg8::StaticOrder, false>((PG8_LAS unsigned char*)shm, g, S, E, nullptr); }
                }
                }
            }
        }
      }
        if (ph + 1 < a.ph_hi) GRID_BAR();
#ifdef PROBE_SP
        { const unsigned long long tnow = __builtin_amdgcn_s_memrealtime(); if ((ph == 0 && PROBE_SP < 0) || (ph > 0 && (ph - 1) % NSP == PROBE_SP)) probe_acc += tnow - probe_t0; probe_t0 = tnow; }
#endif
    }
#ifdef PROBE_SP
    { const unsigned long long t0 = __builtin_amdgcn_s_memrealtime(); while (__builtin_amdgcn_s_memrealtime() - t0 < probe_acc) __builtin_amdgcn_s_sleep(8); }
#endif
}

template <int KMASK> static bool prep_kernel(int lds_bytes) {
    return hipFuncSetAttribute((const void*)fwd_kernel<KMASK>, hipFuncAttributeMaxDynamicSharedMemorySize, lds_bytes) == hipSuccess;
}
template <int K> static void launch_kind(int kind, int grid, int lds, hipStream_t st, const Args& a) {
    if constexpr (K <= NSP) { if (kind == K) hipLaunchKernelGGL(fwd_kernel<(1 << K)>, dim3(grid), dim3(512), lds, st, a); else launch_kind<K + 1>(kind, grid, lds, st, a); }
}
template <int K> static bool prep_all(int lds) { if constexpr (K <= NSP) return prep_kernel<(1 << K)>(lds) && prep_all<K + 1>(lds); else return true; }

extern "C" void kernel_launch(void* const* d_in, const int* in_sizes, int n_in, void* d_out, int out_size, void* d_ws, size_t ws_size, hipStream_t stream) {
    static int grid = 0;
    constexpr int LDS_BYTES = LDS_MAIN + 64;
    if (grid == 0) {
        if (n_in != N_IN || out_size != M_ * D_ || ws_size < WS_END) { fprintf(stderr, "kernel_launch: unexpected shapes (n_in %d, out %d, ws %zu < %zu)\n", n_in, out_size, ws_size, (size_t)WS_END); grid = -1; return; }
        int dev = 0, cus = 0;
        (void)hipGetDevice(&dev); (void)hipDeviceGetAttribute(&cus, hipDeviceAttributeMultiprocessorCount, dev);
#if MK_ONE_LAUNCH
        bool ok = prep_kernel<KALL>(LDS_BYTES);
        int per_cu = 0;
        (void)hipOccupancyMaxActiveBlocksPerMultiprocessor(&per_cu, (const void*)fwd_kernel<KALL>, 512, LDS_BYTES);
        (void)hipGetLastError();
        if (per_cu < 1) { fprintf(stderr, "kernel_launch: occupancy query says %d blocks per CU\n", per_cu); ok = false; }
#else
        bool ok = prep_all<0>(LDS_BYTES);
#endif
        if (!ok) { fprintf(stderr, "kernel_launch: kernel set-up failed\n"); grid = -1; return; }
        grid = cus;
    }
    if (grid < 0) return;
    Args a{};
    for (int i = 0; i < N_IN; ++i) a.in[i] = (const float*)d_in[i];
    a.out = (float*)d_out; a.ws = (unsigned char*)d_ws;
#if MK_ONE_LAUNCH
    (void)hipMemsetAsync(d_ws, 0, XCD_BAR_WORDS * 4, stream);
    (void)hipMemsetAsync((unsigned char*)d_ws + WS_CNT, 0, (size_t)L_ * 128 * 256, stream);
    a.ph_lo = 0; a.ph_hi = N_PHASES;
    void* args[] = {&a};
    hipError_t e = hipLaunchCooperativeKernel((const void*)fwd_kernel<KALL>, dim3(grid), dim3(512), args, LDS_BYTES, stream);
    if (e != hipSuccess) fprintf(stderr, "cooperative launch failed: %s (grid %d)\n", hipGetErrorString(e), grid);
#else
    for (int ph = 0; ph < N_PHASES; ++ph) {
        a.ph_lo = ph; a.ph_hi = ph + 1;
        launch_kind<0>(ph == 0 ? NSP : (ph - 1) % NSP, grid, LDS_BYTES, stream, a);
    }
#endif
}
```
